# Optimizing an MI355X kernel written in HIP

```python
import math
import jax, jax.numpy as jnp
from jax import lax
import numpy as np

D_MODEL = 2048
BATCH = 1
SEQ = 8192
DEPTH = 1

RWKV_HEADS = 16
RWKV_HEAD_DIM = 64
RWKV_WIDTH = RWKV_HEADS * RWKV_HEAD_DIM
DECAY_LORA = 64
AAA_LORA = 64
GATE_LORA = 128
DIFF_HEADS = 8
DIFF_QK_DIM = 64
DIFF_V_DIM = 2 * DIFF_QK_DIM
DIFF_WIDTH = DIFF_HEADS * DIFF_V_DIM
MIX_WIDTH = RWKV_WIDTH + DIFF_WIDTH
ROPE_THETA = 10000.0
Q_BLOCK = 128
RWKV_COLS = 3 * RWKV_WIDTH + DECAY_LORA + AAA_LORA + GATE_LORA
DIFF_QK_COLS = DIFF_HEADS * 2 * DIFF_QK_DIM
DIFF_COLS = 2 * DIFF_QK_COLS + DIFF_WIDTH
IN_COLS = RWKV_COLS + DIFF_COLS
MEM_LEN = 256
MEM_HEADS = 4
MEM_HEAD_DIM = D_MODEL // MEM_HEADS
N_GROUPS = 8
EXPERTS_PER_GROUP = 8
N_EXPERTS = N_GROUPS * EXPERTS_PER_GROUP
TOP_K = 2
D_EXPERT = D_MODEL // 2
EXPERT_BLOCK = 128
NORM_EPS = 1e-6
LNX_EPS = 64e-5
SUBLN_EPS = 1e-5

kernel_name = "hymba_rwkv7_diffattn_hiermoe_layer"


def rms_norm(x, g, eps=NORM_EPS):
    xf = x.astype(jnp.float32)
    y = xf * lax.rsqrt(jnp.mean(xf * xf, axis=-1, keepdims=True) + eps)
    return (y * g.astype(jnp.float32)).astype(x.dtype)


def wkv7_scan(r, w, k, v, a, b):
    B, S, H, N = r.shape

    def step(state, inp):
        r_t, w_t, k_t, v_t, a_t, b_t = inp
        sa = jnp.einsum('bhvk,bhk->bhv', state, a_t)
        state = (state * w_t[:, :, None, :] + sa[..., None] * b_t[:, :, None, :]
                 + v_t[..., None] * k_t[:, :, None, :])
        y_t = jnp.einsum('bhvk,bhk->bhv', state, r_t)
        return state, y_t

    s0 = jnp.zeros((B, H, N, N), jnp.float32)
    xs = tuple(jnp.moveaxis(t, 1, 0) for t in (r, w, k, v, a, b))
    _, ys = lax.scan(step, s0, xs)
    return jnp.moveaxis(ys, 0, 1)


def rwkv7_group(p, mu, w0, w2, a0, a2, g2, k_k, k_a, r_k, lnx_w, lnx_b):
    f32 = jnp.float32
    B, S, _ = p.shape
    H, N = RWKV_HEADS, RWKV_HEAD_DIM
    prev = jnp.pad(p, ((0, 0), (1, 0), (0, 0)))[:, :-1]
    p = (p + (prev - p) * mu).astype(f32)
    split_at = [RWKV_WIDTH, 2 * RWKV_WIDTH, 3 * RWKV_WIDTH,
                3 * RWKV_WIDTH + DECAY_LORA, 3 * RWKV_WIDTH + DECAY_LORA + AAA_LORA]
    r, k, v, wd, ad, gd = jnp.split(p, split_at, axis=-1)
    w_raw = -jax.nn.softplus(-(w0.astype(f32) + jnp.tanh(wd) @ w2.astype(f32))) - 0.5
    decay = jnp.exp(-jnp.exp(w_raw))
    a = jax.nn.sigmoid(a0.astype(f32) + ad @ a2.astype(f32))
    g = jax.nn.sigmoid(gd) @ g2.astype(f32)
    heads = lambda t: t.reshape(B, S, H, N)
    kk = heads(k * k_k.astype(f32))
    kk = kk / jnp.maximum(jnp.sqrt(jnp.sum(kk * kk, axis=-1, keepdims=True)), 1e-12)
    k = k * (1.0 + (a - 1.0) * k_a.astype(f32))
    r_h, k_h, v_h, a_h = heads(r), heads(k), heads(v), heads(a)
    y = wkv7_scan(r_h, heads(decay), k_h, v_h, -kk, kk * a_h)
    mean = jnp.mean(y, axis=-1, keepdims=True)
    var = jnp.mean((y - mean) ** 2, axis=-1, keepdims=True)
    y = ((y - mean) * lax.rsqrt(var + LNX_EPS)).reshape(B, S, RWKV_WIDTH)
    y = y * lnx_w.astype(f32) + lnx_b.astype(f32)
    bonus = jnp.sum(r_h * k_h * r_k.astype(f32), axis=-1, keepdims=True) * v_h
    y = y + bonus.reshape(B, S, RWKV_WIDTH)
    return y * g


def rope_tables(positions):
    inv_freq = ROPE_THETA ** (-(jnp.arange(0, DIFF_QK_DIM, 2, dtype=jnp.float32) / DIFF_QK_DIM))
    ang = positions.astype(jnp.float32)[..., None] * inv_freq
    return jnp.cos(ang), jnp.sin(ang)


def apply_rope(t, cos, sin):
    t1, t2 = jnp.split(t, 2, axis=-1)
    return jnp.concatenate([t1 * cos - t2 * sin, t1 * sin + t2 * cos], axis=-1)


def diff_attention_group(p, positions, lambdas, subln_w, lambda_init):
    f32 = jnp.float32
    B, S, _ = p.shape
    H, DQ, DV = DIFF_HEADS, DIFF_QK_DIM, DIFF_V_DIM
    q, k, v = jnp.split(p.astype(f32), [DIFF_QK_COLS, 2 * DIFF_QK_COLS], axis=-1)
    q = q.reshape(B, S, H, 2, DQ)
    k = k.reshape(B, S, H, 2, DQ)
    v = v.reshape(B, S, H, DV)
    cos, sin = rope_tables(positions)
    cos, sin = cos[:, :, None, None, :], sin[:, :, None, None, :]
    q = apply_rope(q, cos, sin) * (DQ ** -0.5)
    k = apply_rope(k, cos, sin)
    lam_p = lambdas.astype(f32)
    lam = (jnp.exp(jnp.sum(lam_p[0] * lam_p[1])) - jnp.exp(jnp.sum(lam_p[2] * lam_p[3]))
           + lambda_init)
    nb = S // Q_BLOCK
    qb = jnp.moveaxis(q.reshape(B, nb, Q_BLOCK, H, 2, DQ), 1, 0)
    kpos = jnp.arange(S)

    def block(args):
        q_blk, start = args
        s = jnp.einsum('bqhcd,bkhcd->bhcqk', q_blk, k)
        qpos = start + jnp.arange(Q_BLOCK)
        s = jnp.where(kpos[None, :] <= qpos[:, None], s, -jnp.inf)
        pr = jax.nn.softmax(s, axis=-1)
        attn = pr[:, :, 0] - lam * pr[:, :, 1]
        return jnp.einsum('bhqk,bkhe->bqhe', attn, v)

    o = lax.map(block, (qb, jnp.arange(nb) * Q_BLOCK))
    o = jnp.moveaxis(o, 0, 1).reshape(B, S, H, DV)
    o = o * lax.rsqrt(jnp.mean(o * o, axis=-1, keepdims=True) + SUBLN_EPS)
    o = o * subln_w.astype(f32) * (1.0 - lambda_init)
    return o.reshape(B, S, DIFF_WIDTH)


def memory_cross_attention(h, memn, wq, wk, wv, wo):
    f32 = jnp.float32
    B, S, D = h.shape
    M = memn.shape[1]
    q = (h @ wq).reshape(B, S, MEM_HEADS, MEM_HEAD_DIM).astype(f32)
    k = (memn @ wk).reshape(B, M, MEM_HEADS, MEM_HEAD_DIM).astype(f32)
    v = (memn @ wv).reshape(B, M, MEM_HEADS, MEM_HEAD_DIM).astype(f32)
    s = jnp.einsum('bqhd,bkhd->bhqk', q, k) * (MEM_HEAD_DIM ** -0.5)
    pr = jax.nn.softmax(s, axis=-1)
    o = jnp.einsum('bhqk,bkhd->bqhd', pr, v).reshape(B, S, D).astype(h.dtype)
    return o @ wo


def hierarchical_moe(h, wg_r, bg_r, we_r, be_r, w_gate, w_up, w_down):
    f32 = jnp.float32
    B, S, D = h.shape
    Ntok = B * S
    hf = h.reshape(Ntok, D)
    hf32 = hf.astype(f32)
    g_logits = hf32 @ wg_r.astype(f32) + bg_r.astype(f32)
    g_prob = jax.nn.softmax(g_logits, axis=-1)
    g_idx = jnp.argmax(g_logits, axis=-1)
    g_w = jnp.take_along_axis(g_prob, g_idx[:, None], axis=-1)[:, 0]
    e_logits = (hf32 @ we_r.astype(f32) + be_r.astype(f32)).reshape(Ntok, N_GROUPS, EXPERTS_PER_GROUP)
    e_logits = jnp.take_along_axis(e_logits, g_idx[:, None, None], axis=1)[:, 0]
    e_prob = jax.nn.softmax(e_logits, axis=-1)
    top_p, top_i = lax.top_k(e_prob, TOP_K)
    top_p = top_p / jnp.sum(top_p, axis=-1, keepdims=True)
    weights = g_w[:, None] * top_p
    expert_id = g_idx[:, None] * EXPERTS_PER_GROUP + top_i

    A = Ntok * TOP_K
    flat_e = expert_id.reshape(A).astype(jnp.int32)
    flat_tok = jnp.repeat(jnp.arange(Ntok, dtype=jnp.int32), TOP_K)
    flat_w = weights.reshape(A)
    order = jnp.argsort(flat_e, stable=True)
    sorted_e = flat_e[order]
    counts = jnp.bincount(flat_e, length=N_EXPERTS)
    padded_counts = ((counts + EXPERT_BLOCK - 1) // EXPERT_BLOCK) * EXPERT_BLOCK
    padded_end = jnp.cumsum(padded_counts)
    padded_start = padded_end - padded_counts
    start = jnp.cumsum(counts) - counts
    rank = jnp.arange(A) - start[sorted_e]
    dest = padded_start[sorted_e] + rank
    n_blocks = -(-(A + N_EXPERTS * (EXPERT_BLOCK - 1)) // EXPERT_BLOCK)
    P = n_blocks * EXPERT_BLOCK
    buf_tok = jnp.zeros((P,), jnp.int32).at[dest].set(flat_tok[order])
    buf_w = jnp.zeros((P,), f32).at[dest].set(flat_w[order])
    block_start = jnp.arange(n_blocks) * EXPERT_BLOCK
    block_e = jnp.minimum(jnp.searchsorted(padded_end, block_start, side='right'), N_EXPERTS - 1)

    def run_block(args):
        tok, w, e = args
        xb = hf[tok]
        hid = jax.nn.silu(xb @ w_gate[e]) * (xb @ w_up[e])
        return (hid @ w_down[e]).astype(f32) * w[:, None]

    ys = lax.map(run_block, (buf_tok.reshape(n_blocks, EXPERT_BLOCK),
                             buf_w.reshape(n_blocks, EXPERT_BLOCK), block_e))
    out = jnp.zeros((Ntok, D), f32).at[buf_tok].add(ys.reshape(P, D))
    return out.reshape(B, S, D).astype(h.dtype)


def setup_inputs(seed: int = 0) -> dict:
    key = jax.random.key(seed)
    ks = iter(jax.random.split(key, 48))
    f32 = jnp.float32
    L, D = DEPTH, D_MODEL

    def nrm(shape, scale):
        return jax.random.normal(next(ks), shape, f32) * scale

    def unif(shape, lo, hi):
        return jax.random.uniform(next(ks), shape, f32, lo, hi)

    return {
        "x": nrm((BATCH, SEQ, D), 1.0),
        "mem": nrm((BATCH, MEM_LEN, D), 1.0),
        "positions": jnp.broadcast_to(jnp.arange(SEQ, dtype=jnp.int32), (BATCH, SEQ)),
        "mix_norm": 1.0 + nrm((L, D), 0.02),
        "w_in": nrm((L, D, IN_COLS), D ** -0.5),
        "shift_mu": unif((L, RWKV_COLS), 0.0, 1.0),
        "decay_w0": unif((L, RWKV_WIDTH), -5.0, 1.0),
        "decay_w2": nrm((L, DECAY_LORA, RWKV_WIDTH), 0.1),
        "aaa_a0": nrm((L, RWKV_WIDTH), 0.1),
        "aaa_a2": nrm((L, AAA_LORA, RWKV_WIDTH), AAA_LORA ** -0.5),
        "gate_g2": nrm((L, GATE_LORA, RWKV_WIDTH), GATE_LORA ** -0.5),
        "k_k": 0.85 + nrm((L, RWKV_WIDTH), 0.02),
        "k_a": 1.0 + nrm((L, RWKV_WIDTH), 0.02),
        "r_k": nrm((L, RWKV_HEADS, RWKV_HEAD_DIM), 0.1),
        "lnx_w": 1.0 + nrm((L, RWKV_WIDTH), 0.02),
        "lnx_b": nrm((L, RWKV_WIDTH), 0.02),
        "diff_lambda": nrm((L, 4, DIFF_QK_DIM), 0.1),
        "subln_w": 1.0 + nrm((L, DIFF_V_DIM), 0.02),
        "w_out": nrm((L, MIX_WIDTH, D), MIX_WIDTH ** -0.5),
        "mem_q_norm": 1.0 + nrm((L, D), 0.02),
        "mem_kv_norm": 1.0 + nrm((L, D), 0.02),
        "wq_mem": nrm((L, D, D), D ** -0.5),
        "wk_mem": nrm((L, D, D), D ** -0.5),
        "wv_mem": nrm((L, D, D), D ** -0.5),
        "wo_mem": nrm((L, D, D), D ** -0.5),
        "moe_norm": 1.0 + nrm((L, D), 0.02),
        "router_group_w": nrm((L, D, N_GROUPS), D ** -0.5),
        "router_group_b": nrm((L, N_GROUPS), 0.01),
        "router_expert_w": nrm((L, D, N_EXPERTS), D ** -0.5),
        "router_expert_b": nrm((L, N_EXPERTS), 0.01),
        "expert_gate": nrm((L, N_EXPERTS, D, D_EXPERT), D ** -0.5),
        "expert_up": nrm((L, N_EXPERTS, D, D_EXPERT), D ** -0.5),
        "expert_down": nrm((L, N_EXPERTS, D_EXPERT, D), D_EXPERT ** -0.5),
        "final_norm": 1.0 + nrm((D,), 0.02),
    }


def reference(x, mem, positions, mix_norm, w_in, shift_mu, decay_w0, decay_w2, aaa_a0, aaa_a2,
              gate_g2, k_k, k_a, r_k, lnx_w, lnx_b, diff_lambda, subln_w, w_out,
              mem_q_norm, mem_kv_norm, wq_mem, wk_mem, wv_mem, wo_mem,
              moe_norm, router_group_w, router_group_b, router_expert_w, router_expert_b,
              expert_gate, expert_up, expert_down, final_norm):
    h = x
    for l in range(DEPTH):
        lambda_init = 0.8 - 0.6 * math.exp(-0.3 * l)
        xn = rms_norm(h, mix_norm[l])
        proj = xn @ w_in[l]
        y_rwkv = rwkv7_group(proj[..., :RWKV_COLS], shift_mu[l], decay_w0[l], decay_w2[l],
                             aaa_a0[l], aaa_a2[l], gate_g2[l], k_k[l], k_a[l], r_k[l],
                             lnx_w[l], lnx_b[l])
        y_diff = diff_attention_group(proj[..., RWKV_COLS:], positions, diff_lambda[l],
                                      subln_w[l], lambda_init)
        mixed = jnp.concatenate([y_rwkv, y_diff], axis=-1).astype(h.dtype)
        h = h + mixed @ w_out[l]
        h = h + memory_cross_attention(rms_norm(h, mem_q_norm[l]), rms_norm(mem, mem_kv_norm[l]),
                                       wq_mem[l], wk_mem[l], wv_mem[l], wo_mem[l])
        h = h + hierarchical_moe(rms_norm(h, moe_norm[l]), router_group_w[l], router_group_b[l],
                                 router_expert_w[l], router_expert_b[l],
                                 expert_gate[l], expert_up[l], expert_down[l])
    return rms_norm(h, final_norm)
```

```cpp
#include <hip/hip_runtime.h>
#include <stdint.h>
#include <stdio.h>
#include <math.h>

typedef unsigned short bf16_t;
typedef float f32x4 __attribute__((ext_vector_type(4)));
typedef unsigned u32x4 __attribute__((ext_vector_type(4)));

constexpr int SEQ = 8192, DM = 2048, RW = 1024, NH_R = 16, HD_R = 64;
constexpr int RWKV_COLS = 3328, IN_COLS = 6400, QK_COLS = 1024;
constexpr int MEM_LEN = 256, MEM_HEADS = 4, MEM_HD = 512;
constexpr int N_GROUPS = 8, EPG = 8, N_EXP = 64, D_EXP = 1024;
constexpr int XG_ROWS = 32768;
constexpr float NORM_EPS = 1e-6f, LNX_EPS = 64e-5f, SUBLN_EPS = 1e-5f;
constexpr float LAMBDA_INIT = 0.2f;
constexpr float C2 = 0.125f * 1.4426950408889634f;

constexpr size_t MiB = 1u << 20;
constexpr size_t WS_CTL = 0, WS_ROPE = 1 * MiB, WS_WINT = 4 * MiB, WS_WOUTT = 29 * MiB, WS_WKVT = 37 * MiB, WS_WQB = 53 * MiB, WS_WOT = 61 * MiB,
                 WS_BTS = 69 * MiB, WS_BTO = 73 * MiB, WS_MEMN = 77 * MiB, WS_KV = 78 * MiB, WS_ASG = 80 * MiB, WS_BONUS = 81 * MiB,
                 WS_WGUT = 96 * MiB, WS_WDT = 608 * MiB, WS_H1 = 864 * MiB, WS_HN1 = 928 * MiB, WS_PM = 960 * MiB, WS_H2 = 976 * MiB, WS_XH = 1040 * MiB,
                 WS_XN = 1072 * MiB, WS_PR = 1104 * MiB, WS_QB = 1156 * MiB, WS_KB = 1172 * MiB, WS_VB = 1188 * MiB, WS_S0 = 1204 * MiB  ,
                 WS_Y = 1428 * MiB, WS_O2 = 1460 * MiB, WS_MIXED = 1492 * MiB, WS_END = 1524 * MiB;
constexpr size_t WS_QKRAW = WS_H2, WS_SRAW = WS_XH;
constexpr size_t WS_XG = 1072 * MiB, WS_HID = 1200 * MiB, WS_YC = 1264 * MiB, WS_GU = WS_YC;
constexpr int CW_CNT = 0, CW_BASE = 64, CW_NT = 160, CW_TILEE = 192;

__device__ __forceinline__ float bf2f(bf16_t b) { return __uint_as_float((unsigned)b << 16); }
__device__ __forceinline__ bf16_t f2bf(float f) { unsigned u = __float_as_uint(f); return (bf16_t)((u + 0x7fffu + ((u >> 16) & 1u)) >> 16); }
__device__ __forceinline__ float sigmoidf_(float x) { return 1.f / (1.f + __expf(-x)); }
__device__ __forceinline__ int rope_phys(int d) { return d < 32 ? 8 * (d >> 2) + (d & 3) : 8 * ((d - 32) >> 2) + 4 + ((d - 32) & 3); }

__global__ void k_transpose(const float* W, int K, int N, bf16_t* WT, int mode, int rowoff, size_t wstride, int rows_per_z) {
    __shared__ float t[32][33];
    W += (size_t)blockIdx.z * wstride; rowoff += blockIdx.z * rows_per_z;
    const int n0 = blockIdx.x * 32, k0 = blockIdx.y * 32, tx = threadIdx.x & 31, ty = threadIdx.x >> 5;
    for (int i = 0; i < 4; ++i) t[ty + 8 * i][tx] = W[(size_t)(k0 + ty + 8 * i) * N + n0 + tx];
    __syncthreads();
    for (int i = 0; i < 4; ++i) { const int n = n0 + ty + 8 * i; int r = n;
        if (mode == 1) r = (n & ~63) + rope_phys(n & 63);
        else if (mode == 2) r = (n >> 7) * 256 + (n & 127);
        else if (mode == 3) r = (n >> 7) * 256 + 128 + (n & 127);
        WT[(size_t)(rowoff + r) * K + k0 + tx] = f2bf(t[tx][ty + 8 * i]); }
}
__global__ void k_convert(const float* W, bf16_t* O, size_t n) { size_t i = (size_t)blockIdx.x * blockDim.x + threadIdx.x; if (i < n) O[i] = f2bf(W[i]); }
__global__ void k_rmsnorm_bf16(const float* x, const float* g, bf16_t* out) {
    __shared__ float red[4];
    const float* xr = x + (size_t)blockIdx.x * DM; const int tid = threadIdx.x;
    float v[8]; float s = 0.f;
    for (int i = 0; i < 8; ++i) { v[i] = xr[tid + 256 * i]; s += v[i] * v[i]; }
    for (int o = 32; o > 0; o >>= 1) s += __shfl_xor(s, o);
    if ((tid & 63) == 0) red[tid >> 6] = s;
    __syncthreads();
    const float rs = rsqrtf((red[0] + red[1] + red[2] + red[3]) * (1.f / DM) + NORM_EPS);
    for (int i = 0; i < 8; ++i) out[(size_t)blockIdx.x * DM + tid + 256 * i] = f2bf(v[i] * rs * g[tid + 256 * i]);
}
__global__ void k_rope_table(const int* pos, float* tab) {
    const int i = blockIdx.x * blockDim.x + threadIdx.x; if (i >= SEQ * 32) return;
    const int t = i >> 5, j = i & 31;
    const double inv = pow(10000.0, -(double)j / 32.0), ang = (double)pos[t] * inv;
    tab[2 * i] = (float)cos(ang); tab[2 * i + 1] = (float)sin(ang);
}

struct EpiInProj { bf16_t* PR; float* QKraw; bf16_t* Vb;
    __device__ void operator()(int m, int n, const float* v) const {
        if (n < RWKV_COLS) { for (int i = 0; i < 4; ++i) PR[(size_t)m * RWKV_COLS + n + i] = f2bf(v[i]); }
        else if (n < RWKV_COLS + 2 * QK_COLS) { for (int i = 0; i < 4; ++i) QKraw[(size_t)m * 2048 + (n - RWKV_COLS) + i] = v[i]; }
        else { for (int i = 0; i < 4; ++i) Vb[(size_t)m * 1024 + (n - RWKV_COLS - 2 * QK_COLS) + i] = f2bf(v[i]); } } };
struct EpiBf { bf16_t* C; int ldc; int pad = 0; __device__ void operator()(int m, int n, const float* v) const { for (int i = 0; i < 4; ++i) C[(size_t)m * ldc + n + i] = f2bf(v[i]); } };
struct EpiF32 { float* C; int ldc; int pad = 0; __device__ void operator()(int m, int n, const float* v) const { for (int i = 0; i < 4; ++i) C[(size_t)m * ldc + n + i] = v[i]; } };
struct EpiResid { const float* base; float* out; int ldc; int pad = 0; __device__ void operator()(int m, int n, const float* v) const { for (int i = 0; i < 4; ++i) out[(size_t)m * ldc + n + i] = base[(size_t)m * ldc + n + i] + v[i]; } };

template <class Epi>
__global__ void __launch_bounds__(256) k_gemm(const bf16_t* A, int lda, const bf16_t* Bt, int ldb, int K, Epi epi, const unsigned* ctl, int eStrideB) {
    __shared__ float As[32][68], Bs[32][68];
    const int tid = threadIdx.x, m0 = blockIdx.y * 64, n0 = blockIdx.x * 64;
    if (ctl) { if ((m0 >> 8) >= (int)ctl[CW_NT]) return; Bt += (size_t)ctl[CW_TILEE + (m0 >> 8)] * eStrideB * ldb; }
    const int lr = tid >> 2, lc = (tid & 3) * 8;
    const int ty = tid >> 4, tx = tid & 15;
    float acc[4][4] = {};
    for (int k0 = 0; k0 < K; k0 += 32) {
        const u32x4 av = *(const u32x4*)(A + (size_t)(m0 + lr) * lda + k0 + lc);
        const u32x4 bv = *(const u32x4*)(Bt + (size_t)(n0 + lr) * ldb + k0 + lc);
        __syncthreads();
        for (int i = 0; i < 4; ++i) { As[lc + 2 * i][lr] = __uint_as_float(av[i] << 16); As[lc + 2 * i + 1][lr] = __uint_as_float(av[i] & 0xffff0000u);
                                      Bs[lc + 2 * i][lr] = __uint_as_float(bv[i] << 16); Bs[lc + 2 * i + 1][lr] = __uint_as_float(bv[i] & 0xffff0000u); }
        __syncthreads();
#pragma unroll 8
        for (int k = 0; k < 32; ++k) { const f32x4 a = *(const f32x4*)&As[k][ty * 4], b = *(const f32x4*)&Bs[k][tx * 4];
            for (int i = 0; i < 4; ++i) for (int j = 0; j < 4; ++j) acc[i][j] += a[i] * b[j]; }
    }
    for (int i = 0; i < 4; ++i) epi(m0 + ty * 4 + i, n0 + tx * 4, acc[i]);
}

__global__ void k_rope_apply(const float* QKraw, const float* tab, bf16_t* Qb, bf16_t* Kb) {
    const int t = blockIdx.x;
    for (int idx = threadIdx.x; idx < 1024; idx += 256) { const int which = idx >> 9, sh = (idx >> 5) & 15, j = idx & 31;
        const int plo = 8 * (j >> 2) + (j & 3), phi = plo + 4;
        const float* src = QKraw + (size_t)t * 2048 + which * 1024 + sh * 64;
        const float x1 = src[plo], x2 = src[phi], c = tab[((size_t)t * 32 + j) * 2], s = tab[((size_t)t * 32 + j) * 2 + 1];
        const float sc = which == 0 ? C2 : 1.f;
        bf16_t* dst = (which == 0 ? Qb : Kb) + (size_t)t * 1024 + sh * 64;
        dst[plo] = f2bf((x1 * c - x2 * s) * sc); dst[phi] = f2bf((x1 * s + x2 * c) * sc); }
}

struct PrepW { const float *mu, *w0, *w2, *a0, *a2, *g2, *k_k, *k_a, *r_k; };
__global__ void __launch_bounds__(256) k_prep(const bf16_t* PR, PrepW P, float* S0, float* BONUS) {
    __shared__ float xs[256];
    const int t = blockIdx.x, tid = threadIdx.x;
    const bf16_t* cur = PR + (size_t)t * RWKV_COLS; const bf16_t* prv = cur - RWKV_COLS;
    auto shifted = [&](int c) { const float a = bf2f(cur[c]), p = t > 0 ? bf2f(prv[c]) : 0.f; return a + (p - a) * P.mu[c]; };
    { const float v = shifted(3072 + tid); xs[tid] = tid < 64 ? tanhf(v) : (tid < 128 ? v : sigmoidf_(v)); }
    __syncthreads();
    float lw[4], la[4], lg[4] = {0.f, 0.f, 0.f, 0.f};
    for (int i = 0; i < 4; ++i) { lw[i] = P.w0[tid * 4 + i]; la[i] = P.a0[tid * 4 + i]; }
#pragma unroll 4
    for (int j = 0; j < 64; ++j) { const f32x4 w = *(const f32x4*)(P.w2 + (size_t)j * RW + tid * 4), a = *(const f32x4*)(P.a2 + (size_t)j * RW + tid * 4);
        for (int i = 0; i < 4; ++i) { lw[i] += xs[j] * w[i]; la[i] += xs[64 + j] * a[i]; } }
#pragma unroll 4
    for (int j = 0; j < 128; ++j) { const f32x4 g = *(const f32x4*)(P.g2 + (size_t)j * RW + tid * 4); for (int i = 0; i < 4; ++i) lg[i] += xs[128 + j] * g[i]; }
    float r[4], k0[4], v[4], kk[4], a[4], ss = 0.f;
    for (int i = 0; i < 4; ++i) { const int c = tid * 4 + i; r[i] = shifted(c); k0[i] = shifted(1024 + c); v[i] = shifted(2048 + c);
        a[i] = sigmoidf_(la[i]); kk[i] = k0[i] * P.k_k[c]; ss += kk[i] * kk[i]; }
    for (int o = 1; o < 16; o <<= 1) ss += __shfl_xor(ss, o);
    const float inv = 1.f / fmaxf(sqrtf(ss), 1e-12f);
    float bon = 0.f; const size_t ob = (size_t)t * RW + tid * 4; constexpr size_t SS = (size_t)SEQ * RW;
    for (int i = 0; i < 4; ++i) { const int c = tid * 4 + i;
        const float x = -lw[i], sp = fmaxf(x, 0.f) + log1pf(__expf(-fabsf(x))), wraw = -sp - 0.5f, dec = __expf(-__expf(wraw));
        const float kn = kk[i] * inv, k = k0[i] * (1.f + (a[i] - 1.f) * P.k_a[c]);
        bon += r[i] * k * P.r_k[c];
        S0[0 * SS + ob + i] = r[i]; S0[1 * SS + ob + i] = dec; S0[2 * SS + ob + i] = k; S0[3 * SS + ob + i] = v[i];
        S0[4 * SS + ob + i] = -kn; S0[5 * SS + ob + i] = kn * a[i]; S0[6 * SS + ob + i] = lg[i]; }
    for (int o = 1; o < 16; o <<= 1) bon += __shfl_xor(bon, o);
    if ((tid & 15) == 0) BONUS[t * 16 + (tid >> 4)] = bon;
}
__global__ void __launch_bounds__(256) k_scan(const float* S0, float* Y) {
    const int w = blockIdx.x * 4 + (threadIdx.x >> 6), lane = threadIdx.x & 63, h = w >> 6, vr = w & 63;
    constexpr size_t SS = (size_t)SEQ * RW;
    const float* pr = S0 + h * 64 + lane; float s = 0.f;
    for (int t = 0; t < SEQ; ++t) { const size_t o = (size_t)t * RW;
        const float r = pr[o], wd = pr[SS + o], k = pr[2 * SS + o], a = pr[4 * SS + o], b = pr[5 * SS + o], v = S0[3 * SS + o + h * 64 + vr];
        float sa = s * a; for (int x = 32; x > 0; x >>= 1) sa += __shfl_xor(sa, x);
        s = s * wd + sa * b + v * k;
        float y = s * r; for (int x = 32; x > 0; x >>= 1) y += __shfl_xor(y, x);
        if (lane == 0) Y[o + h * 64 + vr] = y; }
}
__global__ void __launch_bounds__(256) k_rwkv_post(const float* Y, const float* S0, const float* BONUS, const float* lnx_w, const float* lnx_b, bf16_t* MIXED) {
    const int t = blockIdx.x, tid = threadIdx.x; constexpr size_t SS = (size_t)SEQ * RW; const size_t ob = (size_t)t * RW + tid * 4;
    float y[4], s = 0.f; for (int i = 0; i < 4; ++i) { y[i] = Y[ob + i]; s += y[i]; }
    for (int o = 1; o < 16; o <<= 1) s += __shfl_xor(s, o);
    const float mean = s * (1.f / 64.f); float q = 0.f; for (int i = 0; i < 4; ++i) { y[i] -= mean; q += y[i] * y[i]; }
    for (int o = 1; o < 16; o <<= 1) q += __shfl_xor(q, o);
    const float rstd = rsqrtf(q * (1.f / 64.f) + LNX_EPS), bon = BONUS[t * 16 + (tid >> 4)];
    for (int i = 0; i < 4; ++i) { const int c = tid * 4 + i; const float o = (y[i] * rstd * lnx_w[c] + lnx_b[c] + bon * S0[3 * SS + ob + i]) * S0[6 * SS + ob + i];
        MIXED[(size_t)t * DM + c] = f2bf(o); }
}
__global__ void __launch_bounds__(64) k_attn(const bf16_t* Qb, const bf16_t* Kb, const bf16_t* Vb, bf16_t* O2) {
    const int row = blockIdx.x * 64 + threadIdx.x, sh = blockIdx.y, qt = blockIdx.z;
    float q[64], o[32]; for (int d = 0; d < 64; ++d) q[d] = bf2f(Qb[(size_t)row * 1024 + sh * 64 + d]);
    for (int d = 0; d < 32; ++d) o[d] = 0.f;
    float m = -1e30f, l = 0.f; const int jmax = blockIdx.x * 64 + 63;
    const bf16_t* kp = Kb + sh * 64; const bf16_t* vp = Vb + (sh >> 1) * 128 + qt * 32;
    for (int j = 0; j <= jmax; ++j) {
        float s = 0.f; for (int d = 0; d < 64; ++d) s += q[d] * bf2f(kp[(size_t)j * 1024 + d]);
        if (j <= row) { const float mn = fmaxf(m, s), f = exp2f(m - mn), p = exp2f(s - mn); l = l * f + p; m = mn;
            for (int d = 0; d < 32; ++d) o[d] = o[d] * f + p * bf2f(vp[(size_t)j * 1024 + d]); } }
    const float il = 1.f / l;
    for (int d = 0; d < 32; ++d) O2[(size_t)row * 2048 + sh * 128 + qt * 32 + d] = f2bf(o[d] * il);
}
__global__ void __launch_bounds__(256) k_diff_post(const bf16_t* O2, const float* lambdas, const float* subln_w, bf16_t* MIXED) {
    __shared__ float lamsh;
    const int t = blockIdx.x, tid = threadIdx.x;
    if (tid < 64) { float a = lambdas[tid] * lambdas[64 + tid], b = lambdas[128 + tid] * lambdas[192 + tid];
        for (int o = 32; o > 0; o >>= 1) { a += __shfl_xor(a, o); b += __shfl_xor(b, o); }
        if (tid == 0) lamsh = expf(a) - expf(b) + LAMBDA_INIT; }
    __syncthreads();
    const float lam = lamsh; const int h = tid >> 5, d0 = (tid & 31) * 4;
    float o[4], q = 0.f;
    for (int i = 0; i < 4; ++i) { o[i] = bf2f(O2[(size_t)t * 2048 + h * 256 + d0 + i]) - lam * bf2f(O2[(size_t)t * 2048 + h * 256 + 128 + d0 + i]); q += o[i] * o[i]; }
    for (int x = 1; x < 32; x <<= 1) q += __shfl_xor(q, x);
    const float rs = rsqrtf(q * (1.f / 128.f) + SUBLN_EPS) * (1.f - LAMBDA_INIT);
    for (int i = 0; i < 4; ++i) MIXED[(size_t)t * DM + 1024 + h * 128 + d0 + i] = f2bf(o[i] * rs * subln_w[d0 + i]);
}
__global__ void __launch_bounds__(256) k_softmax_mem(const float* Sraw, bf16_t* Pm) {
    const int t = blockIdx.x, tid = threadIdx.x, h = tid >> 6;
    const float sc = 0.044194173824159216f;
    float v[4], m = -1e30f; for (int i = 0; i < 4; ++i) { v[i] = Sraw[(size_t)t * 1024 + h * 256 + (tid & 63) + 64 * i] * sc; m = fmaxf(m, v[i]); }
    for (int o = 32; o > 0; o >>= 1) m = fmaxf(m, __shfl_xor(m, o));
    float s = 0.f; for (int i = 0; i < 4; ++i) { v[i] = __expf(v[i] - m); s += v[i]; }
    for (int o = 32; o > 0; o >>= 1) s += __shfl_xor(s, o);
    const float il = 1.f / s; for (int i = 0; i < 4; ++i) Pm[(size_t)t * 1024 + h * 256 + (tid & 63) + 64 * i] = f2bf(v[i] * il);
}
__global__ void __launch_bounds__(256) k_router(const float* H2, const float* g, const float* wg, const float* bg, const float* we, const float* be, bf16_t* XH, unsigned* ctl, int* asg_e, int* asg_r, float* asg_w) {
    __shared__ float hn[DM]; __shared__ float red[4]; __shared__ float lg[72];
    const int t = blockIdx.x, tid = threadIdx.x; const float* xr = H2 + (size_t)t * DM;
    float v[8], s = 0.f; for (int i = 0; i < 8; ++i) { v[i] = xr[tid + 256 * i]; s += v[i] * v[i]; }
    for (int o = 32; o > 0; o >>= 1) s += __shfl_xor(s, o);
    if ((tid & 63) == 0) red[tid >> 6] = s;
    __syncthreads();
    const float rs = rsqrtf((red[0] + red[1] + red[2] + red[3]) * (1.f / DM) + NORM_EPS);
    for (int i = 0; i < 8; ++i) { const float x = v[i] * rs * g[tid + 256 * i]; hn[tid + 256 * i] = x; XH[(size_t)t * DM + tid + 256 * i] = f2bf(x); }
    __syncthreads();
    if (tid < 72) { float a = 0.f;
        if (tid < 8) { for (int k = 0; k < DM; ++k) a += hn[k] * wg[(size_t)k * 8 + tid]; a += bg[tid]; }
        else { for (int k = 0; k < DM; ++k) a += hn[k] * we[(size_t)k * 64 + tid - 8]; a += be[tid - 8]; }
        lg[tid] = a; }
    __syncthreads();
    if (tid == 0) {
        int gi = 0; float gm = lg[0]; for (int i = 1; i < 8; ++i) if (lg[i] > gm) { gm = lg[i]; gi = i; }
        float gs = 0.f; for (int i = 0; i < 8; ++i) gs += expf(lg[i] - gm);
        const float gw = 1.f / gs;
        const float* el = lg + 8 + gi * 8; int i0 = 0; for (int i = 1; i < 8; ++i) if (el[i] > el[i0]) i0 = i;
        int i1 = -1; for (int i = 0; i < 8; ++i) if (i != i0 && (i1 < 0 || el[i] > el[i1])) i1 = i;
        const float p1 = expf(el[i1] - el[i0]), w0 = gw / (1.f + p1), w1 = gw * p1 / (1.f + p1);
        const int e0 = gi * 8 + i0, e1 = gi * 8 + i1;
        asg_e[2 * t] = e0; asg_e[2 * t + 1] = e1; asg_w[2 * t] = w0; asg_w[2 * t + 1] = w1;
        asg_r[2 * t] = (int)atomicAdd(&ctl[CW_CNT + e0], 1u); asg_r[2 * t + 1] = (int)atomicAdd(&ctl[CW_CNT + e1], 1u); }
}
__global__ void k_moe_offsets(unsigned* ctl) {
    if (threadIdx.x == 0) { unsigned b = 0; int nt = 0;
        for (int e = 0; e < N_EXP; ++e) { ctl[CW_BASE + e] = b; const unsigned n = (ctl[CW_CNT + e] + 255u) / 256u; for (unsigned i = 0; i < n; ++i) ctl[CW_TILEE + nt++] = e; b += n * 256u; }
        ctl[CW_BASE + N_EXP] = b; ctl[CW_NT] = nt; }
}
__global__ void __launch_bounds__(256) k_gather(const bf16_t* XH, const unsigned* ctl, const int* asg_e, const int* asg_r, bf16_t* XG) {
    const int t = blockIdx.x, tid = threadIdx.x; const u32x4 v = *(const u32x4*)(XH + (size_t)t * DM + tid * 8);
    for (int i = 0; i < 2; ++i) { const size_t row = ctl[CW_BASE + asg_e[2 * t + i]] + asg_r[2 * t + i]; *(u32x4*)(XG + row * DM + tid * 8) = v; }
}
__global__ void k_silu_mul(const float* GU, const unsigned* ctl, bf16_t* HID) {
    const size_t i = (size_t)blockIdx.x * blockDim.x + threadIdx.x; const size_t row = i >> 10; const int c = (int)(i & 1023);
    if (row >= (size_t)ctl[CW_NT] * 256) return;
    const float gt = GU[row * 2048 + (c >> 7) * 256 + (c & 127)], up = GU[row * 2048 + (c >> 7) * 256 + 128 + (c & 127)];
    HID[row * 1024 + c] = f2bf(gt / (1.f + __expf(-gt)) * up);
}
__global__ void __launch_bounds__(256) k_final(const float* H2, const float* YC, const unsigned* ctl, const int* asg_e, const int* asg_r, const float* asg_w, const float* g, float* out) {
    __shared__ float red[4];
    const int t = blockIdx.x, tid = threadIdx.x;
    const size_t r0 = ctl[CW_BASE + asg_e[2 * t]] + asg_r[2 * t], r1 = ctl[CW_BASE + asg_e[2 * t + 1]] + asg_r[2 * t + 1]; const float w0 = asg_w[2 * t], w1 = asg_w[2 * t + 1];
    float v[8], s = 0.f; for (int i = 0; i < 8; ++i) { const int c = tid + 256 * i; v[i] = H2[(size_t)t * DM + c] + (w0 * YC[r0 * DM + c] + w1 * YC[r1 * DM + c]); s += v[i] * v[i]; }
    for (int o = 32; o > 0; o >>= 1) s += __shfl_xor(s, o);
    if ((tid & 63) == 0) red[tid >> 6] = s;
    __syncthreads();
    const float rs = rsqrtf((red[0] + red[1] + red[2] + red[3]) * (1.f / DM) + NORM_EPS);
    for (int i = 0; i < 8; ++i) out[(size_t)t * DM + tid + 256 * i] = v[i] * rs * g[tid + 256 * i];
}

template <class Epi> static void gemm(hipStream_t st, const bf16_t* A, int lda, const bf16_t* Bt, int ldb, int M, int N, int K, Epi e, const unsigned* ctl = nullptr, int eStrideB = 0) {
    hipLaunchKernelGGL(k_gemm<Epi>, dim3(N / 64, M / 64), dim3(256), 0, st, A, lda, Bt, ldb, K, e, ctl, eStrideB);
}
extern "C" void kernel_launch(void* const* d_in, const int* in_sizes, int n_in, void* d_out, int out_size, void* d_ws, size_t ws_size, hipStream_t stream) {
    if (n_in != 34 || ws_size < WS_END) { fprintf(stderr, "kernel_launch: need 34 inputs and %zu bytes of workspace (got %d, %zu)\n", (size_t)WS_END, n_in, ws_size); return; }
    auto F = [&](int i) { return (const float*)d_in[i]; };
    const float *x = F(0), *mem = F(1); const int* positions = (const int*)d_in[2];
    const float *mix_norm = F(3), *w_in = F(4), *w_out = F(18), *mem_q_norm = F(19), *mem_kv_norm = F(20), *wq = F(21), *wk = F(22), *wv = F(23), *wo = F(24),
                *moe_norm = F(25), *rgw = F(26), *rgb = F(27), *rew = F(28), *reb = F(29), *eg = F(30), *eu = F(31), *ed = F(32), *final_norm = F(33);
    char* ws = (char*)d_ws; hipStream_t st = stream;
    unsigned* ctl = (unsigned*)(ws + WS_CTL); float* rope = (float*)(ws + WS_ROPE);
    bf16_t *WinT = (bf16_t*)(ws + WS_WINT), *WoutT = (bf16_t*)(ws + WS_WOUTT), *WkvT = (bf16_t*)(ws + WS_WKVT), *WqB = (bf16_t*)(ws + WS_WQB), *WoT = (bf16_t*)(ws + WS_WOT),
           *BtS = (bf16_t*)(ws + WS_BTS), *BtO = (bf16_t*)(ws + WS_BTO), *MEMN = (bf16_t*)(ws + WS_MEMN), *KV = (bf16_t*)(ws + WS_KV), *WguT = (bf16_t*)(ws + WS_WGUT), *WdT = (bf16_t*)(ws + WS_WDT),
           *HN1 = (bf16_t*)(ws + WS_HN1), *Pm = (bf16_t*)(ws + WS_PM), *XH = (bf16_t*)(ws + WS_XH), *XN = (bf16_t*)(ws + WS_XN), *PR = (bf16_t*)(ws + WS_PR), *Qb = (bf16_t*)(ws + WS_QB),
           *Kb = (bf16_t*)(ws + WS_KB), *Vb = (bf16_t*)(ws + WS_VB), *O2 = (bf16_t*)(ws + WS_O2), *MIXED = (bf16_t*)(ws + WS_MIXED), *XG = (bf16_t*)(ws + WS_XG), *HID = (bf16_t*)(ws + WS_HID);
    float *H1 = (float*)(ws + WS_H1), *H2 = (float*)(ws + WS_H2), *S0 = (float*)(ws + WS_S0), *Y = (float*)(ws + WS_Y), *BONUS = (float*)(ws + WS_BONUS), *QKraw = (float*)(ws + WS_QKRAW),
          *Sraw = (float*)(ws + WS_SRAW), *YC = (float*)(ws + WS_YC), *GU = (float*)(ws + WS_GU);
    int* asg_e = (int*)(ws + WS_ASG); int* asg_r = asg_e + 2 * SEQ; float* asg_w = (float*)(asg_r + 2 * SEQ);
    hipMemsetAsync(ctl, 0, 4096, st);
    hipLaunchKernelGGL(k_transpose, dim3(RWKV_COLS / 32, DM / 32, 1), dim3(256), 0, st, w_in, DM, IN_COLS, WinT, 0, 0, (size_t)0, 0);
    hipLaunchKernelGGL(k_transpose, dim3(2 * QK_COLS / 32, DM / 32, 1), dim3(256), 0, st, w_in + RWKV_COLS, DM, IN_COLS, WinT + (size_t)RWKV_COLS * DM, 1, 0, (size_t)0, 0);
    hipLaunchKernelGGL(k_transpose, dim3(1024 / 32, DM / 32, 1), dim3(256), 0, st, w_in + RWKV_COLS + 2 * QK_COLS, DM, IN_COLS, WinT + (size_t)(RWKV_COLS + 2 * QK_COLS) * DM, 0, 0, (size_t)0, 0);
    hipLaunchKernelGGL(k_transpose, dim3(DM / 32, DM / 32, 1), dim3(256), 0, st, w_out, DM, DM, WoutT, 0, 0, (size_t)0, 0);
    hipLaunchKernelGGL(k_transpose, dim3(DM / 32, DM / 32, 1), dim3(256), 0, st, wk, DM, DM, WkvT, 0, 0, (size_t)0, 0);
    hipLaunchKernelGGL(k_transpose, dim3(DM / 32, DM / 32, 1), dim3(256), 0, st, wv, DM, DM, WkvT + (size_t)DM * DM, 0, 0, (size_t)0, 0);
    hipLaunchKernelGGL(k_transpose, dim3(DM / 32, DM / 32, 1), dim3(256), 0, st, wo, DM, DM, WoT, 0, 0, (size_t)0, 0);
    hipLaunchKernelGGL(k_convert, dim3(DM * DM / 256), dim3(256), 0, st, wq, WqB, (size_t)DM * DM);
    hipLaunchKernelGGL(k_transpose, dim3(D_EXP / 32, DM / 32, N_EXP), dim3(256), 0, st, eg, DM, D_EXP, WguT, 2, 0, (size_t)DM * D_EXP, 2048);
    hipLaunchKernelGGL(k_transpose, dim3(D_EXP / 32, DM / 32, N_EXP), dim3(256), 0, st, eu, DM, D_EXP, WguT, 3, 0, (size_t)DM * D_EXP, 2048);
    hipLaunchKernelGGL(k_transpose, dim3(DM / 32, D_EXP / 32, N_EXP), dim3(256), 0, st, ed, D_EXP, DM, WdT, 0, 0, (size_t)DM * D_EXP, 2048);
    hipLaunchKernelGGL(k_rope_table, dim3(SEQ * 32 / 256), dim3(256), 0, st, positions, rope);
    hipLaunchKernelGGL(k_rmsnorm_bf16, dim3(SEQ), dim3(256), 0, st, x, mix_norm, XN);
    hipLaunchKernelGGL(k_rmsnorm_bf16, dim3(MEM_LEN), dim3(256), 0, st, mem, mem_kv_norm, MEMN);
    gemm(st, XN, DM, WinT, DM, SEQ, IN_COLS, DM, EpiInProj{PR, QKraw, Vb});
    hipLaunchKernelGGL(k_rope_apply, dim3(SEQ), dim3(256), 0, st, QKraw, rope, Qb, Kb);
    PrepW P{F(5), F(6), F(7), F(8), F(9), F(10), F(11), F(12), F(13)};
    hipLaunchKernelGGL(k_prep, dim3(SEQ), dim3(256), 0, st, PR, P, S0, BONUS);
    hipLaunchKernelGGL(k_scan, dim3(256), dim3(256), 0, st, S0, Y);
    hipLaunchKernelGGL(k_rwkv_post, dim3(SEQ), dim3(256), 0, st, Y, S0, BONUS, F(14), F(15), MIXED);
    hipLaunchKernelGGL(k_attn, dim3(SEQ / 64, 16, 4), dim3(64), 0, st, Qb, Kb, Vb, O2);
    hipLaunchKernelGGL(k_diff_post, dim3(SEQ), dim3(256), 0, st, O2, F(16), F(17), MIXED);
    gemm(st, MIXED, DM, WoutT, DM, SEQ, DM, DM, EpiResid{x, H1, DM});
    gemm(st, MEMN, DM, WkvT, DM, MEM_LEN, 2 * DM, DM, EpiBf{KV, 2 * DM});
    for (int h = 0; h < MEM_HEADS; ++h) {
        gemm(st, KV + h * MEM_HD, 2 * DM, WqB + h * MEM_HD, DM, MEM_LEN, DM, MEM_HD, EpiBf{BtS + (size_t)h * MEM_LEN * DM, DM});
        gemm(st, WoT + h * MEM_HD, DM, KV + DM + h * MEM_HD, 2 * DM, DM, MEM_LEN, MEM_HD, EpiBf{BtO + h * MEM_LEN, MEM_HEADS * MEM_LEN});
    }
    hipLaunchKernelGGL(k_rmsnorm_bf16, dim3(SEQ), dim3(256), 0, st, H1, mem_q_norm, HN1);
    gemm(st, HN1, DM, BtS, DM, SEQ, MEM_HEADS * MEM_LEN, DM, EpiF32{Sraw, MEM_HEADS * MEM_LEN});
    hipLaunchKernelGGL(k_softmax_mem, dim3(SEQ), dim3(256), 0, st, Sraw, Pm);
    gemm(st, Pm, MEM_HEADS * MEM_LEN, BtO, MEM_HEADS * MEM_LEN, SEQ, DM, MEM_HEADS * MEM_LEN, EpiResid{H1, H2, DM});
    hipLaunchKernelGGL(k_router, dim3(SEQ), dim3(256), 0, st, H2, moe_norm, rgw, rgb, rew, reb, XH, ctl, asg_e, asg_r, asg_w);
    hipLaunchKernelGGL(k_moe_offsets, dim3(1), dim3(64), 0, st, ctl);
    hipLaunchKernelGGL(k_gather, dim3(SEQ), dim3(256), 0, st, XH, ctl, asg_e, asg_r, XG);
    gemm(st, XG, DM, WguT, DM, XG_ROWS, 2048, DM, EpiF32{GU, 2048}, ctl, 2048);
    hipLaunchKernelGGL(k_silu_mul, dim3(XG_ROWS * 1024 / 256), dim3(256), 0, st, GU, ctl, HID);
    gemm(st, HID, D_EXP, WdT, D_EXP, XG_ROWS, DM, D_EXP, EpiF32{YC, DM}, ctl, 2048);
    hipLaunchKernelGGL(k_final, dim3(SEQ), dim3(256), 0, st, H2, YC, ctl, asg_e, asg_r, asg_w, final_norm, (float*)d_out);
}
```

```cpp
#include <hip/hip_runtime.h>
#include <stdint.h>
#include <stdio.h>
#include <math.h>

typedef unsigned short bf16_t;
typedef float f32x4 __attribute__((ext_vector_type(4)));
typedef unsigned u32x4 __attribute__((ext_vector_type(4)));

#ifndef MK_NAIVE_MASK
#define MK_NAIVE_MASK 0
#endif
#ifndef MK_PROBE
#define MK_PROBE -1
#endif
#ifndef MK_PROBE_REPS
#define MK_PROBE_REPS 4
#endif

constexpr int SEQ = 8192, DM = 2048, RW = 1024, NH_R = 16, HD_R = 64;
constexpr int RWKV_COLS = 3328, IN_COLS = 6400, QK_COLS = 1024;
constexpr int MEM_LEN = 256, MEM_HEADS = 4, MEM_HD = 512;
constexpr int N_GROUPS = 8, EPG = 8, N_EXP = 64, D_EXP = 1024;
constexpr int XG_ROWS = 32768;
constexpr float NORM_EPS = 1e-6f, LNX_EPS = 64e-5f, SUBLN_EPS = 1e-5f;
constexpr float LAMBDA_INIT = 0.2f;
constexpr float C2 = 0.125f * 1.4426950408889634f;

constexpr size_t MiB = 1u << 20;
constexpr size_t WS_CTL = 0, WS_ROPE = 1 * MiB, WS_WINT = 4 * MiB, WS_WOUTT = 29 * MiB, WS_WKVT = 37 * MiB, WS_WQBH = 53 * MiB, WS_WOTH = 61 * MiB,
                 WS_BTS = 69 * MiB, WS_BTO = 73 * MiB, WS_MEMN = 77 * MiB, WS_KVH = 78 * MiB, WS_ASG = 80 * MiB, WS_BONUS = 81 * MiB,
                 WS_WGUT = 96 * MiB, WS_WDT = 608 * MiB, WS_H1 = 864 * MiB, WS_HN1 = 928 * MiB, WS_PM = 960 * MiB, WS_H2 = 976 * MiB, WS_XH = 1040 * MiB,
                 WS_XN = 1072 * MiB, WS_PR = 1104 * MiB, WS_QB = 1156 * MiB, WS_KB = 1172 * MiB, WS_VB = 1188 * MiB, WS_S0 = 1204 * MiB  ,
                 WS_Y = 1428 * MiB, WS_O2 = 1460 * MiB, WS_MIXED = 1492 * MiB, WS_END = 1524 * MiB;
constexpr size_t WS_XL = WS_S0, WS_WLORA = WS_S0 + 4 * MiB, WS_LG = WS_S0 + 6 * MiB, WS_RPP = WS_S0 + 54 * MiB, WS_YG = WS_S0 + 70 * MiB, WS_PT = WS_S0 + 102 * MiB, WS_QT = WS_S0 + 118 * MiB,
                 WS_SC = WS_S0 + 150 * MiB, WS_EG = WS_S0 + 166 * MiB, WS_EBV = WS_S0 + 182 * MiB;
constexpr size_t WS_PSQ = 84 * MiB;
constexpr size_t WS_RT = 82 * MiB, WS_RS = 83 * MiB;
constexpr size_t WS_QKRAW = WS_H2, WS_SRAW = WS_XH;
#if MK_PROBE >= 0
constexpr size_t WS_XG = 1524 * MiB, WS_HID = 1652 * MiB, WS_YC = 1716 * MiB, WS_GU = WS_YC, WS_NEED = 1972 * MiB;
#else
constexpr size_t WS_XG = 1072 * MiB, WS_HID = 1200 * MiB, WS_YC = 1264 * MiB, WS_GU = WS_YC, WS_NEED = WS_END;
#endif
constexpr size_t CTL_ZERO_BYTES = 1 * MiB;
constexpr int CW_CNT = 0, CW_BASE = 64, CW_NT = 160, CW_TILEE = 192;
constexpr int CW_TMO = 512, CW_CODE = 513;
constexpr int CW_AQ = 1024;
constexpr int CW_BAR = 4096;

__device__ __forceinline__ float bf2f(bf16_t b) { return __uint_as_float((unsigned)b << 16); }
__device__ __forceinline__ bf16_t f2bf(float f) { unsigned u = __float_as_uint(f); return (bf16_t)((u + 0x7fffu + ((u >> 16) & 1u)) >> 16); }
__device__ __forceinline__ float sigmoidf_(float x) { return 1.f / (1.f + __expf(-x)); }
__host__ __device__ __forceinline__ int rope_phys(int d) { return d < 32 ? 8 * (d >> 2) + (d & 3) : 8 * ((d - 32) >> 2) + 4 + ((d - 32) & 3); }
__host__ __device__ __forceinline__ int row_map(int mode, int n) {
    return mode == 1 ? (n & ~63) + rope_phys(n & 63) : mode == 2 ? (n >> 7) * 256 + (n & 127) : mode == 3 ? (n >> 7) * 256 + 128 + (n & 127) : n; }

namespace pg8 {
#define PG8_LAS __attribute__((address_space(3)))
typedef unsigned short bf16_t;
typedef short bf16x8 __attribute__((ext_vector_type(8)));
typedef float f32x4 __attribute__((ext_vector_type(4)));
typedef unsigned u32x4 __attribute__((ext_vector_type(4)));
constexpr int BM = 256, BK = 64, HALF = 128, HTB = HALF * BK * 2  , STAGE_BYTES = 8 * HTB, NXCD = 8, WGM = 8;

__host__ __device__ __forceinline__ int lds_byte(int r, int c) { const int st = (r >> 4) * 2 + (c >> 5), rr = r & 15, cc = c & 31, ob = rr * 64 + cc * 2; return st * 1024 + (ob ^ (((ob >> 9) & 1) << 5)); }
__host__ __device__ __forceinline__ void stage_rc(int b, int& R, int& C) { const int st = b / 1024, sb = b % 1024, swz = sb ^ (((sb >> 9) & 1) << 5); R = (st >> 1) * 16 + swz / 64; C = (st & 1) * 32 + (swz % 64) / 2; }
__host__ __device__ __forceinline__ int perm32(int rho) { const int n = rho >> 4, i = rho & 15; return 8 * (i >> 2) + 4 * n + (i & 3); }

struct Unit { int pm, pn; };
struct Gemm { const bf16_t* A; const bf16_t* Bt; int M, N, K, lda, ldb; };

struct StaticOrder {
    int nM, nN, nwg, G, c;
    __host__ __device__ void init(int M, int N, int G_, int c_) { nM = M / BM; nN = N / BM; nwg = nM * nN; G = G_; c = c_; }
    __host__ __device__ bool next(int i, Unit& u) const {
        const long L = (long)i * G + c; if (L >= nwg) return false;
        int wgid = (int)L; { const int q = nwg / NXCD, r = nwg % NXCD, xcd = wgid % NXCD, off = wgid / NXCD; wgid = (xcd < r ? xcd * (q + 1) : r * (q + 1) + (xcd - r) * q) + off; }
        const int nig = WGM * nN, gid = wgid / nig, fm = gid * WGM, gsz = (nM - fm) < WGM ? (nM - fm) : WGM;
        u.pm = fm + ((wgid % nig) % gsz); u.pn = (wgid % nig) / gsz; return true;
    }
    __device__ __forceinline__ void a_ready(const Unit&) const {}
    __device__ __forceinline__ void done(const Unit&) const {}
};
__device__ __forceinline__ unsigned cvt_pk_bf16(float lo, float hi) { unsigned r; asm volatile("v_cvt_pk_bf16_f32 %0, %1, %2" : "=v"(r) : "v"(lo), "v"(hi)); return r; }
template <class Epi, class Sched, bool ALIGN_EPI = false, bool SP2 = false>
__device__ __forceinline__ void gemm_phase(PG8_LAS unsigned char* lds, const Gemm g, const Sched& S, const Epi& E) {
    const int tid = threadIdx.x, wid = __builtin_amdgcn_readfirstlane(tid >> 6), lane = tid & 63, wr = wid >> 2, wc = wid & 3, fr = lane & 15, fq = lane >> 4;
    const int K = g.K, nt = K / BK;
    unsigned voffA[2], voffB[2];
#pragma unroll
    for (int i = 0; i < 2; ++i) { int R, C; stage_rc(tid * 16 + i * 8192, R, C); const int Rb = Epi::PERM ? ((R & ~31) + perm32(R & 31)) : R;
        voffA[i] = (unsigned)(R * g.lda + C) * 2u; voffB[i] = (unsigned)(Rb * g.ldb + C) * 2u; }
    const size_t kstep = (size_t)(BK * 2);
    const size_t hstepA = (size_t)HALF * g.lda * 2, hstepB = (size_t)HALF * g.ldb * 2;
    const size_t tstepA = 2 * hstepA, tstepB = 2 * hstepB;
    const unsigned ldsw = (unsigned)wid * 1024u;
    const int aoff = lds_byte(wr * 64 + fr, fq * 8), boff = lds_byte(wc * 32 + fr, fq * 8);
#define PG8_SA(b, h) (((b) * 2 + (h)) * HTB)
#define PG8_SB(b, h) ((4 + (b) * 2 + (h)) * HTB)
#define PG8_STAGE(bufoff, gbase, voff) do { _Pragma("unroll") for (int _i = 0; _i < 2; ++_i) \
        __builtin_amdgcn_global_load_lds((const unsigned*)((const char*)(gbase) + (voff)[_i]), (PG8_LAS unsigned*)(lds + (bufoff) + ldsw + _i * 8192), 16, 0, 0); } while (0)
#define PG8_LDA(dst, b, h) do { _Pragma("unroll") for (int m = 0; m < 4; ++m) _Pragma("unroll") for (int k = 0; k < 2; ++k) dst[m][k] = *(const PG8_LAS bf16x8*)(lds + PG8_SA(b, h) + aoff + m * 2048 + k * 1024); } while (0)
#define PG8_LDB(dst, b, h) do { _Pragma("unroll") for (int n = 0; n < 2; ++n) _Pragma("unroll") for (int k = 0; k < 2; ++k) dst[n][k] = *(const PG8_LAS bf16x8*)(lds + PG8_SB(b, h) + boff + n * 2048 + k * 1024); } while (0)
#define PG8_MMA(ai, bj, At, Bt) do { __builtin_amdgcn_s_setprio(1); _Pragma("unroll") for (int m = 0; m < 4; ++m) _Pragma("unroll") for (int n = 0; n < 2; ++n) _Pragma("unroll") for (int k = 0; k < 2; ++k) \
        acc[ai][bj][m][n] = __builtin_amdgcn_mfma_f32_16x16x32_bf16(Bt[n][k], At[m][k], acc[ai][bj][m][n], 0, 0, 0); __builtin_amdgcn_s_setprio(0); } while (0)
#define PG8_WAIT_V(n) asm volatile("s_waitcnt vmcnt(" #n ")" ::: "memory")
#define PG8_WAIT_L(n) asm volatile("s_waitcnt lgkmcnt(" #n ")" ::: "memory")
#define PG8_BAR __builtin_amdgcn_s_barrier()
#define PG8_SCHED __builtin_amdgcn_sched_barrier(0)
    Unit cur, nxt; int ui = 0;
    if (!S.next(0, cur)) return;
    f32x4 acc[2][2][4][2];
#pragma unroll
    for (int a = 0; a < 2; ++a)
#pragma unroll
        for (int b = 0; b < 2; ++b)
#pragma unroll
            for (int m = 0; m < 4; ++m)
#pragma unroll
                for (int n = 0; n < 2; ++n) acc[a][b][m][n] = (f32x4){0.f, 0.f, 0.f, 0.f};
    bf16x8 At[4][2], B0[2][2], B1[2][2];
    const char* cA = (const char*)g.A + (size_t)cur.pm * tstepA; const char* cB = (const char*)g.Bt + (size_t)cur.pn * tstepB;
    S.a_ready(cur);
    if constexpr (SP2) {
        PG8_STAGE(PG8_SB(0, 0), cB, voffB); PG8_STAGE(PG8_SB(0, 1), cB + hstepB, voffB); PG8_STAGE(PG8_SA(0, 0), cA, voffA); PG8_STAGE(PG8_SA(0, 1), cA + hstepA, voffA);
        if (wr == 1) PG8_BAR;
        PG8_WAIT_V(2); PG8_BAR;
        PG8_STAGE(PG8_SB(1, 0), cB + kstep, voffB); PG8_STAGE(PG8_SA(1, 0), cA + kstep, voffA); PG8_STAGE(PG8_SB(1, 1), cB + hstepB + kstep, voffB);
        PG8_WAIT_V(6); PG8_BAR;
    } else {
        PG8_STAGE(PG8_SB(0, 0), cB, voffB); PG8_STAGE(PG8_SA(0, 0), cA, voffA); PG8_STAGE(PG8_SB(0, 1), cB + hstepB, voffB); PG8_STAGE(PG8_SA(0, 1), cA + hstepA, voffA);
        if (wr == 1) PG8_BAR;
        PG8_WAIT_V(4); PG8_BAR;
        PG8_STAGE(PG8_SB(1, 0), cB + kstep, voffB); PG8_STAGE(PG8_SA(1, 0), cA + kstep, voffA); PG8_STAGE(PG8_SB(1, 1), cB + hstepB + kstep, voffB);
        PG8_WAIT_V(6); PG8_BAR;
    }
    for (;;) {
        const bool has_next = S.next(ui + 1, nxt);
        const char* nA = has_next ? (const char*)g.A + (size_t)nxt.pm * tstepA : cA; const char* nB = has_next ? (const char*)g.Bt + (size_t)nxt.pn * tstepB : cB;
        for (int t = 0; t < nt; t += 2) {
            const bool last = (t == nt - 2);
            const char* a1 = cA + (size_t)(t + 1) * kstep;
            const char* a2 = last ? nA : cA + (size_t)(t + 2) * kstep; const char* b2 = last ? nB : cB + (size_t)(t + 2) * kstep;
            const char* a3 = a2 + kstep; const char* b3 = b2 + kstep;
            if (last && has_next) S.a_ready(nxt);
            if constexpr (SP2) {
            PG8_LDB(B0, 0, 0); PG8_LDB(B1, 0, 1); PG8_SCHED; PG8_LDA(At, 0, 0); PG8_STAGE(PG8_SA(1, 1), a1 + hstepA, voffA);
            PG8_WAIT_V(8); PG8_WAIT_L(0); PG8_BAR; PG8_MMA(0, 0, At, B0); PG8_MMA(0, 1, At, B1); PG8_BAR; PG8_SCHED;
            PG8_LDA(At, 0, 1); PG8_STAGE(PG8_SB(0, 0), b2, voffB); PG8_STAGE(PG8_SB(0, 1), b2 + hstepB, voffB); PG8_STAGE(PG8_SA(0, 0), a2, voffA);
            PG8_WAIT_V(8); PG8_WAIT_L(0); PG8_BAR; PG8_MMA(1, 0, At, B0); PG8_MMA(1, 1, At, B1); PG8_BAR; PG8_SCHED;
            PG8_LDB(B0, 1, 0); PG8_LDB(B1, 1, 1); PG8_SCHED; PG8_LDA(At, 1, 0); PG8_STAGE(PG8_SA(0, 1), a2 + hstepA, voffA);
            PG8_WAIT_V(8); PG8_WAIT_L(0); PG8_BAR; PG8_MMA(0, 0, At, B0); PG8_MMA(0, 1, At, B1); PG8_BAR; PG8_SCHED;
            PG8_LDA(At, 1, 1); PG8_STAGE(PG8_SB(1, 0), b3, voffB); PG8_STAGE(PG8_SB(1, 1), b3 + hstepB, voffB); PG8_STAGE(PG8_SA(1, 0), a3, voffA);
            PG8_WAIT_V(8); PG8_WAIT_L(0); PG8_BAR; PG8_MMA(1, 0, At, B0); PG8_MMA(1, 1, At, B1); PG8_BAR; PG8_SCHED;
            } else {
            PG8_LDB(B0, 0, 0); PG8_SCHED; PG8_LDA(At, 0, 0); PG8_STAGE(PG8_SA(1, 1), a1 + hstepA, voffA);
            PG8_WAIT_L(8); PG8_BAR; PG8_WAIT_L(0); PG8_MMA(0, 0, At, B0); PG8_BAR; PG8_SCHED;
            PG8_LDB(B1, 0, 1); PG8_STAGE(PG8_SB(0, 0), b2, voffB);
            PG8_BAR; PG8_WAIT_L(0); PG8_MMA(0, 1, At, B1); PG8_BAR;
            PG8_LDA(At, 0, 1); PG8_STAGE(PG8_SA(0, 0), a2, voffA);
            PG8_BAR; PG8_WAIT_L(0); PG8_MMA(1, 0, At, B0); PG8_BAR; PG8_SCHED;
            PG8_STAGE(PG8_SB(0, 1), b2 + hstepB, voffB);
            PG8_WAIT_V(6); PG8_BAR; PG8_MMA(1, 1, At, B1); PG8_BAR;
            PG8_LDB(B0, 1, 0); PG8_SCHED; PG8_LDA(At, 1, 0); PG8_STAGE(PG8_SA(0, 1), a2 + hstepA, voffA);
            PG8_WAIT_L(8); PG8_BAR; PG8_WAIT_L(0); PG8_MMA(0, 0, At, B0); PG8_BAR; PG8_SCHED;
            PG8_LDB(B1, 1, 1); PG8_STAGE(PG8_SB(1, 0), b3, voffB);
            PG8_BAR; PG8_WAIT_L(0); PG8_MMA(0, 1, At, B1); PG8_BAR;
            PG8_LDA(At, 1, 1); PG8_STAGE(PG8_SA(1, 0), a3, voffA);
            PG8_BAR; PG8_WAIT_L(0); PG8_MMA(1, 0, At, B0); PG8_BAR; PG8_SCHED;
            PG8_STAGE(PG8_SB(1, 1), b3 + hstepB, voffB);
            PG8_WAIT_V(6); PG8_BAR; PG8_MMA(1, 1, At, B1); PG8_BAR;
            }
        }
        if constexpr (ALIGN_EPI) { if (wr == 0) PG8_BAR; }
        if constexpr (!Epi::AFTER_DRAIN) { E(acc, cur, wr, wc, fr, fq); S.done(cur); }
        if (!has_next) break;
#pragma unroll
        for (int a = 0; a < 2; ++a)
#pragma unroll
            for (int b = 0; b < 2; ++b)
#pragma unroll
                for (int m = 0; m < 4; ++m)
#pragma unroll
                    for (int n = 0; n < 2; ++n) acc[a][b][m][n] = (f32x4){0.f, 0.f, 0.f, 0.f};
        cur = nxt; cA = nA; cB = nB; ++ui;
        if constexpr (ALIGN_EPI) { if (wr == 1) PG8_BAR; }
    }
    PG8_WAIT_V(0);
    if constexpr (!ALIGN_EPI) { if (wr == 0) PG8_BAR; }
    PG8_BAR;
    if constexpr (Epi::AFTER_DRAIN) { E.fused(acc, cur, wr, wc, fr, fq, lds, wid, lane); S.done(cur); }
#undef PG8_SA
#undef PG8_SB
#undef PG8_STAGE
#undef PG8_LDA
#undef PG8_LDB
#undef PG8_MMA
#undef PG8_WAIT_V
#undef PG8_WAIT_L
#undef PG8_BAR
#undef PG8_SCHED
}
}
namespace pg8 {
__device__ __forceinline__ u32x4 pack8(const f32x4 v0, const f32x4 v1) { u32x4 w; w.x = cvt_pk_bf16(v0[0], v0[1]); w.y = cvt_pk_bf16(v0[2], v0[3]); w.z = cvt_pk_bf16(v1[0], v1[1]); w.w = cvt_pk_bf16(v1[2], v1[3]); return w; }
struct EpiInProj {
    static constexpr bool PERM = true, AFTER_DRAIN = false;
    bf16_t *PR, *Qb, *Kb, *Vb; const float* rope;
    __device__ __forceinline__ void operator()(const f32x4 (&acc)[2][2][4][2], const Unit& u, int wr, int wc, int fr, int fq) const {
        const int row0 = u.pm * BM + wr * 64 + fr, cl = wc * 32 + 8 * fq;
        if (u.pn < 13 || u.pn >= 21) {
            bf16_t* base; int ldc, colt;
            if (u.pn < 13) { base = PR; ldc = RWKV_COLS; colt = u.pn * 256; } else { base = Vb; ldc = 1024; colt = (u.pn - 21) * 256; }
#pragma unroll
            for (int ai = 0; ai < 2; ++ai)
#pragma unroll
                for (int m = 0; m < 4; ++m) { bf16_t* rowp = base + (size_t)(row0 + ai * HALF + m * 16) * ldc + colt + cl;
#pragma unroll
                    for (int bj = 0; bj < 2; ++bj) *(u32x4*)(rowp + bj * HALF) = pack8(acc[ai][bj][m][0], acc[ai][bj][m][1]); }
        } else {
            const bool isq = u.pn < 17; bf16_t* base = isq ? Qb : Kb; const int colt = (u.pn - (isq ? 13 : 17)) * 256; const float sc = isq ? C2 : 1.f;
            const int j0 = 16 * (wc & 1) + 4 * fq;
#pragma unroll
            for (int ai = 0; ai < 2; ++ai)
#pragma unroll
                for (int m = 0; m < 4; ++m) { const int row = row0 + ai * HALF + m * 16;
                    const f32x4 t0 = *(const f32x4*)(rope + ((size_t)row * 32 + j0) * 2), t1 = *(const f32x4*)(rope + ((size_t)row * 32 + j0) * 2 + 4);
                    const f32x4 cs = {t0[0], t0[2], t1[0], t1[2]}, sn = {t0[1], t0[3], t1[1], t1[3]};
                    bf16_t* rowp = base + (size_t)row * 1024 + colt + cl;
#pragma unroll
                    for (int bj = 0; bj < 2; ++bj) { const f32x4 x1 = acc[ai][bj][m][0], x2 = acc[ai][bj][m][1];
                        const f32x4 lo = (x1 * cs - x2 * sn) * sc, hi = (x1 * sn + x2 * cs) * sc;
                        *(u32x4*)(rowp + bj * HALF) = pack8(lo, hi); } }
        }
    }
};
struct EpiKV {
    static constexpr bool PERM = true, AFTER_DRAIN = false;
    bf16_t* KVh;
    __device__ __forceinline__ void operator()(const f32x4 (&acc)[2][2][4][2], const Unit& u, int wr, int wc, int fr, int fq) const {
        bf16_t* base = KVh + (size_t)(u.pn >> 1) * (MEM_LEN * MEM_HD) + (u.pn & 1) * 256 + wc * 32 + 8 * fq;
#pragma unroll
        for (int ai = 0; ai < 2; ++ai)
#pragma unroll
            for (int m = 0; m < 4; ++m) { bf16_t* rowp = base + (size_t)(wr * 64 + fr + ai * HALF + m * 16) * MEM_HD;
#pragma unroll
                for (int bj = 0; bj < 2; ++bj) *(u32x4*)(rowp + bj * HALF) = pack8(acc[ai][bj][m][0], acc[ai][bj][m][1]); }
    }
};
struct EpiBfGen {
    static constexpr bool PERM = true, AFTER_DRAIN = false;
    bf16_t* C; int ldc, pm_mask, pn_mask, pn_sub;
    __device__ __forceinline__ void operator()(const f32x4 (&acc)[2][2][4][2], const Unit& u, int wr, int wc, int fr, int fq) const {
        bf16_t* base = C + (size_t)((u.pm & pm_mask) * BM + wr * 64 + fr) * ldc + ((u.pn - pn_sub) & pn_mask) * BM + wc * 32 + 8 * fq;
#pragma unroll
        for (int ai = 0; ai < 2; ++ai)
#pragma unroll
            for (int m = 0; m < 4; ++m) { bf16_t* rowp = base + (size_t)(ai * HALF + m * 16) * ldc;
#pragma unroll
                for (int bj = 0; bj < 2; ++bj) *(u32x4*)(rowp + bj * HALF) = pack8(acc[ai][bj][m][0], acc[ai][bj][m][1]); }
    }
};
struct EpiBfGenCS {
    static constexpr bool PERM = true, AFTER_DRAIN = false;
    bf16_t* C; int ldc, pm_mask, pn_mask, pn_sub; const float* cs;
    __device__ __forceinline__ void operator()(const f32x4 (&acc)[2][2][4][2], const Unit& u, int wr, int wc, int fr, int fq) const {
        const int colb = ((u.pn - pn_sub) & pn_mask) * BM + wc * 32 + 8 * fq;
        bf16_t* base = C + (size_t)((u.pm & pm_mask) * BM + wr * 64 + fr) * ldc + colb;
        const f32x4 sa0 = *(const f32x4*)(cs + colb), sa1 = *(const f32x4*)(cs + colb + 4), sb0 = *(const f32x4*)(cs + colb + HALF), sb1 = *(const f32x4*)(cs + colb + HALF + 4);
#pragma unroll
        for (int ai = 0; ai < 2; ++ai)
#pragma unroll
            for (int m = 0; m < 4; ++m) { bf16_t* rowp = base + (size_t)(ai * HALF + m * 16) * ldc;
                *(u32x4*)(rowp) = pack8(acc[ai][0][m][0] * sa0, acc[ai][0][m][1] * sa1); *(u32x4*)(rowp + HALF) = pack8(acc[ai][1][m][0] * sb0, acc[ai][1][m][1] * sb1); }
    }
};
struct EpiResid {
    static constexpr bool PERM = false, AFTER_DRAIN = false;
    const float* base; float* out;
    __device__ __forceinline__ void operator()(const f32x4 (&acc)[2][2][4][2], const Unit& u, int wr, int wc, int fr, int fq) const {
        const int row0 = u.pm * BM + wr * 64 + fr, col0 = u.pn * BM + wc * 32 + 4 * fq;
#pragma unroll
        for (int ai = 0; ai < 2; ++ai)
#pragma unroll
            for (int m = 0; m < 4; ++m) { const size_t off = (size_t)(row0 + ai * HALF + m * 16) * DM + col0;
#pragma unroll
                for (int bj = 0; bj < 2; ++bj)
#pragma unroll
                    for (int n = 0; n < 2; ++n) *(f32x4*)(out + off + bj * HALF + n * 16) = *(const f32x4*)(base + off + bj * HALF + n * 16) + acc[ai][bj][m][n]; }
    }
};
struct EpiResidSq {
    static constexpr bool PERM = true, AFTER_DRAIN = false;
    const float* base; float* out; bf16_t* outb; float* psq;
    __device__ __forceinline__ void operator()(const f32x4 (&acc)[2][2][4][2], const Unit& u, int wr, int wc, int fr, int fq) const {
        const int row0 = u.pm * BM + wr * 64 + fr, col0 = u.pn * BM + wc * 32 + 8 * fq;
#pragma unroll
        for (int ai = 0; ai < 2; ++ai)
#pragma unroll
            for (int m = 0; m < 4; ++m) { const int row = row0 + ai * HALF + m * 16; const size_t off = (size_t)row * DM + col0; float s = 0.f;
#pragma unroll
                for (int bj = 0; bj < 2; ++bj) { const f32x4 v0 = *(const f32x4*)(base + off + bj * HALF) + acc[ai][bj][m][0], v1 = *(const f32x4*)(base + off + bj * HALF + 4) + acc[ai][bj][m][1];
                    *(f32x4*)(out + off + bj * HALF) = v0; *(f32x4*)(out + off + bj * HALF + 4) = v1; *(u32x4*)(outb + off + bj * HALF) = pack8(v0, v1);
                    s += ((v0[0] * v0[0] + v0[1] * v0[1]) + (v0[2] * v0[2] + v0[3] * v0[3])) + ((v1[0] * v1[0] + v1[1] * v1[1]) + (v1[2] * v1[2] + v1[3] * v1[3])); }
                s += __shfl_xor(s, 16); s += __shfl_xor(s, 32);
                if (fq == 0) psq[(size_t)row * 32 + u.pn * 4 + wc] = s; }
    }
};
struct EpiSoftmax {
    static constexpr bool PERM = true, AFTER_DRAIN = true;
    bf16_t* P; float scale_log2e;
    __device__ __forceinline__ void fused(f32x4 (&acc)[2][2][4][2], const Unit& u, int wr, int wc, int fr, int fq, PG8_LAS unsigned char* lds, int wid, int lane) const {
        PG8_LAS float* Pm = (PG8_LAS float*)lds;
        PG8_LAS float* Ps = (PG8_LAS float*)(lds + 4096);
        PG8_LAS float* Rs = (PG8_LAS float*)(lds + 8192);
        { const float* psq = (const float*)((const unsigned char*)P + ((long)WS_PSQ - (long)WS_PM));
          const int t_ = wid * 64 + lane, r_ = t_ >> 1, hf = t_ & 1; const float* pp = psq + (size_t)(u.pm * BM + r_) * 32 + hf * 16; float s = 0.f;
#pragma unroll
          for (int j = 0; j < 4; ++j) { const f32x4 v = *(const f32x4*)(pp + 4 * j); s += (v[0] + v[1]) + (v[2] + v[3]); }
          s += __shfl_xor(s, 1);
          if (!hf) Rs[r_] = rsqrtf(s * (1.f / DM) + NORM_EPS); }
#pragma unroll
        for (int ai = 0; ai < 2; ++ai)
#pragma unroll
            for (int m = 0; m < 4; ++m) { float mx = -3.0e38f;
#pragma unroll
                for (int bj = 0; bj < 2; ++bj)
#pragma unroll
                    for (int n = 0; n < 2; ++n) { acc[ai][bj][m][n] = acc[ai][bj][m][n] * scale_log2e; const f32x4 x = acc[ai][bj][m][n]; mx = fmaxf(mx, fmaxf(fmaxf(x[0], x[1]), fmaxf(x[2], x[3]))); }
                mx = fmaxf(mx, __shfl_xor(mx, 16)); mx = fmaxf(mx, __shfl_xor(mx, 32));
                if (fq == 0) Pm[(ai * HALF + wr * 64 + m * 16 + fr) * 4 + wc] = mx; }
        asm volatile("s_waitcnt lgkmcnt(0)" ::: "memory"); __builtin_amdgcn_s_barrier(); asm volatile("" ::: "memory");
#pragma unroll
        for (int ai = 0; ai < 2; ++ai)
#pragma unroll
            for (int m = 0; m < 4; ++m) { const int r = ai * HALF + wr * 64 + m * 16 + fr; const f32x4 pm4 = *(const PG8_LAS f32x4*)(Pm + r * 4);
                const float mx = fmaxf(fmaxf(pm4[0], pm4[1]), fmaxf(pm4[2], pm4[3])), rsr = Rs[r]; float s = 0.f;
#pragma unroll
                for (int bj = 0; bj < 2; ++bj)
#pragma unroll
                    for (int n = 0; n < 2; ++n) { f32x4 x = acc[ai][bj][m][n];
#pragma unroll
                        for (int i = 0; i < 4; ++i) x[i] = __builtin_amdgcn_exp2f((x[i] - mx) * rsr);
                        acc[ai][bj][m][n] = x; s += (x[0] + x[1]) + (x[2] + x[3]); }
                s += __shfl_xor(s, 16); s += __shfl_xor(s, 32);
                if (fq == 0) Ps[r * 4 + wc] = s; }
        asm volatile("s_waitcnt lgkmcnt(0)" ::: "memory"); __builtin_amdgcn_s_barrier(); asm volatile("" ::: "memory");
        bf16_t* base = P + (size_t)(u.pm * BM) * 1024 + u.pn * BM + wc * 32 + 8 * fq;
#pragma unroll
        for (int ai = 0; ai < 2; ++ai)
#pragma unroll
            for (int m = 0; m < 4; ++m) { const int r = ai * HALF + wr * 64 + m * 16 + fr; const f32x4 ps4 = *(const PG8_LAS f32x4*)(Ps + r * 4);
                const float inv = 1.0f / ((ps4[0] + ps4[1]) + (ps4[2] + ps4[3]));
#pragma unroll
                for (int bj = 0; bj < 2; ++bj) *(u32x4*)(base + (size_t)r * 1024 + bj * HALF) = pack8(acc[ai][bj][m][0] * inv, acc[ai][bj][m][1] * inv); }
    }
};
struct EpiGateUp {
    static constexpr bool PERM = true, AFTER_DRAIN = false;
    bf16_t* HID;
    __device__ __forceinline__ void operator()(const f32x4 (&acc)[2][2][4][2], const Unit& u, int wr, int wc, int fr, int fq) const {
        bf16_t* base = HID + (size_t)(u.pm * BM + wr * 64 + fr) * D_EXP + (u.pn & 7) * HALF + wc * 32 + 8 * fq;
#pragma unroll
        for (int ai = 0; ai < 2; ++ai)
#pragma unroll
            for (int m = 0; m < 4; ++m) { f32x4 h[2];
#pragma unroll
                for (int n = 0; n < 2; ++n) { const f32x4 gt = acc[ai][0][m][n], up = acc[ai][1][m][n];
#pragma unroll
                    for (int i = 0; i < 4; ++i) h[n][i] = gt[i] * __builtin_amdgcn_rcpf(1.0f + __builtin_amdgcn_exp2f(-1.4426950408889634f * gt[i])) * up[i]; }
                *(u32x4*)(base + (size_t)(ai * HALF + m * 16) * D_EXP) = pack8(h[0], h[1]); }
    }
};
struct EpiYC {
    static constexpr bool PERM = false, AFTER_DRAIN = false;
    float* YC;
    __device__ __forceinline__ void operator()(const f32x4 (&acc)[2][2][4][2], const Unit& u, int wr, int wc, int fr, int fq) const {
        float* base = YC + (size_t)(u.pm * BM + wr * 64 + fr) * DM + (u.pn & 7) * BM + wc * 32 + 4 * fq;
#pragma unroll
        for (int ai = 0; ai < 2; ++ai)
#pragma unroll
            for (int m = 0; m < 4; ++m)
#pragma unroll
                for (int bj = 0; bj < 2; ++bj)
#pragma unroll
                    for (int n = 0; n < 2; ++n) *(f32x4*)(base + (size_t)(ai * HALF + m * 16) * DM + bj * HALF + n * 16) = acc[ai][bj][m][n];
    }
};
struct HeadOrderS { int G, c;
    __device__ __forceinline__ bool next(int i, Unit& u) const { const int L = i * G + c; if (L >= 32) return false; u.pm = L >> 3; u.pn = L; return true; }
    __device__ __forceinline__ void a_ready(const Unit&) const {} __device__ __forceinline__ void done(const Unit&) const {} };
struct HeadOrderO { int G, c;
    __device__ __forceinline__ bool next(int i, Unit& u) const { const int L = i * G + c; if (L >= 32) return false; u.pm = L; u.pn = 4 + (L >> 3); return true; }
    __device__ __forceinline__ void a_ready(const Unit&) const {} __device__ __forceinline__ void done(const Unit&) const {} };
struct MoeOrder { const unsigned* ctl; int G, c;
    __device__ __forceinline__ bool next(int i, Unit& u) const { const int L = i * G + c;
        const int nt = (int)__hip_atomic_load(ctl + CW_NT, __ATOMIC_RELAXED, __HIP_MEMORY_SCOPE_AGENT); if (L >= nt * 8) return false;
        u.pm = L >> 3; u.pn = (int)__hip_atomic_load(ctl + CW_TILEE + u.pm, __ATOMIC_RELAXED, __HIP_MEMORY_SCOPE_AGENT) * 8 + (L & 7); return true; }
    __device__ __forceinline__ void a_ready(const Unit&) const {} __device__ __forceinline__ void done(const Unit&) const {} };
}

#include <hip/hip_bf16.h>
#include <cmath>
namespace attn_body {
using bf16=__hip_bfloat16;
using bf16x8=__attribute__((ext_vector_type(8)))short;
using s16x4=__attribute__((ext_vector_type(4)))short;
using f32x16=__attribute__((ext_vector_type(16)))float;
using u32x4=__attribute__((ext_vector_type(4)))unsigned;
constexpr int BATCH=2,NHEAD=16,SEQ=8192,D=64,DM=NHEAD*D;
constexpr int NW=8,QBLK=32,QB=QBLK*NW,KVBLK=64,NQB=SEQ/QB;
constexpr int ATTN_PITCH=DM, ATTN_UNIT_ROWS=QB;
__device__ __forceinline__ int crow(int r,int hi){return (r&3)+8*(r>>2)+4*hi;}
#define SBAR() __builtin_amdgcn_sched_barrier(0)
__device__ __forceinline__ void cmask(f32x16&p0,f32x16&p1,int jb,int qrel,int hi){
  const float NEG=-INFINITY; int kb=64*jb+4*hi;
  #pragma unroll
  for(int r=0;r<16;++r){int kv=kb+(r&3)+8*(r>>2); if(kv>qrel)p0[r]=NEG; if(kv+32>qrel)p1[r]=NEG;}
}

constexpr int NSLOT=3, SLOTB=8192;
constexpr int LDS_K=0, LDS_V=NSLOT*SLOTB, LDS_WS=2*NSLOT*SLOTB, LDS_OST=LDS_WS+NW*64*4, LDS_BYTES=LDS_OST+NW*4096;
constexpr float C2=0.125f*1.4426950408889634f;
__device__ __forceinline__ void glds16(const void*gsrc,unsigned lds_dst){unsigned keep;
  asm volatile("s_mov_b32 %0, m0\n\ts_mov_b32 m0, %2\n\ts_nop 0\n\tglobal_load_lds_dwordx4 %1, off\n\ts_mov_b32 m0, %0":"=&s"(keep):"v"(gsrc),"s"(lds_dst):"memory");}
__device__ __forceinline__ float max3f(float a,float b,float c){float r;asm("v_max3_f32 %0, %1, %2, %3":"=v"(r):"v"(a),"v"(b),"v"(c));return r;}
__device__ __forceinline__ float max2f(float a,float b){float r;asm("v_max_f32_e32 %0, %1, %2":"=v"(r):"v"(a),"v"(b));return r;}
__device__ __forceinline__ float fadd_s(float a,float b){float r;asm("v_add_f32_e32 %0, %1, %2":"=v"(r):"v"(a),"v"(b));return r;}
__device__ __forceinline__ float fsub_s(float a,float b){float r;asm("v_sub_f32_e32 %0, %1, %2":"=v"(r):"v"(a),"v"(b));return r;}
typedef float f32x2_t __attribute__((ext_vector_type(2))); typedef __bf16 bf16x2_t __attribute__((ext_vector_type(2)));
__device__ __forceinline__ unsigned cvtpk_s(float lo,float hi){f32x2_t v={lo,hi};bf16x2_t b=__builtin_convertvector(v,bf16x2_t);return __builtin_bit_cast(unsigned,b);}
#define WAIT_BAR(N) asm volatile("s_waitcnt vmcnt(" #N ") lgkmcnt(0)\n\ts_barrier":::"memory")

__device__ __forceinline__ void qkt(f32x16&p0,f32x16&p1,const char*Kslot,const bf16x8*qr,const f32x16&negm,int r32,int hi){
  const char*kb=Kslot+hi*1024+r32*16;
  #pragma unroll
  for(int d0=0;d0<4;++d0){
    const bf16x8 b0=*reinterpret_cast<const bf16x8*>(kb+d0*2048);
    const bf16x8 b1=*reinterpret_cast<const bf16x8*>(kb+d0*2048+512);
    if(d0==0){p0=__builtin_amdgcn_mfma_f32_32x32x16_bf16(b0,qr[0],negm,0,0,0);p1=__builtin_amdgcn_mfma_f32_32x32x16_bf16(b1,qr[0],negm,0,0,0);}
    else{p0=__builtin_amdgcn_mfma_f32_32x32x16_bf16(b0,qr[d0],p0,0,0,0);p1=__builtin_amdgcn_mfma_f32_32x32x16_bf16(b1,qr[d0],p1,0,0,0);}}
}
typedef __attribute__((address_space(3))) const char* lds_cptr;
typedef short v4i16_t __attribute__((ext_vector_type(4)));
__device__ __forceinline__ void kload8(bf16x8*kf,lds_cptr kp){
  kf[0]=*(const __attribute__((address_space(3))) bf16x8*)(kp);      kf[1]=*(const __attribute__((address_space(3))) bf16x8*)(kp+512);
  kf[2]=*(const __attribute__((address_space(3))) bf16x8*)(kp+2048); kf[3]=*(const __attribute__((address_space(3))) bf16x8*)(kp+2560);
  kf[4]=*(const __attribute__((address_space(3))) bf16x8*)(kp+4096); kf[5]=*(const __attribute__((address_space(3))) bf16x8*)(kp+4608);
  kf[6]=*(const __attribute__((address_space(3))) bf16x8*)(kp+6144); kf[7]=*(const __attribute__((address_space(3))) bf16x8*)(kp+6656);
}
__device__ __forceinline__ void kload2(bf16x8*kf,lds_cptr kp,int j){ kf[2*j]=*(const __attribute__((address_space(3))) bf16x8*)(kp+j*2048); kf[2*j+1]=*(const __attribute__((address_space(3))) bf16x8*)(kp+j*2048+512); }
__device__ __forceinline__ s16x4 vtr(lds_cptr p){ return __builtin_bit_cast(s16x4,__builtin_amdgcn_ds_read_tr16_b64_v4i16((__attribute__((address_space(3))) v4i16_t*)p)); }
__device__ __forceinline__ float rowmax(const f32x16&p0,const f32x16&p1){
  float a=max3f(p0[0],p0[1],p1[0]),b=max3f(p0[2],p0[3],p1[1]);a=max3f(a,p1[2],p1[3]);
  #pragma unroll
  for(int r=4;r<16;r+=4){a=max3f(a,p0[r],p0[r+1]);b=max3f(b,p0[r+2],p0[r+3]);a=max3f(a,p1[r],p1[r+1]);b=max3f(b,p1[r+2],p1[r+3]);}
  const float m=max2f(a,b);
  auto rr=__builtin_amdgcn_permlane32_swap(__float_as_uint(m),__float_as_uint(m),false,false);
  return max2f(__uint_as_float(rr[0]),__uint_as_float(rr[1]));
}
__device__ __forceinline__ void pv(f32x16*o,int vb,bf16x8 pa0,bf16x8 pa1,bf16x8 pa2,bf16x8 pa3){
  #pragma unroll
  for(int d0=0;d0<2;++d0){s16x4 lo[4],hi[4];
    #pragma unroll
    for(int ks=0;ks<4;++ks){
      asm volatile("ds_read_b64_tr_b16 %0,%1 offset:%c2":"=&v"(lo[ks]):"v"(vb),"i"(d0*4096+ks*1024):"memory");
      asm volatile("ds_read_b64_tr_b16 %0,%1 offset:%c2":"=&v"(hi[ks]):"v"(vb),"i"(d0*4096+ks*1024+512):"memory");}
    asm volatile("s_waitcnt lgkmcnt(0)":::"memory");SBAR();
    #define PK(k) (bf16x8){lo[k][0],lo[k][1],lo[k][2],lo[k][3],hi[k][0],hi[k][1],hi[k][2],hi[k][3]}
    o[d0]=__builtin_amdgcn_mfma_f32_32x32x16_bf16(pa0,PK(0),o[d0],0,0,0);
    o[d0]=__builtin_amdgcn_mfma_f32_32x32x16_bf16(pa1,PK(1),o[d0],0,0,0);
    o[d0]=__builtin_amdgcn_mfma_f32_32x32x16_bf16(pa2,PK(2),o[d0],0,0,0);
    o[d0]=__builtin_amdgcn_mfma_f32_32x32x16_bf16(pa3,PK(3),o[d0],0,0,0);
    #undef PK
  }
}

#ifndef ATTN_STORE16
#define ATTN_STORE16(p,v) (*(u32x4*)(p)=(v))
#endif
template<int THRL> __device__ __forceinline__ void attn_unit(int b,int h,int qb,const bf16*Q,const bf16*__restrict__ K,const bf16*__restrict__ V,bf16*O,char*shm){
  const int tid=threadIdx.x,lane=tid&63,r32=lane&31,hi=lane>>5; const int wid=__builtin_amdgcn_readfirstlane(tid>>6);
  const long rowbase=(long)b*SEQ; const int q0=qb*QB;
  const bf16*Qw=Q+(rowbase+q0+wid*QBLK)*DM+h*D;
  const bf16*Kh=K+rowbase*DM+h*D,*Vh=V+rowbase*DM+h*D;
  const unsigned lds0=(unsigned)(uintptr_t)shm;
  float*wsf=(float*)(shm+LDS_WS)+wid*64;
  const bf16*ksrc=Kh+(long)lane*DM+wid*8;
  const bf16*vsrc=Vh+(long)(16*(wid&3)+(lane>>2))*DM+(wid>>2)*32+(lane&3)*8;
  const unsigned kdst=lds0+LDS_K+wid*1024, vdst=lds0+LDS_V+wid*1024;
  #define DMA_K(t,slot) glds16(ksrc+(long)(t)*KVBLK*DM,(unsigned)__builtin_amdgcn_readfirstlane(kdst+(slot)))
  #define DMA_V(t,slot) glds16(vsrc+(long)(t)*KVBLK*DM,(unsigned)__builtin_amdgcn_readfirstlane(vdst+(slot)))
  const int vb0=(int)(lds0+LDS_V)+((lane>>4)&1)*32+(lane&3)*8+(4*hi+((lane&15)>>2))*64;
  const char*Kbase=shm+LDS_K; bf16x8 kf[8];
  const lds_cptr shm3=(lds_cptr)shm; const lds_cptr kp0=shm3+LDS_K+hi*1024+r32*16; const lds_cptr vp0=shm3+LDS_V+((lane>>4)&1)*32+(lane&3)*8+(4*hi+((lane&15)>>2))*64;
  const int NT=(q0+QB)/KVBLK;
  DMA_K(0,0);DMA_V(0,0);DMA_K(1,SLOTB);
  bf16x8 qr[4];
  #pragma unroll
  for(int d0=0;d0<4;++d0)qr[d0]=*reinterpret_cast<const bf16x8*>(&Qw[(long)r32*DM+d0*16+hi*8]);
  float mhat=0.f,l_reg=0.f;f32x16 o[2];o[0]=f32x16{};o[1]=f32x16{};f32x16 negm=f32x16{};asm volatile("":"+v"(negm));
  const int qrel=wid*QBLK+r32;
  #define CMASK(P0,P1,t) do{int jb_=(t)-(NT-4); if(jb_>=0)cmask(P0,P1,jb_,qrel,hi);}while(0)
  bool resc=false;
  #define START(P0,P1) do{ const float rm=rowmax(P0,P1); resc=false; \
    { const float dl=rm; mhat=fadd_s(mhat,dl); \
      _Pragma("unroll") for(int r=0;r<16;++r){P0[r]=fsub_s(P0[r],dl);P1[r]=fsub_s(P1[r],dl);} \
      _Pragma("unroll") for(int r=0;r<16;++r)negm[r]=-mhat; asm volatile("":"+v"(negm)); } \
    _Pragma("unroll") for(int r=0;r<16;++r)P0[r]=__builtin_amdgcn_exp2f(P0[r]); }while(0)
  #define RESC() do{ if(resc){ asm volatile("s_waitcnt lgkmcnt(0)":::"memory"); \
      _Pragma("unroll") for(int d_=0;d_<2;++d_) _Pragma("unroll") for(int r=0;r<16;++r)o[d_][r]*=wsf[crow(r,hi)]; } }while(0)
  f32x16 pA0,pA1,pB0,pB1;
  int sl_prev=0,sl_cur=0,sl_next=SLOTB;
  #define ROT() do{sl_prev=sl_cur;sl_cur=sl_next;sl_next=(sl_next==(NSLOT-1)*SLOTB)?0:sl_next+SLOTB;}while(0)
  DMA_K(2,2*SLOTB);
  WAIT_BAR(3);
  qkt(pA0,pA1,Kbase,qr,negm,r32,hi);asm volatile("s_nop 15\n\ts_nop 7":"+v"(pA0),"+v"(pA1));CMASK(pA0,pA1,0);
  START(pA0,pA1);
  _Pragma("unroll") for(int r=0;r<16;++r)pA1[r]=__builtin_amdgcn_exp2f(pA1[r]);
  WAIT_BAR(0);
  DMA_K(3,0);DMA_V(1,SLOTB);
  ROT();
  kload8(kf,kp0+sl_cur);
  WAIT_BAR(2);
  s16x4 vlo[8],vhi[8]; u32x4 pw0,pw1,pw2,pw3;
  #define PKW(P,B) cvtpk_s(P[B],P[B+1])
  #define PAF(k) __builtin_bit_cast(bf16x8,pw##k)
  #define VFR(i) (bf16x8){vlo[i][0],vlo[i][1],vlo[i][2],vlo[i][3],vhi[i][0],vhi[i][1],vhi[i][2],vhi[i][3]}
  #define PIN(x) asm volatile("":"+v"(x))
  #define MX3(a,b,c) __builtin_fmaxf(__builtin_fmaxf((a),(b)),(c))
  #define GAPA(MF,A0,A1,A2,A3,W0,W1,PW) do{ MF; sacc+=A0; sacc+=A1; sacc+=A2; sacc+=A3; PIN(sacc); W0; W1; PIN(PW); SBAR(); }while(0)
  #define EX(v) __builtin_amdgcn_exp2f(v)
  #define GAPB(MF,X,B) do{ MF; X[B]=EX(X[B]); X[B+1]=EX(X[B+1]); X[B+2]=EX(X[B+2]); X[B+3]=EX(X[B+3]); PIN(X); SBAR(); }while(0)
  #define VRD(i) do{ vlo[i]=vtr(vp_+(((i)>>2)*4096+((i)&3)*1024)); vhi[i]=vtr(vp_+(((i)>>2)*4096+((i)&3)*1024+512)); }while(0)
  #define KRD(G,j) do{ if(G){ kload2(kf,kp0+sl_next,j); SBAR(); } }while(0)
  #define STEP(C0,C1,P0,P1,t,GK,GV,GL) do{ SBAR(); \
    const lds_cptr vp_=vp0+sl_prev; \
    VRD(0); SBAR(); float sacc=(P0[0]+P0[1]); \
    GAPA(C0=__builtin_amdgcn_mfma_f32_32x32x16_bf16(kf[0],qr[0],negm,0,0,0), P0[2],P0[3],P0[4],P0[5],     pw0[0]=PKW(P0,0), pw0[1]=PKW(P0,2), pw0); \
    VRD(4); SBAR(); GAPA(C1=__builtin_amdgcn_mfma_f32_32x32x16_bf16(kf[1],qr[0],negm,0,0,0), P0[6],P0[7],P0[8],P0[9],     pw0[2]=PKW(P0,4), pw0[3]=PKW(P0,6), pw0); \
    VRD(1); SBAR(); GAPA(C0=__builtin_amdgcn_mfma_f32_32x32x16_bf16(kf[2],qr[1],C0,0,0,0),   P0[10],P0[11],P0[12],P0[13], pw1[0]=PKW(P0,8), pw1[1]=PKW(P0,10), pw1); \
    VRD(5); SBAR(); GAPA(C1=__builtin_amdgcn_mfma_f32_32x32x16_bf16(kf[3],qr[1],C1,0,0,0),   P0[14],P0[15],P1[0],P1[1],   pw1[2]=PKW(P0,12),pw1[3]=PKW(P0,14), pw1); \
    VRD(2); SBAR(); GAPA(C0=__builtin_amdgcn_mfma_f32_32x32x16_bf16(kf[4],qr[2],C0,0,0,0),   P1[2],P1[3],P1[4],P1[5],     pw2[0]=PKW(P1,0), pw2[1]=PKW(P1,2), pw2); \
    VRD(6); SBAR(); GAPA(C1=__builtin_amdgcn_mfma_f32_32x32x16_bf16(kf[5],qr[2],C1,0,0,0),   P1[6],P1[7],P1[8],P1[9],     pw2[2]=PKW(P1,4), pw2[3]=PKW(P1,6), pw2); \
    VRD(3); SBAR(); GAPA(C0=__builtin_amdgcn_mfma_f32_32x32x16_bf16(kf[6],qr[3],C0,0,0,0),   P1[10],P1[11],P1[12],P1[13], pw3[0]=PKW(P1,8), pw3[1]=PKW(P1,10), pw3); \
    VRD(7); SBAR(); GAPA(C1=__builtin_amdgcn_mfma_f32_32x32x16_bf16(kf[7],qr[3],C1,0,0,0),   P1[14],P1[15],0.f,0.f,       pw3[2]=PKW(P1,12),pw3[3]=PKW(P1,14), pw3); \
    l_reg+=sacc; \
    if(GK){DMA_K((t)+3,sl_cur);} if(GV){DMA_V((t)+1,sl_next);} \
    CMASK(C0,C1,t); \
    { float a=MX3(C0[0],C0[1],C1[0]),b=MX3(C0[2],C0[3],C1[1]); a=MX3(a,C1[2],C1[3]); \
      _Pragma("unroll") for(int r=4;r<16;r+=4){a=MX3(a,C0[r],C0[r+1]);b=MX3(b,C0[r+2],C0[r+3]);a=MX3(a,C1[r],C1[r+1]);b=MX3(b,C1[r+2],C1[r+3]);} \
      float rm=__builtin_fmaxf(a,b); { auto rr=__builtin_amdgcn_permlane32_swap(__float_as_uint(rm),__float_as_uint(rm),false,false); rm=__builtin_fmaxf(__uint_as_float(rr[0]),__uint_as_float(rr[1])); } \
      resc=false; \
      if(__builtin_expect(__any(rm>(float)THRL),0)){ const float dl=__builtin_fmaxf(rm,0.f); mhat+=dl; \
        _Pragma("unroll") for(int r=0;r<16;++r){C0[r]-=dl;C1[r]-=dl;} \
        _Pragma("unroll") for(int r=0;r<16;++r)negm[r]=-mhat; asm volatile("":"+v"(negm)); \
        const float f=__builtin_amdgcn_exp2f(-dl); l_reg*=f; if(hi==0)wsf[r32]=f; resc=true; } } \
    SBAR(); \
    GAPB(o[0]=__builtin_amdgcn_mfma_f32_32x32x16_bf16(PAF(0),VFR(0),o[0],0,0,0), C0,0); \
    GAPB(o[1]=__builtin_amdgcn_mfma_f32_32x32x16_bf16(PAF(0),VFR(4),o[1],0,0,0), C0,4); \
    KRD(GL,0); GAPB(o[0]=__builtin_amdgcn_mfma_f32_32x32x16_bf16(PAF(1),VFR(1),o[0],0,0,0), C0,8); \
    KRD(GL,1); GAPB(o[1]=__builtin_amdgcn_mfma_f32_32x32x16_bf16(PAF(1),VFR(5),o[1],0,0,0), C0,12); \
    KRD(GL,2); GAPB(o[0]=__builtin_amdgcn_mfma_f32_32x32x16_bf16(PAF(2),VFR(2),o[0],0,0,0), C1,0); \
    KRD(GL,3); GAPB(o[1]=__builtin_amdgcn_mfma_f32_32x32x16_bf16(PAF(2),VFR(6),o[1],0,0,0), C1,4); \
    GAPB(o[0]=__builtin_amdgcn_mfma_f32_32x32x16_bf16(PAF(3),VFR(3),o[0],0,0,0), C1,8); \
    GAPB(o[1]=__builtin_amdgcn_mfma_f32_32x32x16_bf16(PAF(3),VFR(7),o[1],0,0,0), C1,12); \
    }while(0)
  int t=1;
  #undef CMASK
  #define CMASK(P0,P1,t) do{}while(0)
  for(;t+5<NT;t+=2){
    STEP(pB0,pB1,pA0,pA1,t,true,true,true);     WAIT_BAR(2); RESC(); ROT();
    STEP(pA0,pA1,pB0,pB1,t+1,true,true,true);   WAIT_BAR(2); RESC(); ROT();
  }
  #undef CMASK
  #define CMASK(P0,P1,t) do{int jb_=(t)-(NT-4); if(jb_>=0)cmask(P0,P1,jb_,qrel,hi);}while(0)
  #define ENDW(tt) do{ if((tt)+3<NT){WAIT_BAR(2);} else if((tt)+2<NT){WAIT_BAR(1);} else {WAIT_BAR(0);} }while(0)
  for(;t+1<NT;t+=2){
    STEP(pB0,pB1,pA0,pA1,t,(t+3<NT),(t+1<NT),(t+1<NT));       ENDW(t);   RESC(); ROT();
    STEP(pA0,pA1,pB0,pB1,t+1,(t+4<NT),(t+2<NT),(t+2<NT));     ENDW(t+1); RESC(); ROT();
  }
  STEP(pB0,pB1,pA0,pA1,NT-1,false,false,false); RESC();
  { float sacc=pB0[0]+pB0[1]; _Pragma("unroll") for(int r=2;r<16;++r)sacc+=pB0[r]; _Pragma("unroll") for(int r=0;r<16;++r)sacc+=pB1[r]; l_reg+=sacc;
    pw0=(u32x4){PKW(pB0,0),PKW(pB0,2),PKW(pB0,4),PKW(pB0,6)};pw1=(u32x4){PKW(pB0,8),PKW(pB0,10),PKW(pB0,12),PKW(pB0,14)};pw2=(u32x4){PKW(pB1,0),PKW(pB1,2),PKW(pB1,4),PKW(pB1,6)};pw3=(u32x4){PKW(pB1,8),PKW(pB1,10),PKW(pB1,12),PKW(pB1,14)};
    SBAR(); pv(o,vb0+sl_cur,PAF(0),PAF(1),PAF(2),PAF(3)); }
  #undef PKW
  #undef PAF
  #undef VFR
  #undef PIN
  #undef MX3
  #undef GAPA
  #undef GAPB
  #undef EX
  #undef VRD
  #undef KRD
  #undef STEP
  #undef ENDW
  {auto rr=__builtin_amdgcn_permlane32_swap(__float_as_uint(l_reg),__float_as_uint(l_reg),false,false);l_reg=__uint_as_float(rr[0])+__uint_as_float(rr[1]);}
  if(hi==0)wsf[32+r32]=l_reg;asm volatile("s_waitcnt lgkmcnt(0)":::"memory");
  float rli[16];
  #pragma unroll
  for(int r=0;r<16;++r)rli[r]=__builtin_amdgcn_rcpf(wsf[32+crow(r,hi)]);
  bf16*Ow=O+(rowbase+q0+wid*QBLK)*DM+h*D;
  { bf16*stg=(bf16*)(shm+LDS_OST)+wid*2048;
    #pragma unroll
    for(int r=0;r<16;++r){const int orow=crow(r,hi);
      #pragma unroll
      for(int d0=0;d0<2;++d0)stg[orow*64+d0*32+r32]=__float2bfloat16(o[d0][r]*rli[r]);}
    asm volatile("s_waitcnt lgkmcnt(0)":::"memory");
    #pragma unroll
    for(int i=0;i<4;++i){const int row=i*8+(lane>>3),ch=lane&7; const u32x4 v=*(const u32x4*)(stg+row*64+ch*8); ATTN_STORE16(Ow+(long)row*DM+ch*8,v);} }
  asm volatile("s_waitcnt lgkmcnt(0)\n\ts_barrier":::"memory");
  #undef DMA_K
  #undef DMA_V
  #undef CMASK
  #undef START
  #undef RESC
  #undef ROT
}
constexpr int ATTN_LDS_BYTES=LDS_BYTES;
struct AttnTensors { const bf16* Q; const bf16* K; const bf16* V; bf16* O; };
struct AttnUnit { int bh; int qb; };
struct StaticOrder {
  int vcu;
  __device__ __forceinline__ explicit StaticOrder(int grid,int block):vcu((block%8)*(grid/8)+block/8){}
  __device__ __forceinline__ bool next(int i,AttnUnit&u)const{ if(i>=4)return false; const int s=vcu&7; u.bh=vcu>>3; u.qb=(i==0)?s:(i==1)?15-s:(i==2)?16+s:31-s; return true; }
  __device__ __forceinline__ void a_ready(const AttnUnit&)const{}
  __device__ __forceinline__ void done(const AttnUnit&)const{}
};
struct QueueOrder {
  unsigned* head; volatile __attribute__((address_space(3))) unsigned* slot; int grp;
  __device__ __forceinline__ bool next(int,AttnUnit&u)const{
    __syncthreads();
    if(threadIdx.x==0) slot[0]=__hip_atomic_fetch_add(head+64*grp,1u,__ATOMIC_RELAXED,__HIP_MEMORY_SCOPE_AGENT);
    __syncthreads();
    const unsigned q=slot[0]; if(q>=128u)return false;
    u.qb=31-(int)(q>>2); u.bh=4*grp+(int)(q&3u); return true; }
  __device__ __forceinline__ void a_ready(const AttnUnit&)const{}
  __device__ __forceinline__ void done(const AttnUnit&)const{}
};
template<class Sched,int THRL=8> __device__ __forceinline__ void attn_phase(char*lds,const AttnTensors&T,const Sched&S){
  AttnUnit u;
  for(int i=0;S.next(i,u);++i){ S.a_ready(u); { const int st=u.bh, h=(st>>1)&15, e=st&1, hv=(((st>>2)&7)<<1)+e; attn_unit<THRL>(st>>5,h,u.qb,T.Q,T.K,T.V+(hv-h)*D,T.O+(size_t)e*SEQ*DM,lds); } S.done(u); }
}
#undef SBAR
#undef WAIT_BAR
}
#define GAS __attribute__((address_space(1)))
#define LAS __attribute__((address_space(3)))
typedef unsigned short bf16;
typedef unsigned v4u __attribute__((ext_vector_type(4)));
typedef short bf16x8 __attribute__((ext_vector_type(8)));
typedef GAS unsigned gu32;
typedef GAS unsigned long long gu64;
#define RLX_AGENT __ATOMIC_RELAXED, __HIP_MEMORY_SCOPE_AGENT
#define LDS_WAIT() asm volatile("s_waitcnt lgkmcnt(0)" ::: "memory")
#define VM_WAIT() asm volatile("s_waitcnt vmcnt(0)" ::: "memory")
__device__ __forceinline__ unsigned long long rt() { return __builtin_amdgcn_s_memrealtime(); }

#define XB_TMO      128
#define XB_XCNT(j)  (256  + 64 * (j))
#define XB_XSUB(j)  (1280 + 64 * (j))
#define XB_XGEN(j)  (2304 + 64 * (j))
#define XB_TOP      3328
#define XB_TOPGEN   3392
#define XCD_BAR_WORDS 3456
#define XB_SPIN_CAP (1u << 18)

__device__ __forceinline__ unsigned xb_ld(unsigned* p)              { return __hip_atomic_load(p, __ATOMIC_RELAXED, __HIP_MEMORY_SCOPE_AGENT); }
__device__ __forceinline__ unsigned xb_add(unsigned* p, unsigned v) { return __hip_atomic_fetch_add(p, v, __ATOMIC_RELAXED, __HIP_MEMORY_SCOPE_AGENT); }
__device__ __forceinline__ unsigned xb_xcc_id() { return (unsigned)__builtin_amdgcn_s_getreg((3 << 11) | 20) & 0xFu; }
#define XB_SPIN(cond, bar) do { unsigned _sp = 0; while (cond) { __builtin_amdgcn_s_sleep(1); \
    if ((++_sp & 255u) == 0u) { if (xb_ld(&(bar)[XB_TMO])) break; if (_sp > XB_SPIN_CAP) { atomicAdd(&(bar)[XB_TMO], 1u); break; } } } } while (0)

struct XcdBarrier {
    unsigned* bar; unsigned x;
    volatile LAS unsigned* st;
};

__device__ __forceinline__ XcdBarrier xcd_barrier_post(unsigned* bar, volatile LAS unsigned* st) {
    XcdBarrier b; b.bar = bar; b.x = xb_xcc_id(); b.st = st;
    if (threadIdx.x == 0) (void)xb_add(&bar[XB_XCNT(b.x)], 1u);
    return b;
}
__device__ __forceinline__ void xcd_barrier_complete(unsigned* bar, unsigned x, unsigned& nloc, unsigned& nx) {
    const unsigned G = gridDim.x * gridDim.y * gridDim.z;
    unsigned sum, cnt, mine, sp = 0u;
    for (;;) {
        sum = 0u; cnt = 0u; mine = 0u;
#pragma unroll
        for (unsigned j = 0; j < 16; ++j) { const unsigned c = xb_ld(&bar[XB_XCNT(j)]); sum += c; cnt += (c > 0u) ? 1u : 0u; mine = (j == x) ? c : mine; }
        if (sum == G) break;
        __builtin_amdgcn_s_sleep(1);
        if ((++sp & 255u) == 0u) { if (xb_ld(&bar[XB_TMO])) break; if (sp > XB_SPIN_CAP) { atomicAdd(&bar[XB_TMO], 1u); break; } }
    }
    nloc = mine > 0u ? mine : 1u; nx = cnt > 0u ? cnt : 1u;
}

__device__ __forceinline__ void xcd_barrier(const XcdBarrier& b) {
    asm volatile("s_waitcnt vmcnt(0)" ::: "memory");
    __syncthreads();
    if (threadIdx.x == 0) {
        unsigned* bar = b.bar;
        __builtin_amdgcn_s_waitcnt(0);
        unsigned nloc = b.st[0], nx = b.st[1];
        if (nloc == 0u) { xcd_barrier_complete(bar, b.x, nloc, nx); b.st[0] = nloc; b.st[1] = nx; }
        const unsigned old = xb_add(&bar[XB_XSUB(b.x)], 1u);
        const unsigned gen = old / nloc;
        if (old + 1u == (gen + 1u) * nloc) {
            __builtin_amdgcn_fence(__ATOMIC_RELEASE, "agent");
            asm volatile("s_waitcnt vmcnt(0)" ::: "memory");
            const unsigned og = xb_add(&bar[XB_TOP], 1u);
            const unsigned tg = og / nx;
            if (og + 1u == (tg + 1u) * nx) xb_add(&bar[XB_TOPGEN], 1u);
            else XB_SPIN(xb_ld(&bar[XB_TOPGEN]) == tg, bar);
            __builtin_amdgcn_fence(__ATOMIC_ACQUIRE, "agent");
            xb_add(&bar[XB_XGEN(b.x)], 1u);
            asm volatile("s_waitcnt vmcnt(0)" ::: "memory");
        } else {
            XB_SPIN(xb_ld(&bar[XB_XGEN(b.x)]) == gen, bar);
            __builtin_amdgcn_fence(__ATOMIC_ACQUIRE, "agent");
            asm volatile("s_waitcnt vmcnt(0)" ::: "memory");
        }
    }
    __syncthreads();
}

__device__ __forceinline__ unsigned pk2(float lo, float hi) { return (unsigned)f2bf(lo) | ((unsigned)f2bf(hi) << 16); }
#define DPP_ADD(v, ctrl) v += __builtin_bit_cast(float, __builtin_amdgcn_update_dpp(0, __builtin_bit_cast(int, v), ctrl, 0xf, 0xf, true))
__device__ __forceinline__ float rowpair_sum(float v) { float a = v, b = v; asm("s_nop 1\n\tv_permlane16_swap_b32 %0, %1" : "+v"(a), "+v"(b)); return a + b; }
__device__ __forceinline__ float wave_allsum(float v) {
    DPP_ADD(v, 0xB1);
    DPP_ADD(v, 0x4E);
    DPP_ADD(v, 0x141);
    DPP_ADD(v, 0x140);
    v = rowpair_sum(v);
    { float a = v, b = v; asm("s_nop 1\n\tv_permlane32_swap_b32 %0, %1" : "+v"(a), "+v"(b)); v = a + b; }
    return v;
}
__device__ __forceinline__ float row16_sum(float v) { DPP_ADD(v, 0xB1); DPP_ADD(v, 0x4E); DPP_ADD(v, 0x141); DPP_ADD(v, 0x140); return v; }
struct PrepW { const float *mu, *w0, *w2, *a0, *a2, *g2, *k_k, *k_a, *r_k; };

__device__ __forceinline__ void prep_token_a(const bf16_t* PR, const PrepW& P, int t, int lt, LAS float* xs) {
    const bf16_t* cur = PR + (size_t)t * RWKV_COLS; const int c = 3072 + lt;
    const float a = bf2f(cur[c]), p = t > 0 ? bf2f(cur[c - RWKV_COLS]) : 0.f, v = a + (p - a) * P.mu[c];
    xs[lt] = lt < 64 ? tanhf(v) : (lt < 128 ? v : sigmoidf_(v));
}
__device__ __forceinline__ void prep_token_b(const bf16_t* PR, const PrepW& P, int t, int lt, const LAS float* xs, float* S0, float* BONUS) {
    const bf16_t* cur = PR + (size_t)t * RWKV_COLS;
    float lw[4], la[4], lg[4] = {0.f, 0.f, 0.f, 0.f};
#pragma unroll
    for (int i = 0; i < 4; ++i) { lw[i] = P.w0[lt * 4 + i]; la[i] = P.a0[lt * 4 + i]; }
#pragma unroll 4
    for (int j = 0; j < 64; ++j) { const f32x4 w = *(const GAS f32x4*)(P.w2 + (size_t)j * RW + lt * 4), a = *(const GAS f32x4*)(P.a2 + (size_t)j * RW + lt * 4); const float x0 = xs[j], x1 = xs[64 + j];
#pragma unroll
        for (int i = 0; i < 4; ++i) { lw[i] += x0 * w[i]; la[i] += x1 * a[i]; } }
#pragma unroll 4
    for (int j = 0; j < 128; ++j) { const f32x4 g = *(const GAS f32x4*)(P.g2 + (size_t)j * RW + lt * 4); const float x2 = xs[128 + j];
#pragma unroll
        for (int i = 0; i < 4; ++i) lg[i] += x2 * g[i]; }
    float r[4], k0[4], v[4], kk[4], a[4], ss = 0.f;
#pragma unroll
    for (int i = 0; i < 4; ++i) { const int c = lt * 4 + i;
        { const float x = bf2f(cur[c]), p = t > 0 ? bf2f(cur[c - RWKV_COLS]) : 0.f; r[i] = x + (p - x) * P.mu[c]; }
        { const float x = bf2f(cur[1024 + c]), p = t > 0 ? bf2f(cur[1024 + c - RWKV_COLS]) : 0.f; k0[i] = x + (p - x) * P.mu[1024 + c]; }
        { const float x = bf2f(cur[2048 + c]), p = t > 0 ? bf2f(cur[2048 + c - RWKV_COLS]) : 0.f; v[i] = x + (p - x) * P.mu[2048 + c]; }
        a[i] = sigmoidf_(la[i]); kk[i] = k0[i] * P.k_k[c]; ss += kk[i] * kk[i]; }
    ss = row16_sum(ss);
    const float inv = 1.f / fmaxf(sqrtf(ss), 1e-12f);
    float bon = 0.f; const size_t ob = (size_t)t * RW + lt * 4; constexpr size_t SS = (size_t)SEQ * RW;
    f32x4 o_r, o_w, o_k, o_v, o_a, o_b, o_g;
#pragma unroll
    for (int i = 0; i < 4; ++i) { const int c = lt * 4 + i;
        const float x = -lw[i], sp = fmaxf(x, 0.f) + log1pf(__expf(-fabsf(x))), wraw = -sp - 0.5f, dec = __expf(-__expf(wraw));
        const float kn = kk[i] * inv, k = k0[i] * (1.f + (a[i] - 1.f) * P.k_a[c]);
        bon += r[i] * k * P.r_k[c];
        o_r[i] = r[i]; o_w[i] = dec; o_k[i] = k; o_v[i] = v[i]; o_a[i] = -kn; o_b[i] = kn * a[i]; o_g[i] = lg[i]; }
    *(GAS f32x4*)(S0 + 0 * SS + ob) = o_r; *(GAS f32x4*)(S0 + 1 * SS + ob) = o_w; *(GAS f32x4*)(S0 + 2 * SS + ob) = o_k; *(GAS f32x4*)(S0 + 3 * SS + ob) = o_v;
    *(GAS f32x4*)(S0 + 4 * SS + ob) = o_a; *(GAS f32x4*)(S0 + 5 * SS + ob) = o_b; *(GAS f32x4*)(S0 + 6 * SS + ob) = o_g;
    bon = row16_sum(bon);
    if ((lt & 15) == 0) BONUS[t * 16 + (lt >> 4)] = bon;
}
__device__ __forceinline__ void scan_row(const float* S0, float* Y, int h, int vr, int lane) {
    constexpr size_t SS = (size_t)SEQ * RW; constexpr int U = 8;
    const GAS float* pr = (const GAS float*)S0 + h * 64 + lane; const GAS float* pv = (const GAS float*)S0 + 3 * SS + h * 64 + vr;
    float s = 0.f, yacc = 0.f;
    float cr[U], cw[U], ck[U], ca[U], cb[U], cv[U];
#pragma unroll
    for (int u = 0; u < U; ++u) { const size_t o = (size_t)u * RW; cr[u] = pr[o]; cw[u] = pr[SS + o]; ck[u] = pr[2 * SS + o]; ca[u] = pr[4 * SS + o]; cb[u] = pr[5 * SS + o]; cv[u] = pv[o]; }
    for (int t0 = 0; t0 < SEQ; t0 += U) {
        float nr[U], nw[U], nk[U], na[U], nb[U], nv[U];
        const int tn = (t0 + U < SEQ) ? t0 + U : t0;
#pragma unroll
        for (int u = 0; u < U; ++u) { const size_t o = (size_t)(tn + u) * RW; nr[u] = pr[o]; nw[u] = pr[SS + o]; nk[u] = pr[2 * SS + o]; na[u] = pr[4 * SS + o]; nb[u] = pr[5 * SS + o]; nv[u] = pv[o]; }
#pragma unroll
        for (int u = 0; u < U; ++u) {
            const float sa = wave_allsum(s * ca[u]);
            s = s * cw[u] + sa * cb[u] + cv[u] * ck[u];
            const float y = wave_allsum(s * cr[u]);
            yacc = (lane == ((t0 + u) & 63)) ? y : yacc; }
        if (((t0 + U) & 63) == 0) ((GAS float*)Y)[(size_t)(t0 + U - 64 + lane) * RW + h * 64 + vr] = yacc;
#pragma unroll
        for (int u = 0; u < U; ++u) { cr[u] = nr[u]; cw[u] = nw[u]; ck[u] = nk[u]; ca[u] = na[u]; cb[u] = nb[u]; cv[u] = nv[u]; }
    }
}
__device__ __forceinline__ void diff_post_token(const bf16_t* O2, float lam, const float* subln_w, bf16_t* MIXED, int t, int lt) {
    const int h = lt >> 5, d0 = (lt & 31) * 4; const bf16_t* ob2 = O2 + (size_t)(d0 >> 6) * SEQ * 1024 + (size_t)t * 1024 + (d0 & 63);
    const unsigned long long a = *(const GAS unsigned long long*)(ob2 + (2 * h) * 64), b = *(const GAS unsigned long long*)(ob2 + (2 * h + 1) * 64);
    f32x4 o; float q = 0.f;
#pragma unroll
    for (int i = 0; i < 4; ++i) { o[i] = bf2f((bf16_t)(a >> (16 * i))) - lam * bf2f((bf16_t)(b >> (16 * i))); q += o[i] * o[i]; }
    q = rowpair_sum(row16_sum(q));
    const float rs = rsqrtf(q * (1.f / 128.f) + SUBLN_EPS) * (1.f - LAMBDA_INIT); const f32x4 sw = *(const GAS f32x4*)(subln_w + d0);
    o = o * rs * sw;
    *(GAS unsigned long long*)(MIXED + (size_t)t * DM + 1024 + h * 128 + d0) = (unsigned long long)pk2(o[0], o[1]) | ((unsigned long long)pk2(o[2], o[3]) << 32);
}
typedef short bf16x8_t __attribute__((ext_vector_type(8)));
typedef float f32x16_t __attribute__((ext_vector_type(16)));
__device__ __forceinline__ int swz(int row, int k) { return row * 128 + ((((k >> 3) ^ row) & 7) << 4) + ((k & 7) << 1); }
__device__ __forceinline__ void mm64(const LAS unsigned char* Aop, const LAS unsigned char* Bop, int ta, int tb0, int lane, f32x4 (&acc)[2]) {
    const int fr = lane & 15, fq = lane >> 4;
    const bf16x8_t a0 = *(const LAS bf16x8_t*)(Aop + swz(16 * ta + fr, 8 * fq)), a1 = *(const LAS bf16x8_t*)(Aop + swz(16 * ta + fr, 32 + 8 * fq));
#pragma unroll
    for (int t = 0; t < 2; ++t) {
        const bf16x8_t b0 = *(const LAS bf16x8_t*)(Bop + swz(16 * (tb0 + t) + fr, 8 * fq)), b1 = *(const LAS bf16x8_t*)(Bop + swz(16 * (tb0 + t) + fr, 32 + 8 * fq));
        acc[t] = __builtin_amdgcn_mfma_f32_16x16x32_bf16(a0, b0, acc[t], 0, 0, 0);
        acc[t] = __builtin_amdgcn_mfma_f32_16x16x32_bf16(a1, b1, acc[t], 0, 0, 0); }
}
__device__ __forceinline__ unsigned long long pk4(const f32x4 v) { return (unsigned long long)pk2(v[0], v[1]) | ((unsigned long long)pk2(v[2], v[3]) << 32); }
__device__ __forceinline__ f32x4 up4(unsigned long long w) { f32x4 r; r[0] = bf2f((bf16_t)w); r[1] = bf2f((bf16_t)(w >> 16)); r[2] = bf2f((bf16_t)(w >> 32)); r[3] = bf2f((bf16_t)(w >> 48)); return r; }
__device__ __forceinline__ float sum8(float v) { DPP_ADD(v, 0xB1); DPP_ADD(v, 0x4E); DPP_ADD(v, 0x141); return v; }
constexpr int SA_AT = 0, SA_BT = 8192, SA_KT = 16384, SA_RT = 24576, SA_ATT = 32768, SA_VTT = 40960, SA_BPT = 49152, SA_KPT = 57344, SA_M1 = 65536, SA_TT = 81920, SA_M2T = 90112,
              SA_M3 = 98304, SA_LW = 106496, SA_TOT = 122880, SA_END = 124928;
constexpr int SA_X1 = SA_AT, SA_WT = SA_BT, SA_G = SA_KT, SA_KPPT = SA_M3;
struct ScanW { const float *mu, *w0, *a0, *k_k, *k_a, *r_k; };
struct ScanBufs { const bf16_t* PR; const bf16_t* LG; bf16_t* RPP; float* YG; bf16_t* PT; float* QT; bf16_t* EG; bf16_t* EBV; };
constexpr int NCHUNK = SEQ / 64;

__device__ __forceinline__ void scanA_unit(LAS unsigned char* L, const ScanW& W, const ScanBufs& B, int h, int c, int tid, int wave, int lane) {
    const int tau = tid >> 3, n0 = (tid & 7) * 8, t = c * 64 + tau, ch = h * 64 + n0;
    float r_[8], km[8], v_[8], a_[8], b_[8], lw[8];
    {
        const bf16_t* cur = B.PR + (size_t)t * RWKV_COLS + ch; const bool hasp = t > 0;
        const u32x4 cr = *(const GAS u32x4*)(cur), ck = *(const GAS u32x4*)(cur + 1024), cv = *(const GAS u32x4*)(cur + 2048);
        u32x4 pr = {0u, 0u, 0u, 0u}, pk = pr, pv = pr;
        if (hasp) { pr = *(const GAS u32x4*)(cur - RWKV_COLS); pk = *(const GAS u32x4*)(cur - RWKV_COLS + 1024); pv = *(const GAS u32x4*)(cur - RWKV_COLS + 2048); }
        const bf16_t* lgp = B.LG + (size_t)t * 3072 + ch;
        const u32x4 gw = *(const GAS u32x4*)(lgp), ga = *(const GAS u32x4*)(lgp + 1024), gg = *(const GAS u32x4*)(lgp + 2048);
        float k0[8], eta[8], g_[8], ss = 0.f;
#pragma unroll
        for (int e = 0; e < 8; ++e) { const int sh = (e & 1) * 16, q = e >> 1;
            const float xr = __uint_as_float((cr[q] >> sh) << 16), xk = __uint_as_float((ck[q] >> sh) << 16), xv = __uint_as_float((cv[q] >> sh) << 16);
            const float yr = __uint_as_float((pr[q] >> sh) << 16), yk = __uint_as_float((pk[q] >> sh) << 16), yv = __uint_as_float((pv[q] >> sh) << 16);
            r_[e] = xr + (yr - xr) * W.mu[ch + e]; k0[e] = xk + (yk - xk) * W.mu[1024 + ch + e]; v_[e] = xv + (yv - xv) * W.mu[2048 + ch + e];
            const float l_w = W.w0[ch + e] + __uint_as_float((gw[q] >> sh) << 16), l_a = W.a0[ch + e] + __uint_as_float((ga[q] >> sh) << 16); g_[e] = __uint_as_float((gg[q] >> sh) << 16);
            const float x = -l_w, sp = fmaxf(x, 0.f) + log1pf(__expf(-fabsf(x)));
            lw[e] = -__expf(-sp - 0.5f);
            eta[e] = sigmoidf_(l_a); const float kk = k0[e] * W.k_k[ch + e]; a_[e] = kk; ss += kk * kk; }
        ss = sum8(ss); const float inv = 1.f / fmaxf(sqrtf(ss), 1e-12f); float bon = 0.f;
#pragma unroll
        for (int e = 0; e < 8; ++e) { const float kn = a_[e] * inv; km[e] = k0[e] * (1.f + (eta[e] - 1.f) * W.k_a[ch + e]); a_[e] = -kn; b_[e] = kn * eta[e]; bon += r_[e] * km[e] * W.r_k[ch + e]; }
        bon = sum8(bon);
        { u32x4 og, ob;
#pragma unroll
          for (int q = 0; q < 4; ++q) { og[q] = pk2(g_[2 * q], g_[2 * q + 1]); ob[q] = pk2(bon * v_[2 * q], bon * v_[2 * q + 1]); }
          *(GAS u32x4*)(B.EG + (size_t)t * RW + ch) = og; *(GAS u32x4*)(B.EBV + (size_t)t * RW + ch) = ob; }
        LAS float* LW = (LAS float*)(L + SA_LW) + tau * 64 + n0;
        *(LAS f32x4*)(LW) = (f32x4){lw[0], lw[1], lw[2], lw[3]}; *(LAS f32x4*)(LW + 4) = (f32x4){lw[4], lw[5], lw[6], lw[7]};
    }
    __syncthreads();
    {
        const int n = tid & 63, part = tid >> 6; LAS float* LW = (LAS float*)(L + SA_LW); LAS float* TOT = (LAS float*)(L + SA_TOT);
        float p[8]; float run = 0.f;
#pragma unroll
        for (int j = 0; j < 8; ++j) { run += LW[(8 * part + j) * 64 + n]; p[j] = run; }
        TOT[part * 64 + n] = run;
        __syncthreads();
        float off = 0.f;
#pragma unroll
        for (int q = 0; q < 8; ++q) off += (q < part) ? TOT[q * 64 + n] : 0.f;
#pragma unroll
        for (int j = 0; j < 8; ++j) LW[(8 * part + j) * 64 + n] = off + p[j];
    }
    __syncthreads();
    {
        const LAS float* LWr = (const LAS float*)(L + SA_LW) + tau * 64 + n0; const LAS float* LWe = (const LAS float*)(L + SA_LW) + 63 * 64 + n0;
        float at[8], bt[8], kt[8], rt[8], bp[8], kp[8];
#pragma unroll
        for (int e = 0; e < 8; ++e) { const float La = LWr[e], Le = LWe[e], eL = __expf(La), eLp = __expf(La - lw[e]), eI = __expf(-La), eE = __expf(Le - La);
            at[e] = a_[e] * eLp; bt[e] = b_[e] * eI; kt[e] = km[e] * eI; rt[e] = r_[e] * eL; bp[e] = b_[e] * eE; kp[e] = km[e] * eE; }
        const int o = swz(tau, n0);
        { u32x4 w;
#pragma unroll
          for (int q = 0; q < 4; ++q) w[q] = pk2(at[2 * q], at[2 * q + 1]);
          *(LAS u32x4*)(L + SA_AT + o) = w;
#pragma unroll
          for (int q = 0; q < 4; ++q) w[q] = pk2(bt[2 * q], bt[2 * q + 1]);
          *(LAS u32x4*)(L + SA_BT + o) = w;
#pragma unroll
          for (int q = 0; q < 4; ++q) w[q] = pk2(kt[2 * q], kt[2 * q + 1]);
          *(LAS u32x4*)(L + SA_KT + o) = w;
#pragma unroll
          for (int q = 0; q < 4; ++q) w[q] = pk2(rt[2 * q], rt[2 * q + 1]);
          *(LAS u32x4*)(L + SA_RT + o) = w; }
#pragma unroll
        for (int e = 0; e < 8; ++e) { const int ot = swz(n0 + e, tau);
            *(LAS bf16_t*)(L + SA_ATT + ot) = f2bf(at[e]); *(LAS bf16_t*)(L + SA_VTT + ot) = f2bf(v_[e]); *(LAS bf16_t*)(L + SA_BPT + ot) = f2bf(bp[e]); *(LAS bf16_t*)(L + SA_KPT + ot) = f2bf(kp[e]); }
    }
    __syncthreads();
    const int ta = wave >> 1, tb0 = 2 * (wave & 1), fr = lane & 15, fq = lane >> 4, i0 = 16 * ta + 4 * fq;
    f32x4 g4[2] = {{0.f, 0.f, 0.f, 0.f}, {0.f, 0.f, 0.f, 0.f}};
    {
        f32x4 d1[2] = {{0.f, 0.f, 0.f, 0.f}, {0.f, 0.f, 0.f, 0.f}}, d1t[2] = {{0.f, 0.f, 0.f, 0.f}, {0.f, 0.f, 0.f, 0.f}}, d2[2] = {{0.f, 0.f, 0.f, 0.f}, {0.f, 0.f, 0.f, 0.f}}, d3[2] = {{0.f, 0.f, 0.f, 0.f}, {0.f, 0.f, 0.f, 0.f}};
        mm64(L + SA_BT, L + SA_AT, ta, tb0, lane, d1); mm64(L + SA_AT, L + SA_BT, ta, tb0, lane, d1t); mm64(L + SA_AT, L + SA_KT, ta, tb0, lane, d2); mm64(L + SA_BT, L + SA_RT, ta, tb0, lane, d3); mm64(L + SA_KT, L + SA_RT, ta, tb0, lane, g4);
#pragma unroll
        for (int t2 = 0; t2 < 2; ++t2) { const int j = 16 * (tb0 + t2) + fr; f32x4 r0;
#pragma unroll
            for (int q = 0; q < 4; ++q) { const int i = i0 + q; if (!(i < j)) d1[t2][q] = 0.f; if (!(j < i)) { d1t[t2][q] = 0.f; d2[t2][q] = 0.f; } if (!(i <= j)) { d3[t2][q] = 0.f; g4[t2][q] = 0.f; } r0[q] = d1t[t2][q] + (i == j ? 1.f : 0.f); }
            *(LAS unsigned long long*)(L + SA_M1 + swz(j, i0)) = pk4(d1[t2]);
            *(LAS unsigned long long*)(L + SA_M1 + 8192 + swz(j, i0)) = pk4(d1t[t2]);
            *(LAS unsigned long long*)(L + SA_TT + swz(j, i0)) = pk4(r0);
            *(LAS unsigned long long*)(L + SA_M2T + swz(j, i0)) = pk4(d2[t2]);
            *(LAS unsigned long long*)(L + SA_M3 + swz(j, i0)) = pk4(d3[t2]); }
    }
    __syncthreads();
    {
#define INV_SQUARE(Lp, Up, Ln, Un, needU) do { f32x4 e1[2] = {{0.f, 0.f, 0.f, 0.f}, {0.f, 0.f, 0.f, 0.f}}, e2[2] = {{0.f, 0.f, 0.f, 0.f}, {0.f, 0.f, 0.f, 0.f}}; \
        mm64(L + (Up), L + (Lp), ta, tb0, lane, e1); if (needU) mm64(L + (Lp), L + (Up), ta, tb0, lane, e2); \
        _Pragma("unroll") for (int t2 = 0; t2 < 2; ++t2) { const int j = 16 * (tb0 + t2) + fr; *(LAS unsigned long long*)(L + (Ln) + swz(j, i0)) = pk4(e1[t2]); if (needU) *(LAS unsigned long long*)(L + (Un) + swz(j, i0)) = pk4(e2[t2]); } } while (0)
#define INV_ACC(Lk, Rp, Rn) do { f32x4 e3[2] = {{0.f, 0.f, 0.f, 0.f}, {0.f, 0.f, 0.f, 0.f}}; mm64(L + (Lk), L + (Rp), ta, tb0, lane, e3); \
        _Pragma("unroll") for (int t2 = 0; t2 < 2; ++t2) { const int j = 16 * (tb0 + t2) + fr; *(LAS unsigned long long*)(L + (Rn) + swz(j, i0)) = pk4(e3[t2] + up4(*(const LAS unsigned long long*)(L + (Rp) + swz(j, i0)))); } } while (0)
        INV_SQUARE(SA_M1, SA_M1 + 8192, SA_AT, SA_BT, true);                                        __syncthreads();
        INV_ACC(SA_AT, SA_TT, SA_KT); INV_SQUARE(SA_AT, SA_BT, SA_M1, SA_M1 + 8192, true);          __syncthreads();
        INV_ACC(SA_M1, SA_KT, SA_TT); INV_SQUARE(SA_M1, SA_M1 + 8192, SA_AT, SA_BT, true);          __syncthreads();
        INV_ACC(SA_AT, SA_TT, SA_KT); INV_SQUARE(SA_AT, SA_BT, SA_M1, SA_M1 + 8192, true);          __syncthreads();
        INV_ACC(SA_M1, SA_KT, SA_TT); INV_SQUARE(SA_M1, SA_M1 + 8192, SA_AT, SA_BT, false);         __syncthreads();
        INV_ACC(SA_AT, SA_TT, SA_KT);
#undef INV_SQUARE
#undef INV_ACC
    }
    __syncthreads();
    {
        f32x4 dx[2] = {{0.f, 0.f, 0.f, 0.f}, {0.f, 0.f, 0.f, 0.f}}, dw[2] = {{0.f, 0.f, 0.f, 0.f}, {0.f, 0.f, 0.f, 0.f}};
        mm64(L + SA_KT, L + SA_M3, ta, tb0, lane, dx); mm64(L + SA_KT, L + SA_BPT, ta, tb0, lane, dw);
#pragma unroll
        for (int t2 = 0; t2 < 2; ++t2) { const int j = 16 * (tb0 + t2) + fr;
            *(LAS unsigned long long*)(L + SA_X1 + swz(j, i0)) = pk4(dx[t2]);
            *(LAS unsigned long long*)(L + SA_WT + swz(j, i0)) = pk4(dw[t2]); }
    }
    __syncthreads();
    const size_t ub = ((size_t)h * NCHUNK + c) * 4096;
    {
        f32x4 dr[2] = {{0.f, 0.f, 0.f, 0.f}, {0.f, 0.f, 0.f, 0.f}}, dp[2] = {{0.f, 0.f, 0.f, 0.f}, {0.f, 0.f, 0.f, 0.f}}, dk[2] = {{0.f, 0.f, 0.f, 0.f}, {0.f, 0.f, 0.f, 0.f}};
        mm64(L + SA_ATT, L + SA_X1, ta, tb0, lane, dr); mm64(L + SA_M2T, L + SA_X1, ta, tb0, lane, g4); mm64(L + SA_ATT, L + SA_WT, ta, tb0, lane, dp); mm64(L + SA_M2T, L + SA_WT, ta, tb0, lane, dk);
        const LAS float* LWe = (const LAS float*)(L + SA_LW) + 63 * 64;
        f32x4 rk[2], kk2[2];
#pragma unroll
        for (int t2 = 0; t2 < 2; ++t2) { const int j = 16 * (tb0 + t2) + fr; rk[t2] = up4(*(const LAS unsigned long long*)(L + SA_RT + swz(j, i0))); kk2[t2] = up4(*(const LAS unsigned long long*)(L + SA_KPT + swz(j, i0))); }
        __syncthreads();
#pragma unroll
        for (int t2 = 0; t2 < 2; ++t2) { const int j = 16 * (tb0 + t2) + fr;
            dr[t2] = dr[t2] + rk[t2]; dk[t2] = dk[t2] + kk2[t2];
#pragma unroll
            for (int q = 0; q < 4; ++q) if (i0 + q == j) dp[t2][q] += __expf(LWe[j]);
            *(GAS unsigned long long*)(B.RPP + ub + j * 64 + i0) = pk4(dr[t2]);
            *(GAS unsigned long long*)(B.PT + ub + (((i0 >> 4) * 64 + j) * 2 + ((i0 >> 2) & 1)) * 8 + ((i0 >> 3) & 1) * 4) = pk4(dp[t2]);
            *(LAS unsigned long long*)(L + SA_G + swz(j, i0)) = pk4(g4[t2]);
            *(LAS unsigned long long*)(L + SA_KPPT + swz(j, i0)) = pk4(dk[t2]); }
    }
    __syncthreads();
    {
        f32x4 dy[2] = {{0.f, 0.f, 0.f, 0.f}, {0.f, 0.f, 0.f, 0.f}}, dq[2] = {{0.f, 0.f, 0.f, 0.f}, {0.f, 0.f, 0.f, 0.f}};
        mm64(L + SA_VTT, L + SA_G, ta, tb0, lane, dy); mm64(L + SA_KPPT, L + SA_VTT, ta, tb0, lane, dq);
#pragma unroll
        for (int t2 = 0; t2 < 2; ++t2) { const int j = 16 * (tb0 + t2) + fr;
            *(GAS f32x4*)(B.YG + ub + j * 64 + i0) = dy[t2];
            *(GAS f32x4*)(B.QT + ub + (((i0 >> 3) * 64 + j) * 2 + ((i0 >> 2) & 1)) * 4) = dq[t2]; }
    }
    __syncthreads();
}
__device__ __forceinline__ unsigned long long ld8(const bf16_t* p) { return *(const GAS unsigned long long*)p; }
__device__ __forceinline__ void scanB_wave(const bf16_t* PT, const float* QT, bf16_t* SC, int h, int ib, int lane) {
    const int c31 = lane & 31, hh = lane >> 5;
    f32x16_t xa[2];
#pragma unroll
    for (int r = 0; r < 16; ++r) { xa[0][r] = 0.f; xa[1][r] = 0.f; }
    u32x4 pa[2][2][2]; f32x4 qa[2][4];
    auto loadPQ = [&](int c, u32x4 (&p)[2][2][2], f32x4 (&q)[2][4]) {
        const size_t ub = ((size_t)h * NCHUNK + c) * 4096;
#pragma unroll
        for (int a = 0; a < 2; ++a) {
#pragma unroll
            for (int nb = 0; nb < 2; ++nb)
#pragma unroll
                for (int s = 0; s < 2; ++s) p[a][nb][s] = *(const GAS u32x4*)(PT + ub + (((2 * nb + s) * 64 + 32 * a + c31) * 2 + hh) * 8);
#pragma unroll
            for (int g = 0; g < 4; ++g) q[a][g] = *(const GAS f32x4*)(QT + ub + (((4 * a + g) * 64 + 32 * ib + c31) * 2 + hh) * 4); }
    };
    auto step = [&](int c, const u32x4 (&p)[2][2][2], const f32x4 (&q)[2][4]) {
        const size_t ub = ((size_t)h * NCHUNK + c) * 4096;
        bf16x8_t bfrag[2][2];
#pragma unroll
        for (int nb = 0; nb < 2; ++nb) {
#pragma unroll
            for (int s = 0; s < 2; ++s) { u32x4 w;
#pragma unroll
                for (int z = 0; z < 4; ++z) w[z] = pg8::cvt_pk_bf16(xa[nb][8 * s + 2 * z], xa[nb][8 * s + 2 * z + 1]);
                bfrag[nb][s] = __builtin_bit_cast(bf16x8_t, w);
                *(GAS unsigned long long*)(SC + ub + ((4 * nb + 2 * s + 0) * 64 + 32 * ib + c31) * 8 + 4 * hh) = (unsigned long long)w[0] | ((unsigned long long)w[1] << 32);
                *(GAS unsigned long long*)(SC + ub + ((4 * nb + 2 * s + 1) * 64 + 32 * ib + c31) * 8 + 4 * hh) = (unsigned long long)w[2] | ((unsigned long long)w[3] << 32); } }
#pragma unroll
        for (int a = 0; a < 2; ++a) { f32x16_t ya;
#pragma unroll
            for (int r = 0; r < 16; ++r) ya[r] = q[a][r >> 2][r & 3];
#pragma unroll
            for (int nb = 0; nb < 2; ++nb)
#pragma unroll
                for (int s = 0; s < 2; ++s) ya = __builtin_amdgcn_mfma_f32_32x32x16_bf16(__builtin_bit_cast(bf16x8_t, p[a][nb][s]), bfrag[nb][s], ya, 0, 0, 0);
            xa[a] = ya; }
    };
    u32x4 pb[2][2][2]; f32x4 qb[2][4];
    loadPQ(0, pa, qa);
    for (int c = 0; c < NCHUNK; c += 2) {
        loadPQ(c + 1, pb, qb);
        step(c, pa, qa);
        loadPQ(c + 2 < NCHUNK ? c + 2 : c + 1, pa, qa);
        step(c + 1, pb, qb);
    }
}
__device__ __forceinline__ void scanC_unit(LAS unsigned char* L, const bf16_t* SC, const bf16_t* RPP, const float* YG, const bf16_t* EG, const bf16_t* EBV, const float* lnx_w, const float* lnx_b, bf16_t* MIXED,
                                           int h, int c, int tid, int wave, int lane) {
    const size_t ub = ((size_t)h * NCHUNK + c) * 4096;
    { const int row = tid >> 3, k0 = (tid & 7) * 8, srow = tid & 63, sc8 = tid >> 6;
      *(LAS u32x4*)(L + swz(srow, 8 * sc8)) = *(const GAS u32x4*)(SC + ub + (sc8 * 64 + srow) * 8);
      *(LAS u32x4*)(L + 8192 + swz(row, k0)) = *(const GAS u32x4*)(RPP + ub + row * 64 + k0); }
    __syncthreads();
    { const int ta = wave >> 1, tb0 = 2 * (wave & 1), fr = lane & 15, fq = lane >> 4, i0 = 16 * ta + 4 * fq;
      f32x4 d[2] = {{0.f, 0.f, 0.f, 0.f}, {0.f, 0.f, 0.f, 0.f}};
      mm64(L, L + 8192, ta, tb0, lane, d);
#pragma unroll
      for (int t2 = 0; t2 < 2; ++t2) { const int j = 16 * (tb0 + t2) + fr; *(LAS f32x4*)(L + 16384 + (j * 64 + i0) * 4) = d[t2] + *(const GAS f32x4*)(YG + ub + j * 64 + i0); } }
    __syncthreads();
    { const int tau = tid >> 3, i8 = (tid & 7) * 8, t = c * 64 + tau, ch = h * 64 + i8;
      f32x4 y0 = *(const LAS f32x4*)(L + 16384 + (tau * 64 + i8) * 4), y1 = *(const LAS f32x4*)(L + 16384 + (tau * 64 + i8 + 4) * 4);
      const float mean = sum8(((y0[0] + y0[1]) + (y0[2] + y0[3])) + ((y1[0] + y1[1]) + (y1[2] + y1[3]))) * (1.f / 64.f);
      y0 = y0 - mean; y1 = y1 - mean;
      const float rstd = rsqrtf(sum8(((y0[0] * y0[0] + y0[1] * y0[1]) + (y0[2] * y0[2] + y0[3] * y0[3])) + ((y1[0] * y1[0] + y1[1] * y1[1]) + (y1[2] * y1[2] + y1[3] * y1[3]))) * (1.f / 64.f) + LNX_EPS);
      const u32x4 eg = *(const GAS u32x4*)(EG + (size_t)t * RW + ch), eb = *(const GAS u32x4*)(EBV + (size_t)t * RW + ch);
      const f32x4 w0 = *(const GAS f32x4*)(lnx_w + ch), w1 = *(const GAS f32x4*)(lnx_w + ch + 4), b0 = *(const GAS f32x4*)(lnx_b + ch), b1 = *(const GAS f32x4*)(lnx_b + ch + 4);
      float o[8];
#pragma unroll
      for (int e = 0; e < 8; ++e) { const int sh = (e & 1) * 16, q = e >> 1; const float g = __uint_as_float((eg[q] >> sh) << 16), bv = __uint_as_float((eb[q] >> sh) << 16);
          const float yv = e < 4 ? y0[e & 3] : y1[e & 3], lw = e < 4 ? w0[e & 3] : w1[e & 3], lb = e < 4 ? b0[e & 3] : b1[e & 3];
          o[e] = (yv * rstd * lw + lb + bv) * g; }
      u32x4 w;
#pragma unroll
      for (int q = 0; q < 4; ++q) w[q] = pk2(o[2 * q], o[2 * q + 1]);
      *(GAS u32x4*)(MIXED + (size_t)t * DM + ch) = w; }
    __syncthreads();
}
constexpr int MS_ROWS = 320, MS_AP = MS_ROWS / 64  , MS_A = 0, MS_B = 49152, MS_STAGE = 65536;
#define MS_BAR() do { asm volatile("s_waitcnt lgkmcnt(0)" ::: "memory"); __builtin_amdgcn_s_barrier(); asm volatile("" ::: "memory"); } while (0)
template <int MODE>
__device__ __forceinline__ void moe_stream_unit(LAS unsigned char* L, const bf16_t* A, int lda_, const float* W0, const float* W1, int ldw_, int ncol0, int K, int row0, int cnt, bf16_t* HID, float* YC, int tid, int wave, int lane) {
    constexpr int nK = MODE == 0 ? DM / 64 : D_EXP / 64, lda = MODE == 0 ? DM : D_EXP, ldw = MODE == 0 ? D_EXP : DM;
    static_assert(nK % 2 == 0 && nK >= 6, "K-loop rotation");
    (void)K; (void)lda_; (void)ldw_; (void)YC;
    typedef unsigned u32x2_t __attribute__((ext_vector_type(2)));
    const int fr = lane & 15, fq = lane >> 4, wn = wave >> 2, wm = (wave + 2 * wn) & 3;
    const int mh = __builtin_amdgcn_readfirstlane(wave & 1), kq = __builtin_amdgcn_readfirstlane(wave >> 1);
    const float* wbase = (MODE == 0 ? (mh ? W1 : W0) : W0 + mh * 64) + ncol0 + (size_t)(16 * kq) * ldw;
    const __amdgpu_buffer_rsrc_t wrsrc = __builtin_amdgcn_make_buffer_rsrc((void*)wbase, 0, 0x7fffffff, 0x00020000);
    const unsigned wlane = (unsigned)((fq * 4 * ldw + fr * 4) * 4), alane = (unsigned)(((tid >> 3) * lda + (tid & 7) * 8) * 2);
    const int awoff = (tid >> 3) * 128 + (((tid & 7) ^ ((tid >> 3) & 7)) << 4);
    const int bwrow = (mh * 64 + 4 * fr) * 128 + (fq & 1) * 8, bwc = (kq * 2 + (fq >> 1)) ^ (fr & 7) ^ ((fr & 1) << 2);
    const int offk0 = fr * 128 + (((0 + fq) ^ (fr & 7)) << 4) + wm * 2048, offk1 = fr * 128 + (((4 + fq) ^ (fr & 7)) << 4) + wm * 2048;
    const int bnb = MS_B + (MODE == 0 ? 2 * wn : 4 * wn) * 2048;
    const int bkx = fr * 128 + ((fq ^ (fr & 7) ^ (fr >> 2)) << 4) + bnb, bky = bkx ^ 64;
    for (int pass0 = 0; pass0 < cnt; pass0 += MS_ROWS) {
        const int rows = (cnt - pass0) < MS_ROWS ? (cnt - pass0) : MS_ROWS, ntiles = (rows + 15) >> 4;
      auto body = [&](auto nmt_, auto nap_) __attribute__((always_inline)) {
        constexpr int NMT = decltype(nmt_)::value, NAP = decltype(nap_)::value;
        const bf16_t* Ap = A + (size_t)(row0 + pass0) * lda;
        const __amdgpu_buffer_rsrc_t arsrc = __builtin_amdgcn_make_buffer_rsrc((void*)Ap, 0, rows * lda * 2, 0x00020000);
        u32x4 a0[NAP]; f32x4 b0[4];
        f32x4 acc[NMT][4];
#pragma unroll
        for (int i = 0; i < NMT; ++i)
#pragma unroll
            for (int t = 0; t < 4; ++t) acc[i][t] = (f32x4){0.f, 0.f, 0.f, 0.f};
#define MS_LOADA(kt, ar) do { _Pragma("unroll") for (int i = 0; i < NAP; ++i) ar[i] = __builtin_bit_cast(u32x4, __builtin_amdgcn_raw_buffer_load_b128(arsrc, alane, (unsigned)(((64 * i) * lda + (kt) * 64) * 2), 0)); } while (0)
#define MS_LOADW(kt, b) do { _Pragma("unroll") for (int j = 0; j < 4; ++j) b[j] = __builtin_bit_cast(f32x4, __builtin_amdgcn_raw_buffer_load_b128(wrsrc, wlane, (unsigned)((((kt) * 64 + j) * ldw) * 4), 2  )); } while (0)
#define MS_WRITE(st, ar, b) do { _Pragma("unroll") for (int i = 0; i < NAP; ++i) *(LAS u32x4*)(L + awoff + ((st) * MS_STAGE + MS_A + i * 8192)) = ar[i]; \
            _Pragma("unroll") for (int c = 0; c < 4; ++c) { const u32x2_t w_ = {pg8::cvt_pk_bf16(b[0][c], b[1][c]), pg8::cvt_pk_bf16(b[2][c], b[3][c])}; \
                *(LAS u32x2_t*)(L + bwrow + ((bwc ^ c) << 4) + ((st) * MS_STAGE + MS_B + c * 128)) = w_; } } while (0)
        LAS unsigned char* const ak00 = L + offk0 + MS_A, * const ak01 = L + offk1 + MS_A, * const ak10 = L + offk0 + MS_STAGE + MS_A, * const ak11 = L + offk1 + MS_STAGE + MS_A;
        LAS unsigned char* const bk0x = L + bkx, * const bk0y = L + bky, * const bk1x = L + bkx + MS_STAGE, * const bk1y = L + bky + MS_STAGE;
#define MS_DSR(dst, base, off) asm volatile("ds_read_b128 %0, %1 offset:%2" : "=v"(dst) : "v"(base), "n"(off) : "memory")
#define MS_BOFF(t) ((MODE == 0 ? (((t) < 2 ? 0 : 4) + ((t) & 1)) : (t)) * 2048)
#define MS_RD(F, st, ks) do { _Pragma("unroll") for (int i = 0; i < NMT; ++i) MS_DSR(F##a[i], ((st) ? ((ks) ? ak11 : ak10) : ((ks) ? ak01 : ak00)), i * 8192); \
            _Pragma("unroll") for (int t = 0; t < 4; ++t) MS_DSR(F##b[t], ((st) ? ((((ks) ^ t) & 1) ? bk1y : bk1x) : ((((ks) ^ t) & 1) ? bk0y : bk0x)), MS_BOFF(t)); } while (0)
#define MS_TIE8(F) "+v"(F##a[0]), "+v"(F##a[1]), "+v"(F##a[2]), "+v"(F##a[3]), "+v"(F##b[0]), "+v"(F##b[1]), "+v"(F##b[2]), "+v"(F##b[3])
#define MS_WAITL(n, F) do { if constexpr (NMT == 5) asm volatile("s_waitcnt lgkmcnt(" #n ")" : MS_TIE8(F), "+v"(F##a[NMT - 1]) :: "memory"); else asm volatile("s_waitcnt lgkmcnt(" #n ")" : MS_TIE8(F) :: "memory"); } while (0)
#define MS_WAITN(F) do { if constexpr (NMT == 5) asm volatile("s_waitcnt lgkmcnt(9)" : MS_TIE8(F), "+v"(F##a[NMT - 1]) :: "memory"); else asm volatile("s_waitcnt lgkmcnt(8)" : MS_TIE8(F) :: "memory"); } while (0)
#define MS_BART(F) do { if constexpr (NMT == 5) asm volatile("s_waitcnt lgkmcnt(0)\n\ts_barrier" : MS_TIE8(F), "+v"(F##a[NMT - 1]) :: "memory"); else asm volatile("s_waitcnt lgkmcnt(0)\n\ts_barrier" : MS_TIE8(F) :: "memory"); } while (0)
#define MS_MM(F) do { _Pragma("unroll") for (int i = 0; i < NMT; ++i) \
            _Pragma("unroll") for (int t = 0; t < 4; ++t) acc[i][t] = __builtin_amdgcn_mfma_f32_16x16x32_bf16(F##b[t], F##a[i], acc[i][t], 0, 0, 0); } while (0)
#define MS_SB() __builtin_amdgcn_sched_barrier(0)
#define MS_ITER(st, WR, LD) do { MS_RD(f1, st, 1); MS_WAITN(f0); MS_MM(f0); MS_SB(); WR; LD; MS_BART(f1); MS_RD(f0, 1 - (st), 0); MS_MM(f1); MS_SB(); } while (0)
        bf16x8_t f0a[NMT], f0b[4], f1a[NMT], f1b[4];
        MS_LOADA(0, a0); MS_LOADW(0, b0);
        MS_WRITE(0, a0, b0); MS_LOADA(1, a0); MS_LOADW(1, b0);
        MS_BAR();
        MS_RD(f0, 0, 0);
        int kt = 0;
        for (; kt + 4 <= nK; kt += 2) {
            MS_ITER(0, MS_WRITE(1, a0, b0), { MS_LOADA(kt + 2, a0); MS_LOADW(kt + 2, b0); });
            MS_ITER(1, MS_WRITE(0, a0, b0), { MS_LOADA(kt + 3, a0); MS_LOADW(kt + 3, b0); });
        }
        MS_ITER(0, MS_WRITE(1, a0, b0), (void)0);
        MS_RD(f1, 1, 1); MS_WAITN(f0); MS_MM(f0); MS_WAITL(0, f1); MS_MM(f1);
#undef MS_ITER
#undef MS_SB
#undef MS_BART
#undef MS_WAITL
#undef MS_WAITN
#undef MS_TIE8
#undef MS_DSR
#undef MS_MM
#undef MS_RD
#undef MS_BOFF
#undef MS_LOADA
#undef MS_LOADW
#undef MS_WRITE
        const __amdgpu_buffer_rsrc_t orsrc = __builtin_amdgcn_make_buffer_rsrc((void*)HID, 0, 0x7fffffff, 0x00020000);
        const unsigned olane = MODE == 0 ? (unsigned)((fr * D_EXP + 4 * fq) * 2) : (unsigned)((fr * DM + 4 * fq) * 2);
#pragma unroll
        for (int i = 0; i < NMT; ++i) { const int mt = wm + 4 * i; if (mt < ntiles) { const unsigned rowb = (unsigned)(row0 + pass0 + 16 * mt);
            if (MODE == 0) {
#pragma unroll
                for (int t = 0; t < 2; ++t) { f32x4 hv;
#pragma unroll
                    for (int r = 0; r < 4; ++r) { const float gt = acc[i][t][r]; hv[r] = gt * __builtin_amdgcn_rcpf(1.0f + __builtin_amdgcn_exp2f(-1.4426950408889634f * gt)) * acc[i][t + 2][r]; }
                    const u32x2_t w2 = {pg8::cvt_pk_bf16(hv[0], hv[1]), pg8::cvt_pk_bf16(hv[2], hv[3])};
                    __builtin_amdgcn_raw_buffer_store_b64(w2, orsrc, olane, (rowb * D_EXP + ncol0 + 16 * (2 * wn + t)) * 2u, 0); }
            } else {
#pragma unroll
                for (int t = 0; t < 4; ++t) { const u32x2_t w2 = {pg8::cvt_pk_bf16(acc[i][t][0], acc[i][t][1]), pg8::cvt_pk_bf16(acc[i][t][2], acc[i][t][3])};
                    __builtin_amdgcn_raw_buffer_store_b64(w2, orsrc, olane, (rowb * DM + ncol0 + 16 * (4 * wn + t)) * 2u, 0); }
            } } }
      };
        if (rows <= 256) body(std::integral_constant<int, 4>{}, std::integral_constant<int, 4>{});
        else body(std::integral_constant<int, 5>{}, std::integral_constant<int, 5>{});
    }
}
constexpr int NWAVES = 8;
constexpr int RING_OFF = 0, RING_BYTES = 131072;
constexpr int LDSCTL_OFF = RING_BYTES, MISC_OFF = LDSCTL_OFF + 320;
constexpr int LDS_BYTES = 147456;
enum Phase { PH_PRO = 0, PH_INPROJ = 1, PH_MEMPRE = 2, PH_LORA = 3, PH_SCANA = 4, PH_SCANB = 5, PH_SCANC = 6, PH_ATTN = 7, PH_POST = 8, PH_OUTPROJ = 9, PH_HN1 = 10, PH_SCORES = 11, PH_MEMOUT = 12,
             PH_ROUTER = 13, PH_GATHER = 14, PH_GATEUP = 15, PH_DOWN = 16, PH_FINAL = 17, PH_N = 18, PH_X1 = 18, PH_X2 = 19, PH_X3 = 20 };

__device__ __forceinline__ float wave_sum(float v) {
#pragma unroll
    for (int o = 1; o < 64; o <<= 1) v += __shfl_xor(v, o);
    return v;
}
__device__ __forceinline__ void tr_item(const float* W, int pitch, int ncols, int K, bf16_t* WT, int ldt, int mode, LAS float* scr, int item, int lane) {
    const int nblk = ncols / 32, kb = item / nblk, nb = item % nblk, k0 = 64 * kb, n0 = 32 * nb;
#pragma unroll 8
    for (int i = 0; i < 32; ++i) { const int kk = 2 * i + (lane >> 5); scr[kk * 33 + (lane & 31)] = W[(size_t)(k0 + kk) * pitch + n0 + (lane & 31)]; }
    LDS_WAIT(); asm volatile("" ::: "memory");
    const int c = lane & 7;
#pragma unroll
    for (int j = 0; j < 4; ++j) { const int n = (lane >> 3) + 8 * j; const LAS float* s = scr + (8 * c) * 33 + n;
        v4u o; o.x = pk2(s[0 * 33], s[1 * 33]); o.y = pk2(s[2 * 33], s[3 * 33]); o.z = pk2(s[4 * 33], s[5 * 33]); o.w = pk2(s[6 * 33], s[7 * 33]);
        *(GAS v4u*)(WT + (size_t)row_map(mode, n0 + n) * ldt + k0 + 8 * c) = o; }
    LDS_WAIT(); asm volatile("" ::: "memory");
}
__device__ __forceinline__ void tr_job(const float* W, int pitch, int ncols, int K, bf16_t* WT, int mode, int nmat, size_t wstride, size_t tstride, LAS float* scr, int gw, int NGW, int lane, int ldt = 0) {
    if (ldt == 0) ldt = K;
    const int per = (K / 64) * (ncols / 32), total = per * nmat;
    for (int it = gw; it < total; it += NGW) { const int mat = it / per, r = it - mat * per; tr_item(W + (size_t)mat * wstride, pitch, ncols, K, WT + (size_t)mat * tstride, ldt, mode, scr, r, lane); }
}
__device__ __forceinline__ void rms_row_bf16(const float* xrow, const float* g, bf16_t* orow, int lane) {
    const GAS f32x4* xr = (const GAS f32x4*)xrow + lane; const GAS f32x4* gr = (const GAS f32x4*)g + lane;
    f32x4 v[8]; float s = 0.f;
#pragma unroll
    for (int j = 0; j < 8; ++j) { v[j] = xr[64 * j]; s += (v[j].x * v[j].x + v[j].y * v[j].y) + (v[j].z * v[j].z + v[j].w * v[j].w); }
    const float rs = rsqrtf(wave_sum(s) * (1.f / DM) + NORM_EPS);
    GAS unsigned long long* o8 = (GAS unsigned long long*)orow + lane;
#pragma unroll
    for (int j = 0; j < 8; ++j) { const f32x4 gg = gr[64 * j]; o8[64 * j] = (unsigned long long)pk2(v[j].x * rs * gg.x, v[j].y * rs * gg.y) | ((unsigned long long)pk2(v[j].z * rs * gg.z, v[j].w * rs * gg.w) << 32); }
}

__device__ __forceinline__ const float* inf_fresh(const float* p) { asm volatile("" : "+s"(p)); return p; }
struct Args { const float* in[34]; float* out; unsigned char* ws; int ph_lo, ph_hi, li, pad; };
__global__ void __launch_bounds__(NWAVES * 64, 2) mk_fwd(Args args) {
    extern __shared__ __attribute__((aligned(16))) unsigned char lds[];
    LAS unsigned char* const L = (LAS unsigned char*)lds;
    volatile LAS unsigned* const MISC = (volatile LAS unsigned*)(L + MISC_OFF);
    const int tid = threadIdx.x, lane = tid & 63, wave = __builtin_amdgcn_readfirstlane(tid >> 6);
    const int G = gridDim.x; const int bx = blockIdx.x; const int vcu = __builtin_amdgcn_readfirstlane((G % 8 == 0) ? (bx % 8) * (G / 8) + bx / 8 : bx);
    unsigned char* ws = args.ws;
    gu32* ctl = (gu32*)(ws + WS_CTL);
    for (int u = tid; u < (LDS_BYTES - LDSCTL_OFF) / 4; u += NWAVES * 64) ((LAS unsigned*)(L + LDSCTL_OFF))[u] = 0u;
    __syncthreads();
    XcdBarrier bar = xcd_barrier_post((unsigned*)(ctl + CW_BAR) + args.li * XCD_BAR_WORDS, MISC + 8);
    const int lo = args.ph_lo, hi = args.ph_hi;
#define IN(k) (lo <= (k) && (k) < hi)
#define FRESH_IDS int tid_f_ = (int)threadIdx.x; asm volatile("" : "+v"(tid_f_)); const int tid = tid_f_, lane = tid_f_ & 63; (void)tid; (void)lane
#define SEAM(k) do { if ((k) + 1 < hi) xcd_barrier(bar); } while (0)
    const int gw = vcu * NWAVES + wave, NGW = G * NWAVES;
#define WSP(T, off) ((T*)(ws + (off)))
#define INF(i) (args.in[i])
    if (IN(PH_PRO)) {
        FRESH_IDS;
        LAS float* scr = (LAS float*)(L + RING_OFF + wave * 16384);
        tr_job(INF(4), IN_COLS, RWKV_COLS, DM, WSP(bf16_t, WS_WINT), 0, 1, 0, 0, scr, gw, NGW, lane);
        tr_job(INF(4) + RWKV_COLS, IN_COLS, 2 * QK_COLS, DM, WSP(bf16_t, WS_WINT) + (size_t)RWKV_COLS * DM, 1, 1, 0, 0, scr, gw, NGW, lane);
        tr_job(INF(4) + RWKV_COLS + 2 * QK_COLS, IN_COLS, 1024, DM, WSP(bf16_t, WS_WINT) + (size_t)(RWKV_COLS + 2 * QK_COLS) * DM, 0, 1, 0, 0, scr, gw, NGW, lane);
        tr_job(INF(22), DM, DM, DM, WSP(bf16_t, WS_WKVT), 0, 1, 0, 0, scr, gw, NGW, lane);
        tr_job(INF(23), DM, DM, DM, WSP(bf16_t, WS_WKVT) + (size_t)DM * DM, 0, 1, 0, 0, scr, gw, NGW, lane);
        for (int i = gw * 64 + lane; i < SEQ * 32; i += NGW * 64) { const int t = i >> 5, j = i & 31;
            const double inv = pow(10000.0, -(double)j / 32.0), ang = (double)((const int*)INF(2))[t] * inv;
            WSP(float, WS_ROPE)[2 * i] = (float)cos(ang); WSP(float, WS_ROPE)[2 * i + 1] = (float)sin(ang); }
        for (int m = gw; m < SEQ; m += NGW) rms_row_bf16(INF(0) + (size_t)m * DM, INF(3), WSP(bf16_t, WS_XN) + (size_t)m * DM, lane);
        for (int m = gw; m < MEM_LEN; m += NGW) rms_row_bf16(INF(1) + (size_t)m * DM, INF(20), WSP(bf16_t, WS_MEMN) + (size_t)m * DM, lane);
        SEAM(PH_PRO);
    }
    if (IN(PH_INPROJ)) {
        FRESH_IDS;
        { pg8::Gemm g{WSP(bf16_t, WS_XN), WSP(bf16_t, WS_WINT), SEQ, IN_COLS, DM, DM, DM}; pg8::StaticOrder S; S.init(SEQ, IN_COLS, G, bx);
          pg8::EpiInProj E{WSP(bf16_t, WS_PR), WSP(bf16_t, WS_QB), WSP(bf16_t, WS_KB), WSP(bf16_t, WS_VB), WSP(float, WS_ROPE)};
          pg8::gemm_phase<pg8::EpiInProj, pg8::StaticOrder, true, true>(L + RING_OFF, g, S, E); }
        { pg8::Gemm g{WSP(bf16_t, WS_MEMN), WSP(bf16_t, WS_WKVT), MEM_LEN, 2 * DM, DM, DM, DM}; pg8::StaticOrder S; S.init(MEM_LEN, 2 * DM, G, (bx + G - 32) % G);
          pg8::EpiKV E{WSP(bf16_t, WS_KVH)};
          pg8::gemm_phase<pg8::EpiKV, pg8::StaticOrder, true, true>(L + RING_OFF, g, S, E); }
        if (bx >= 48 || G <= 48) { const int gw2 = (G > 48 ? bx - 48 : bx) * NWAVES + wave, NGW2 = (G > 48 ? G - 48 : G) * NWAVES;
            __syncthreads();
            LAS float* scr = (LAS float*)(L + RING_OFF + wave * 16384);
            tr_job(INF(18), DM, DM, DM, WSP(bf16_t, WS_WOUTT), 0, 1, 0, 0, scr, gw2, NGW2, lane);
            tr_job(INF(24), DM, DM, MEM_HD, WSP(bf16_t, WS_WOTH), 0, MEM_HEADS, (size_t)MEM_HD * DM, (size_t)DM * MEM_HD, scr, gw2, NGW2, lane);
            for (int i = gw2 * 64 + lane; i < 80 * DM; i += NGW2 * 64) { const int col = i >> 11, k = i & 2047;
                const float w = col < 8 ? INF(26)[(size_t)k * 8 + col] : (col < 72 ? INF(28)[(size_t)k * 64 + col - 8] : 0.f);
                WSP(float, WS_RT)[i] = w * INF(25)[k]; }
            tr_job(INF(7), RW, RW, 64, WSP(bf16_t, WS_WLORA), 0, 1, 0, 0, scr, gw2, NGW2, lane, 256);
            tr_job(INF(9), RW, RW, 64, WSP(bf16_t, WS_WLORA) + (size_t)1024 * 256 + 64, 0, 1, 0, 0, scr, gw2, NGW2, lane, 256);
            tr_job(INF(10), RW, RW, 128, WSP(bf16_t, WS_WLORA) + (size_t)2048 * 256 + 128, 0, 1, 0, 0, scr, gw2, NGW2, lane, 256);
            for (int i = gw2 * 64 + lane; i < 3072 * 32; i += NGW2 * 64) { const int n = i >> 5, col = (i & 31) * 8, sec = n >> 10;
                const bool inblk = (sec == 0 && col < 64) || (sec == 1 && col >= 64 && col < 128) || (sec == 2 && col >= 128);
                if (!inblk) *(GAS v4u*)(WSP(bf16_t, WS_WLORA) + (size_t)n * 256 + col) = (v4u){0u, 0u, 0u, 0u}; }
            for (int i = gw2 * 64 + lane; i < DM * DM / 8; i += NGW2 * 64) { const int k = i >> 8, gc = (i & 255) * 8, h = gc >> 9, d = gc & 511;
                const f32x4 a = *(const GAS f32x4*)(INF(21) + (size_t)k * DM + gc), b = *(const GAS f32x4*)(INF(21) + (size_t)k * DM + gc + 4);
                v4u o; o.x = pk2(a.x, a.y); o.y = pk2(a.z, a.w); o.z = pk2(b.x, b.y); o.w = pk2(b.z, b.w);
                *(GAS v4u*)(WSP(bf16_t, WS_WQBH) + ((size_t)h * DM + k) * MEM_HD + d) = o; }
        }
        SEAM(PH_INPROJ);
    }
    if (IN(PH_MEMPRE)) {
        FRESH_IDS;
        {
            const float* mu = INF(5);
            for (int i = (bx * NWAVES * 64 + tid); i < SEQ * 32; i += G * NWAVES * 64) { const int t = i >> 5, j0 = (i & 31) * 8;
                const bf16_t* cur = WSP(bf16_t, WS_PR) + (size_t)t * RWKV_COLS + 3072 + j0;
                const u32x4 cv = *(const GAS u32x4*)cur; u32x4 pv = {0u, 0u, 0u, 0u}; if (t > 0) pv = *(const GAS u32x4*)(cur - RWKV_COLS);
                float o[8];
#pragma unroll
                for (int e = 0; e < 8; ++e) { const int sh = (e & 1) * 16, q = e >> 1; const float x = __uint_as_float((cv[q] >> sh) << 16), p = __uint_as_float((pv[q] >> sh) << 16), v = x + (p - x) * mu[3072 + j0 + e];
                    o[e] = j0 < 64 ? tanhf(v) : (j0 < 128 ? v : sigmoidf_(v)); }
                u32x4 w;
#pragma unroll
                for (int q = 0; q < 4; ++q) w[q] = pk2(o[2 * q], o[2 * q + 1]);
                *(GAS u32x4*)(WSP(bf16_t, WS_XL) + (size_t)t * 256 + j0) = w; }
        }
        SEAM(PH_MEMPRE);
    }
    if (IN(PH_LORA)) {
        FRESH_IDS;
        pg8::Gemm g{WSP(bf16_t, WS_XL), WSP(bf16_t, WS_WLORA), SEQ, 3072, 256, 256, 256}; pg8::StaticOrder S; S.init(SEQ, 3072, G, bx);
        pg8::EpiBfGen E{WSP(bf16_t, WS_LG), 3072, 0xffff, 0xffff, 0};
        pg8::gemm_phase<pg8::EpiBfGen, pg8::StaticOrder, false, true>(L + RING_OFF, g, S, E);
        { pg8::Gemm g{WSP(bf16_t, WS_KVH), WSP(bf16_t, WS_WQBH), MEM_HEADS * MEM_LEN, MEM_HEADS * DM, MEM_HD, MEM_HD, MEM_HD}; pg8::HeadOrderS S{G, (bx + G - 128 % G) % G};
          pg8::EpiBfGenCS E{WSP(bf16_t, WS_BTS), DM, 0xffff, 7, 0, INF(19)};
          pg8::gemm_phase<pg8::EpiBfGenCS, pg8::HeadOrderS, true, true>(L + RING_OFF, g, S, E); }
        { pg8::Gemm g{WSP(bf16_t, WS_WOTH), WSP(bf16_t, WS_KVH), MEM_HEADS * DM, 2 * MEM_HEADS * MEM_LEN, MEM_HD, MEM_HD, MEM_HD}; pg8::HeadOrderO S{G, (bx + G - 160 % G) % G};
          pg8::EpiBfGen E{WSP(bf16_t, WS_BTO), MEM_HEADS * MEM_LEN, 7, 0xffff, 4};
          pg8::gemm_phase<pg8::EpiBfGen, pg8::HeadOrderO, true, true>(L + RING_OFF, g, S, E); }
        SEAM(PH_LORA);
    }
    if (IN(PH_SCANA)) {
        FRESH_IDS;
        const ScanW W{INF(5), INF(6), INF(8), INF(11), INF(12), INF(13)};
        const ScanBufs B{WSP(bf16_t, WS_PR), WSP(bf16_t, WS_LG), WSP(bf16_t, WS_RPP), WSP(float, WS_YG), WSP(bf16_t, WS_PT), WSP(float, WS_QT), WSP(bf16_t, WS_EG), WSP(bf16_t, WS_EBV)};
        for (int u = bx; u < NH_R * NCHUNK; u += G) scanA_unit(L + RING_OFF, W, B, u / NCHUNK, u % NCHUNK, tid, wave, lane);
        SEAM(PH_SCANA);
    }
    if (IN(PH_SCANB)) {
        FRESH_IDS;
        if (wave == 0 && bx < 2 * NH_R) scanB_wave(WSP(bf16_t, WS_PT), WSP(float, WS_QT), WSP(bf16_t, WS_SC), bx >> 1, bx & 1, lane);
        {
            static_assert(attn_body::ATTN_LDS_BYTES <= RING_BYTES, "attention body LDS");
            const attn_body::AttnTensors AT{(const attn_body::bf16*)WSP(bf16_t, WS_QB), (const attn_body::bf16*)WSP(bf16_t, WS_KB), (const attn_body::bf16*)WSP(bf16_t, WS_VB), (attn_body::bf16*)WSP(bf16_t, WS_O2)};
            const attn_body::QueueOrder S{(unsigned*)(ctl + CW_AQ), MISC + 16, bx & 7};
            attn_body::attn_phase<attn_body::QueueOrder>((char*)lds + RING_OFF, AT, S);
        }
        SEAM(PH_SCANB);
    }
    if (IN(PH_SCANC)) {
        FRESH_IDS;
        for (int u = bx; u < NH_R * NCHUNK; u += G)
            scanC_unit(L + RING_OFF, WSP(bf16_t, WS_SC), WSP(bf16_t, WS_RPP), WSP(float, WS_YG), WSP(bf16_t, WS_EG), WSP(bf16_t, WS_EBV), INF(14), INF(15), WSP(bf16_t, WS_MIXED), u / NCHUNK, u % NCHUNK, tid, wave, lane);
        __syncthreads();
    }
    if (IN(PH_POST)) {
        FRESH_IDS;
        const float* lp = INF(16); const float lam = __expf(wave_allsum(lp[lane] * lp[64 + lane])) - __expf(wave_allsum(lp[128 + lane] * lp[192 + lane])) + LAMBDA_INIT;
        const int hw = tid >> 8, lt = tid & 255;
        for (int t = bx * 2 + hw; t < SEQ; t += 2 * G) diff_post_token(WSP(bf16_t, WS_O2), lam, INF(17), WSP(bf16_t, WS_MIXED), t, lt);
        SEAM(PH_POST);
    }
    if (IN(PH_OUTPROJ)) {
        FRESH_IDS;
        pg8::Gemm g{WSP(bf16_t, WS_MIXED), WSP(bf16_t, WS_WOUTT), SEQ, DM, DM, DM, DM}; pg8::StaticOrder S; S.init(SEQ, DM, G, bx);
        pg8::EpiResidSq E{INF(0), WSP(float, WS_H1), WSP(bf16_t, WS_HN1), WSP(float, WS_PSQ)};
        pg8::gemm_phase<pg8::EpiResidSq, pg8::StaticOrder, false, true>(L + RING_OFF, g, S, E);
        SEAM(PH_OUTPROJ);
    }
    if (IN(PH_HN1)) {
        FRESH_IDS;
    }
    if (IN(PH_SCORES)) {
        FRESH_IDS;
        pg8::Gemm g{WSP(bf16_t, WS_HN1), WSP(bf16_t, WS_BTS), SEQ, MEM_HEADS * MEM_LEN, DM, DM, DM}; pg8::StaticOrder S; S.init(SEQ, MEM_HEADS * MEM_LEN, G, bx);
        pg8::EpiSoftmax E{WSP(bf16_t, WS_PM), 0.044194173824159216f * 1.4426950408889634f};
        pg8::gemm_phase<pg8::EpiSoftmax, pg8::StaticOrder, false, true>(L + RING_OFF, g, S, E);
        SEAM(PH_SCORES);
    }
    if (IN(PH_MEMOUT)) {
        FRESH_IDS;
        pg8::Gemm g{WSP(bf16_t, WS_PM), WSP(bf16_t, WS_BTO), SEQ, DM, MEM_HEADS * MEM_LEN, MEM_HEADS * MEM_LEN, MEM_HEADS * MEM_LEN}; pg8::StaticOrder S; S.init(SEQ, DM, G, bx);
        pg8::EpiResid E{WSP(float, WS_H1), WSP(float, WS_H2)};
        pg8::gemm_phase<pg8::EpiResid, pg8::StaticOrder, false, true>(L + RING_OFF, g, S, E);
        SEAM(PH_MEMOUT);
    }
    if (IN(PH_ROUTER)) {
        FRESH_IDS;
        LAS float* part = (LAS float*)(L + RING_OFF);
        LAS float* ssq = (LAS float*)(L + RING_OFF + 40960);
        const int tl = wave >> 2, kq = wave & 3, fr = lane & 15, fq = lane >> 4;
        int* asg_e = WSP(int, WS_ASG); int* asg_r = asg_e + 2 * SEQ; float* asg_w = (float*)(asg_r + 2 * SEQ);
        for (int it = 0; it < (SEQ / 32 + G - 1) / G; ++it) { const int blk = it * G + bx; const bool on = blk < SEQ / 32; const int t0 = blk * 32 + tl * 16;
            __syncthreads();
            if (on) {
                f32x4 acc[5]; float sq = 0.f;
#pragma unroll
                for (int ct = 0; ct < 5; ++ct) acc[ct] = (f32x4){0.f, 0.f, 0.f, 0.f};
                const GAS float* ap = (const GAS float*)WSP(float, WS_H2) + (size_t)(t0 + fr) * DM + kq * 512 + 4 * fq;
                const GAS float* bp = (const GAS float*)WSP(float, WS_RT) + (size_t)fr * DM + kq * 512 + 4 * fq;
#pragma unroll 2
                for (int kb = 0; kb < 32; ++kb) { const f32x4 av = *(const GAS f32x4*)(ap + kb * 16); f32x4 bv[5];
#pragma unroll
                    for (int ct = 0; ct < 5; ++ct) bv[ct] = *(const GAS f32x4*)(bp + (size_t)ct * 16 * DM + kb * 16);
                    sq += (av[0] * av[0] + av[1] * av[1]) + (av[2] * av[2] + av[3] * av[3]);
#pragma unroll
                    for (int j = 0; j < 4; ++j)
#pragma unroll
                        for (int ct = 0; ct < 5; ++ct) acc[ct] = __builtin_amdgcn_mfma_f32_16x16x4f32(av[j], bv[ct][j], acc[ct], 0, 0, 0); }
                sq = rowpair_sum(sq); { float a2 = sq, b2 = sq; asm("s_nop 1\n\tv_permlane32_swap_b32 %0, %1" : "+v"(a2), "+v"(b2)); sq = a2 + b2; }
                if (fq == 0) ssq[(tl * 4 + kq) * 16 + fr] = sq;
#pragma unroll
                for (int ct = 0; ct < 5; ++ct)
#pragma unroll
                    for (int r = 0; r < 4; ++r) part[((tl * 4 + kq) * 16 + 4 * fq + r) * 80 + ct * 16 + fr] = acc[ct][r]; }
            __syncthreads();
            if (on && tid < 32) { const int tk = tid & 15, tt = tid >> 4, t = blk * 32 + tt * 16 + tk;
                const float s = (ssq[(tt * 4 + 0) * 16 + tk] + ssq[(tt * 4 + 1) * 16 + tk]) + (ssq[(tt * 4 + 2) * 16 + tk] + ssq[(tt * 4 + 3) * 16 + tk]);
                const float rs = rsqrtf(s * (1.f / DM) + NORM_EPS); WSP(float, WS_RS)[t] = rs;
                const LAS float* p0 = part + ((tt * 4 + 0) * 16 + tk) * 80; const float *bg = INF(27), *be = INF(29);
#define LGT(c) ((((p0[c] + p0[1280 + (c)]) + (p0[2560 + (c)] + p0[3840 + (c)])) * rs) + ((c) < 8 ? bg[c] : be[(c) - 8]))
                float gl[8];
#pragma unroll
                for (int i = 0; i < 8; ++i) gl[i] = LGT(i);
                int gi = 0; float gm = gl[0];
#pragma unroll
                for (int i = 1; i < 8; ++i) if (gl[i] > gm) { gm = gl[i]; gi = i; }
                float gs = 0.f;
#pragma unroll
                for (int i = 0; i < 8; ++i) gs += expf(gl[i] - gm);
                const float gwt = 1.f / gs;
                float el[8];
                for (int i = 0; i < 8; ++i) el[i] = LGT(8 + gi * 8 + i);
                int i0 = 0; for (int i = 1; i < 8; ++i) if (el[i] > el[i0]) i0 = i;
                int i1 = -1; for (int i = 0; i < 8; ++i) if (i != i0 && (i1 < 0 || el[i] > el[i1])) i1 = i;
#undef LGT
                const float p1 = expf(el[i1] - el[i0]), w0 = gwt / (1.f + p1), w1 = gwt * p1 / (1.f + p1);
                const int e0 = gi * 8 + i0, e1 = gi * 8 + i1;
                asg_e[2 * t] = e0; asg_e[2 * t + 1] = e1; asg_w[2 * t] = w0; asg_w[2 * t + 1] = w1;
                asg_r[2 * t] = (int)atomicAdd((unsigned*)(ctl + CW_CNT + e0), 1u); asg_r[2 * t + 1] = (int)atomicAdd((unsigned*)(ctl + CW_CNT + e1), 1u); } }
        SEAM(PH_ROUTER);
    }
    if (IN(PH_GATHER)) {
        FRESH_IDS;
        LAS unsigned* sb = (LAS unsigned*)(L + RING_OFF);
        if (tid == 0) { unsigned b = 0; int nt = 0;
            for (int e = 0; e < N_EXP; ++e) { sb[e] = b; const unsigned n = (__hip_atomic_load(ctl + CW_CNT + e, RLX_AGENT) + 255u) / 256u;
                if (bx == 0) { __hip_atomic_store(ctl + CW_BASE + e, b, RLX_AGENT); for (unsigned i = 0; i < n; ++i) __hip_atomic_store(ctl + CW_TILEE + nt + (int)i, (unsigned)e, RLX_AGENT); }
                nt += (int)n; b += n * 256u; }
            if (bx == 0) __hip_atomic_store(ctl + CW_NT, (unsigned)nt, RLX_AGENT); }
        __syncthreads();
        const int* asg_e = WSP(int, WS_ASG); const int* asg_r = asg_e + 2 * SEQ;
        for (int t = gw; t < SEQ; t += NGW) { const GAS f32x4* src = (const GAS f32x4*)(WSP(float, WS_H2) + (size_t)t * DM) + lane; const GAS f32x4* gp = (const GAS f32x4*)INF(25) + lane; const float rs = WSP(float, WS_RS)[t];
            unsigned long long r[8];
#pragma unroll
            for (int i = 0; i < 8; ++i) { const f32x4 v = src[64 * i] * gp[64 * i] * rs; r[i] = (unsigned long long)pk2(v[0], v[1]) | ((unsigned long long)pk2(v[2], v[3]) << 32); }
#pragma unroll
            for (int j = 0; j < 2; ++j) { const size_t row = sb[asg_e[2 * t + j]] + (unsigned)asg_r[2 * t + j]; GAS unsigned long long* dst = (GAS unsigned long long*)(WSP(bf16_t, WS_XG) + row * DM) + lane;
#pragma unroll
                for (int i = 0; i < 8; ++i) dst[64 * i] = r[i]; } }
        SEAM(PH_GATHER);
    }
    if (IN(PH_GATEUP)) {
        FRESH_IDS;
        for (int u = vcu; u < N_EXP * 16; u += G) { const int e = u >> 4, nt = u & 15;
            const int cnt = __builtin_amdgcn_readfirstlane((int)__hip_atomic_load(ctl + CW_CNT + e, RLX_AGENT)), row0 = __builtin_amdgcn_readfirstlane((int)__hip_atomic_load(ctl + CW_BASE + e, RLX_AGENT));
            moe_stream_unit<0>(L + RING_OFF, WSP(bf16_t, WS_XG), DM, INF(30) + (size_t)e * DM * D_EXP, INF(31) + (size_t)e * DM * D_EXP, D_EXP, 64 * nt, DM, row0, cnt, WSP(bf16_t, WS_HID), nullptr, tid, wave, lane); }
        SEAM(PH_GATEUP);
    }
    if (IN(PH_DOWN)) {
        FRESH_IDS;
        for (int u = vcu; u < N_EXP * 16; u += G) { const int e = u >> 4, nt = u & 15;
            const int cnt = __builtin_amdgcn_readfirstlane((int)__hip_atomic_load(ctl + CW_CNT + e, RLX_AGENT)), row0 = __builtin_amdgcn_readfirstlane((int)__hip_atomic_load(ctl + CW_BASE + e, RLX_AGENT));
            moe_stream_unit<1>(L + RING_OFF, WSP(bf16_t, WS_HID), D_EXP, INF(32) + (size_t)e * D_EXP * DM, nullptr, DM, 128 * nt, D_EXP, row0, cnt, WSP(bf16_t, WS_YC), nullptr, tid, wave, lane); }
        SEAM(PH_DOWN);
    }
    if (IN(PH_FINAL)) {
        FRESH_IDS;
        __syncthreads();
        LAS unsigned* sb = (LAS unsigned*)(L + RING_OFF);
        if (tid < N_EXP) sb[tid] = __hip_atomic_load(ctl + CW_BASE + tid, RLX_AGENT);
        __syncthreads();
        const int* asg_e = WSP(int, WS_ASG); const int* asg_r = asg_e + 2 * SEQ; const float* asg_w = (const float*)(asg_r + 2 * SEQ);
        for (int t = gw; t < SEQ; t += NGW) {
            const size_t r0 = sb[asg_e[2 * t]] + (unsigned)asg_r[2 * t], r1 = sb[asg_e[2 * t + 1]] + (unsigned)asg_r[2 * t + 1]; const float w0 = asg_w[2 * t], w1 = asg_w[2 * t + 1];
            const GAS f32x4* hp = (const GAS f32x4*)(WSP(float, WS_H2) + (size_t)t * DM) + lane; typedef unsigned u32x2_t __attribute__((ext_vector_type(2)));
            const GAS u32x2_t* y0 = (const GAS u32x2_t*)(WSP(bf16_t, WS_YC) + r0 * DM) + lane; const GAS u32x2_t* y1 = (const GAS u32x2_t*)(WSP(bf16_t, WS_YC) + r1 * DM) + lane;
            f32x4 v[8]; float s = 0.f;
#pragma unroll
            for (int j = 0; j < 8; ++j) { const u32x2_t ya = y0[64 * j], yb = y1[64 * j];
                const f32x4 fa = {__uint_as_float(ya[0] << 16), __uint_as_float(ya[0] & 0xffff0000u), __uint_as_float(ya[1] << 16), __uint_as_float(ya[1] & 0xffff0000u)};
                const f32x4 fb = {__uint_as_float(yb[0] << 16), __uint_as_float(yb[0] & 0xffff0000u), __uint_as_float(yb[1] << 16), __uint_as_float(yb[1] & 0xffff0000u)};
                v[j] = hp[64 * j] + (fa * w0 + fb * w1); s += (v[j][0] * v[j][0] + v[j][1] * v[j][1]) + (v[j][2] * v[j][2] + v[j][3] * v[j][3]); }
            const float rs = rsqrtf(wave_allsum(s) * (1.f / DM) + NORM_EPS); const GAS f32x4* gp = (const GAS f32x4*)INF(33) + lane; GAS f32x4* op = (GAS f32x4*)(args.out + (size_t)t * DM) + lane;
#pragma unroll
            for (int j = 0; j < 8; ++j) op[64 * j] = v[j] * rs * gp[64 * j]; }
    }
#if MK_PROBE >= 18
    if (IN(PH_X1) || IN(PH_X2) || IN(PH_X3)) {
        f32x4 s = {0.f, 0.f, 0.f, 0.f};
        if (IN(PH_X1)) {
#ifndef MK_XW
#define MK_XW 4
#endif
            if (wave < MK_XW) for (int u = vcu; u < N_EXP * 16; u += G) { const int e = u >> 4, nt = u & 15;
                for (int m = 0; m < 2; ++m) { const float* wb = (m ? INF(31) : INF(30)) + (size_t)e * DM * D_EXP + 64 * nt + (lane & 15) * 4;
                for (int k0 = wave * 4 + (lane >> 4); k0 < DM; k0 += 16 * 4 * MK_XW) { f32x4 v[16];
#pragma unroll
                    for (int j = 0; j < 16; ++j) v[j] = *(const GAS f32x4*)(wb + (size_t)(k0 + 4 * MK_XW * j) * D_EXP);
#pragma unroll
                    for (int j = 0; j < 16; ++j) s += v[j]; } } } }
        if (IN(PH_X2)) {
        FRESH_IDS;
            const size_t total = (size_t)N_EXP * DM * D_EXP / 4;
            for (int m = 0; m < 2; ++m) { const GAS f32x4* p = (const GAS f32x4*)(m ? INF(31) : INF(30));
                for (size_t i = (size_t)gw * 64 + lane; i < total; i += (size_t)NGW * 64 * 8) { f32x4 v[8];
#pragma unroll
                    for (int j = 0; j < 8; ++j) { const size_t q = i + (size_t)j * NGW * 64; v[j] = q < total ? p[q] : (f32x4){0.f, 0.f, 0.f, 0.f}; }
#pragma unroll
                    for (int j = 0; j < 8; ++j) s += v[j]; } } }
        if (IN(PH_X3)) {
        FRESH_IDS;
            for (int u = vcu; u < N_EXP * 16; u += G) { const int e = u >> 4, kb = u & 15;
                for (int m = 0; m < 2; ++m) { const GAS f32x4* p = (const GAS f32x4*)((m ? INF(31) : INF(30)) + (size_t)e * DM * D_EXP + (size_t)kb * 128 * D_EXP);
                    for (int i = tid; i < 128 * D_EXP / 4; i += 512 * 8) { f32x4 v[8];
#pragma unroll
                        for (int j = 0; j < 8; ++j) v[j] = p[i + 512 * j];
#pragma unroll
                        for (int j = 0; j < 8; ++j) s += v[j]; } } } }
        if (s[0] + s[1] + s[2] + s[3] == 123.456f) WSP(float, WS_RS)[SEQ + tid] = s[0];
    }
#endif
#undef IN
#undef SEAM
#undef FRESH_IDS
#undef WSP
#undef INF
}

__global__ void k_transpose(const float* W, int K, int N, bf16_t* WT, int mode, int rowoff, size_t wstride, int rows_per_z) {
    __shared__ float t[32][33];
    W += (size_t)blockIdx.z * wstride; rowoff += blockIdx.z * rows_per_z;
    const int n0 = blockIdx.x * 32, k0 = blockIdx.y * 32, tx = threadIdx.x & 31, ty = threadIdx.x >> 5;
    for (int i = 0; i < 4; ++i) t[ty + 8 * i][tx] = W[(size_t)(k0 + ty + 8 * i) * N + n0 + tx];
    __syncthreads();
    for (int i = 0; i < 4; ++i) { const int n = n0 + ty + 8 * i; int r = n;
        if (mode == 1) r = (n & ~63) + rope_phys(n & 63);
        else if (mode == 2) r = (n >> 7) * 256 + (n & 127);
        else if (mode == 3) r = (n >> 7) * 256 + 128 + (n & 127);
        WT[(size_t)(rowoff + r) * K + k0 + tx] = f2bf(t[tx][ty + 8 * i]); }
}
__global__ void k_wqbh(const float* wq, bf16_t* O) { const size_t i = (size_t)blockIdx.x * blockDim.x + threadIdx.x; const int k = (int)(i >> 11), n = (int)(i & 2047); O[((size_t)(n >> 9) * DM + k) * MEM_HD + (n & 511)] = f2bf(wq[i]); }
__global__ void k_rmsnorm_bf16(const float* x, const float* g, bf16_t* out) {
    __shared__ float red[4];
    const float* xr = x + (size_t)blockIdx.x * DM; const int tid = threadIdx.x;
    float v[8]; float s = 0.f;
    for (int i = 0; i < 8; ++i) { v[i] = xr[tid + 256 * i]; s += v[i] * v[i]; }
    for (int o = 32; o > 0; o >>= 1) s += __shfl_xor(s, o);
    if ((tid & 63) == 0) red[tid >> 6] = s;
    __syncthreads();
    const float rs = rsqrtf((red[0] + red[1] + red[2] + red[3]) * (1.f / DM) + NORM_EPS);
    for (int i = 0; i < 8; ++i) out[(size_t)blockIdx.x * DM + tid + 256 * i] = f2bf(v[i] * rs * g[tid + 256 * i]);
}
__global__ void k_rope_table(const int* pos, float* tab) {
    const int i = blockIdx.x * blockDim.x + threadIdx.x; if (i >= SEQ * 32) return;
    const int t = i >> 5, j = i & 31;
    const double inv = pow(10000.0, -(double)j / 32.0), ang = (double)pos[t] * inv;
    tab[2 * i] = (float)cos(ang); tab[2 * i + 1] = (float)sin(ang);
}

struct NEpiInProj { bf16_t* PR; float* QKraw; bf16_t* Vb;
    __device__ void operator()(int m, int n, const float* v) const {
        if (n < RWKV_COLS) { for (int i = 0; i < 4; ++i) PR[(size_t)m * RWKV_COLS + n + i] = f2bf(v[i]); }
        else if (n < RWKV_COLS + 2 * QK_COLS) { for (int i = 0; i < 4; ++i) QKraw[(size_t)m * 2048 + (n - RWKV_COLS) + i] = v[i]; }
        else { for (int i = 0; i < 4; ++i) Vb[(size_t)m * 1024 + (n - RWKV_COLS - 2 * QK_COLS) + i] = f2bf(v[i]); } } };
struct NEpiBf { bf16_t* C; int ldc; int pad = 0; __device__ void operator()(int m, int n, const float* v) const { for (int i = 0; i < 4; ++i) C[(size_t)m * ldc + n + i] = f2bf(v[i]); } };
struct NEpiF32 { float* C; int ldc; int pad = 0; __device__ void operator()(int m, int n, const float* v) const { for (int i = 0; i < 4; ++i) C[(size_t)m * ldc + n + i] = v[i]; } };
struct NEpiResid { const float* base; float* out; int ldc; int pad = 0; __device__ void operator()(int m, int n, const float* v) const { for (int i = 0; i < 4; ++i) out[(size_t)m * ldc + n + i] = base[(size_t)m * ldc + n + i] + v[i]; } };

template <class Epi>
__global__ void __launch_bounds__(256) k_gemm(const bf16_t* A, int lda, const bf16_t* Bt, int ldb, int K, Epi epi, const unsigned* ctl, int eStrideB) {
    __shared__ float As[32][68], Bs[32][68];
    const int tid = threadIdx.x, m0 = blockIdx.y * 64, n0 = blockIdx.x * 64;
    if (ctl) { if ((m0 >> 8) >= (int)ctl[CW_NT]) return; Bt += (size_t)ctl[CW_TILEE + (m0 >> 8)] * eStrideB * ldb; }
    const int lr = tid >> 2, lc = (tid & 3) * 8;
    const int ty = tid >> 4, tx = tid & 15;
    float acc[4][4] = {};
    for (int k0 = 0; k0 < K; k0 += 32) {
        const u32x4 av = *(const u32x4*)(A + (size_t)(m0 + lr) * lda + k0 + lc);
        const u32x4 bv = *(const u32x4*)(Bt + (size_t)(n0 + lr) * ldb + k0 + lc);
        __syncthreads();
        for (int i = 0; i < 4; ++i) { As[lc + 2 * i][lr] = __uint_as_float(av[i] << 16); As[lc + 2 * i + 1][lr] = __uint_as_float(av[i] & 0xffff0000u);
                                      Bs[lc + 2 * i][lr] = __uint_as_float(bv[i] << 16); Bs[lc + 2 * i + 1][lr] = __uint_as_float(bv[i] & 0xffff0000u); }
        __syncthreads();
#pragma unroll 8
        for (int k = 0; k < 32; ++k) { const f32x4 a = *(const f32x4*)&As[k][ty * 4], b = *(const f32x4*)&Bs[k][tx * 4];
            for (int i = 0; i < 4; ++i) for (int j = 0; j < 4; ++j) acc[i][j] += a[i] * b[j]; }
    }
    for (int i = 0; i < 4; ++i) epi(m0 + ty * 4 + i, n0 + tx * 4, acc[i]);
}

__global__ void k_rope_apply(const float* QKraw, const float* tab, bf16_t* Qb, bf16_t* Kb) {
    const int t = blockIdx.x;
    for (int idx = threadIdx.x; idx < 1024; idx += 256) { const int which = idx >> 9, sh = (idx >> 5) & 15, j = idx & 31;
        const int plo = 8 * (j >> 2) + (j & 3), phi = plo + 4;
        const float* src = QKraw + (size_t)t * 2048 + which * 1024 + sh * 64;
        const float x1 = src[plo], x2 = src[phi], c = tab[((size_t)t * 32 + j) * 2], s = tab[((size_t)t * 32 + j) * 2 + 1];
        const float sc = which == 0 ? C2 : 1.f;
        bf16_t* dst = (which == 0 ? Qb : Kb) + (size_t)t * 1024 + sh * 64;
        dst[plo] = f2bf((x1 * c - x2 * s) * sc); dst[phi] = f2bf((x1 * s + x2 * c) * sc); }
}

__global__ void __launch_bounds__(256) k_prep(const bf16_t* PR, PrepW P, float* S0, float* BONUS) {
    __shared__ float xs[256];
    const int t = blockIdx.x, tid = threadIdx.x;
    const bf16_t* cur = PR + (size_t)t * RWKV_COLS; const bf16_t* prv = cur - RWKV_COLS;
    auto shifted = [&](int c) { const float a = bf2f(cur[c]), p = t > 0 ? bf2f(prv[c]) : 0.f; return a + (p - a) * P.mu[c]; };
    { const float v = shifted(3072 + tid); xs[tid] = tid < 64 ? tanhf(v) : (tid < 128 ? v : sigmoidf_(v)); }
    __syncthreads();
    float lw[4], la[4], lg[4] = {0.f, 0.f, 0.f, 0.f};
    for (int i = 0; i < 4; ++i) { lw[i] = P.w0[tid * 4 + i]; la[i] = P.a0[tid * 4 + i]; }
#pragma unroll 4
    for (int j = 0; j < 64; ++j) { const f32x4 w = *(const f32x4*)(P.w2 + (size_t)j * RW + tid * 4), a = *(const f32x4*)(P.a2 + (size_t)j * RW + tid * 4);
        for (int i = 0; i < 4; ++i) { lw[i] += xs[j] * w[i]; la[i] += xs[64 + j] * a[i]; } }
#pragma unroll 4
    for (int j = 0; j < 128; ++j) { const f32x4 g = *(const f32x4*)(P.g2 + (size_t)j * RW + tid * 4); for (int i = 0; i < 4; ++i) lg[i] += xs[128 + j] * g[i]; }
    float r[4], k0[4], v[4], kk[4], a[4], ss = 0.f;
    for (int i = 0; i < 4; ++i) { const int c = tid * 4 + i; r[i] = shifted(c); k0[i] = shifted(1024 + c); v[i] = shifted(2048 + c);
        a[i] = sigmoidf_(la[i]); kk[i] = k0[i] * P.k_k[c]; ss += kk[i] * kk[i]; }
    for (int o = 1; o < 16; o <<= 1) ss += __shfl_xor(ss, o);
    const float inv = 1.f / fmaxf(sqrtf(ss), 1e-12f);
    float bon = 0.f; const size_t ob = (size_t)t * RW + tid * 4; constexpr size_t SS = (size_t)SEQ * RW;
    for (int i = 0; i < 4; ++i) { const int c = tid * 4 + i;
        const float x = -lw[i], sp = fmaxf(x, 0.f) + log1pf(__expf(-fabsf(x))), wraw = -sp - 0.5f, dec = __expf(-__expf(wraw));
        const float kn = kk[i] * inv, k = k0[i] * (1.f + (a[i] - 1.f) * P.k_a[c]);
        bon += r[i] * k * P.r_k[c];
        S0[0 * SS + ob + i] = r[i]; S0[1 * SS + ob + i] = dec; S0[2 * SS + ob + i] = k; S0[3 * SS + ob + i] = v[i];
        S0[4 * SS + ob + i] = -kn; S0[5 * SS + ob + i] = kn * a[i]; S0[6 * SS + ob + i] = lg[i]; }
    for (int o = 1; o < 16; o <<= 1) bon += __shfl_xor(bon, o);
    if ((tid & 15) == 0) BONUS[t * 16 + (tid >> 4)] = bon;
}
__global__ void __launch_bounds__(256) k_scan(const float* S0, float* Y) {
    const int w = blockIdx.x * 4 + (threadIdx.x >> 6), lane = threadIdx.x & 63, h = w >> 6, vr = w & 63;
    constexpr size_t SS = (size_t)SEQ * RW;
    const float* pr = S0 + h * 64 + lane; float s = 0.f;
    for (int t = 0; t < SEQ; ++t) { const size_t o = (size_t)t * RW;
        const float r = pr[o], wd = pr[SS + o], k = pr[2 * SS + o], a = pr[4 * SS + o], b = pr[5 * SS + o], v = S0[3 * SS + o + h * 64 + vr];
        float sa = s * a; for (int x = 32; x > 0; x >>= 1) sa += __shfl_xor(sa, x);
        s = s * wd + sa * b + v * k;
        float y = s * r; for (int x = 32; x > 0; x >>= 1) y += __shfl_xor(y, x);
        if (lane == 0) Y[o + h * 64 + vr] = y; }
}
__global__ void __launch_bounds__(256) k_rwkv_post(const float* Y, const float* S0, const float* BONUS, const float* lnx_w, const float* lnx_b, bf16_t* MIXED) {
    const int t = blockIdx.x, tid = threadIdx.x; constexpr size_t SS = (size_t)SEQ * RW; const size_t ob = (size_t)t * RW + tid * 4;
    float y[4], s = 0.f; for (int i = 0; i < 4; ++i) { y[i] = Y[ob + i]; s += y[i]; }
    for (int o = 1; o < 16; o <<= 1) s += __shfl_xor(s, o);
    const float mean = s * (1.f / 64.f); float q = 0.f; for (int i = 0; i < 4; ++i) { y[i] -= mean; q += y[i] * y[i]; }
    for (int o = 1; o < 16; o <<= 1) q += __shfl_xor(q, o);
    const float rstd = rsqrtf(q * (1.f / 64.f) + LNX_EPS), bon = BONUS[t * 16 + (tid >> 4)];
    for (int i = 0; i < 4; ++i) { const int c = tid * 4 + i; const float o = (y[i] * rstd * lnx_w[c] + lnx_b[c] + bon * S0[3 * SS + ob + i]) * S0[6 * SS + ob + i];
        MIXED[(size_t)t * DM + c] = f2bf(o); }
}
__global__ void __launch_bounds__(64) k_attn(const bf16_t* Qb, const bf16_t* Kb, const bf16_t* Vb, bf16_t* O2) {
    const int row = blockIdx.x * 64 + threadIdx.x, sh = blockIdx.y, qt = blockIdx.z;
    float q[64], o[32]; for (int d = 0; d < 64; ++d) q[d] = bf2f(Qb[(size_t)row * 1024 + sh * 64 + d]);
    for (int d = 0; d < 32; ++d) o[d] = 0.f;
    float m = -1e30f, l = 0.f; const int jmax = blockIdx.x * 64 + 63;
    const bf16_t* kp = Kb + sh * 64; const bf16_t* vp = Vb + (sh >> 1) * 128 + qt * 32;
    for (int j = 0; j <= jmax; ++j) {
        float s = 0.f; for (int d = 0; d < 64; ++d) s += q[d] * bf2f(kp[(size_t)j * 1024 + d]);
        if (j <= row) { const float mn = fmaxf(m, s), f = exp2f(m - mn), p = exp2f(s - mn); l = l * f + p; m = mn;
            for (int d = 0; d < 32; ++d) o[d] = o[d] * f + p * bf2f(vp[(size_t)j * 1024 + d]); } }
    const float il = 1.f / l;
    for (int d = 0; d < 32; ++d) O2[(size_t)(qt >> 1) * SEQ * 1024 + (size_t)row * 1024 + sh * 64 + (qt & 1) * 32 + d] = f2bf(o[d] * il);
}
__global__ void __launch_bounds__(256) k_diff_post(const bf16_t* O2, const float* lambdas, const float* subln_w, bf16_t* MIXED) {
    __shared__ float lamsh;
    const int t = blockIdx.x, tid = threadIdx.x;
    if (tid < 64) { float a = lambdas[tid] * lambdas[64 + tid], b = lambdas[128 + tid] * lambdas[192 + tid];
        for (int o = 32; o > 0; o >>= 1) { a += __shfl_xor(a, o); b += __shfl_xor(b, o); }
        if (tid == 0) lamsh = expf(a) - expf(b) + LAMBDA_INIT; }
    __syncthreads();
    const float lam = lamsh; const int h = tid >> 5, d0 = (tid & 31) * 4;
    float o[4], q = 0.f;
    const bf16_t* ob = O2 + (size_t)(d0 >> 6) * SEQ * 1024 + (size_t)t * 1024 + (d0 & 63);
    for (int i = 0; i < 4; ++i) { o[i] = bf2f(ob[(2 * h) * 64 + i]) - lam * bf2f(ob[(2 * h + 1) * 64 + i]); q += o[i] * o[i]; }
    for (int x = 1; x < 32; x <<= 1) q += __shfl_xor(q, x);
    const float rs = rsqrtf(q * (1.f / 128.f) + SUBLN_EPS) * (1.f - LAMBDA_INIT);
    for (int i = 0; i < 4; ++i) MIXED[(size_t)t * DM + 1024 + h * 128 + d0 + i] = f2bf(o[i] * rs * subln_w[d0 + i]);
}
__global__ void __launch_bounds__(256) k_softmax_mem(const float* Sraw, bf16_t* Pm) {
    const int t = blockIdx.x, tid = threadIdx.x, h = tid >> 6;
    const float sc = 0.044194173824159216f;
    float v[4], m = -1e30f; for (int i = 0; i < 4; ++i) { v[i] = Sraw[(size_t)t * 1024 + h * 256 + (tid & 63) + 64 * i] * sc; m = fmaxf(m, v[i]); }
    for (int o = 32; o > 0; o >>= 1) m = fmaxf(m, __shfl_xor(m, o));
    float s = 0.f; for (int i = 0; i < 4; ++i) { v[i] = __expf(v[i] - m); s += v[i]; }
    for (int o = 32; o > 0; o >>= 1) s += __shfl_xor(s, o);
    const float il = 1.f / s; for (int i = 0; i < 4; ++i) Pm[(size_t)t * 1024 + h * 256 + (tid & 63) + 64 * i] = f2bf(v[i] * il);
}
__global__ void __launch_bounds__(256) k_router(const float* H2, const float* g, const float* wg, const float* bg, const float* we, const float* be, bf16_t* XH, unsigned* ctl, int* asg_e, int* asg_r, float* asg_w) {
    __shared__ float hn[DM]; __shared__ float red[4]; __shared__ float lg[72];
    const int t = blockIdx.x, tid = threadIdx.x; const float* xr = H2 + (size_t)t * DM;
    float v[8], s = 0.f; for (int i = 0; i < 8; ++i) { v[i] = xr[tid + 256 * i]; s += v[i] * v[i]; }
    for (int o = 32; o > 0; o >>= 1) s += __shfl_xor(s, o);
    if ((tid & 63) == 0) red[tid >> 6] = s;
    __syncthreads();
    const float rs = rsqrtf((red[0] + red[1] + red[2] + red[3]) * (1.f / DM) + NORM_EPS);
    for (int i = 0; i < 8; ++i) { const float x = v[i] * rs * g[tid + 256 * i]; hn[tid + 256 * i] = x; XH[(size_t)t * DM + tid + 256 * i] = f2bf(x); }
    __syncthreads();
    if (tid < 72) { float a = 0.f;
        if (tid < 8) { for (int k = 0; k < DM; ++k) a += hn[k] * wg[(size_t)k * 8 + tid]; a += bg[tid]; }
        else { for (int k = 0; k < DM; ++k) a += hn[k] * we[(size_t)k * 64 + tid - 8]; a += be[tid - 8]; }
        lg[tid] = a; }
    __syncthreads();
    if (tid == 0) {
        int gi = 0; float gm = lg[0]; for (int i = 1; i < 8; ++i) if (lg[i] > gm) { gm = lg[i]; gi = i; }
        float gs = 0.f; for (int i = 0; i < 8; ++i) gs += expf(lg[i] - gm);
        const float gw = 1.f / gs;
        const float* el = lg + 8 + gi * 8; int i0 = 0; for (int i = 1; i < 8; ++i) if (el[i] > el[i0]) i0 = i;
        int i1 = -1; for (int i = 0; i < 8; ++i) if (i != i0 && (i1 < 0 || el[i] > el[i1])) i1 = i;
        const float p1 = expf(el[i1] - el[i0]), w0 = gw / (1.f + p1), w1 = gw * p1 / (1.f + p1);
        const int e0 = gi * 8 + i0, e1 = gi * 8 + i1;
        asg_e[2 * t] = e0; asg_e[2 * t + 1] = e1; asg_w[2 * t] = w0; asg_w[2 * t + 1] = w1;
        asg_r[2 * t] = (int)atomicAdd(&ctl[CW_CNT + e0], 1u); asg_r[2 * t + 1] = (int)atomicAdd(&ctl[CW_CNT + e1], 1u); }
}
__global__ void k_moe_offsets(unsigned* ctl) {
    if (threadIdx.x == 0) { unsigned b = 0; int nt = 0;
        for (int e = 0; e < N_EXP; ++e) { ctl[CW_BASE + e] = b; const unsigned n = (ctl[CW_CNT + e] + 255u) / 256u; for (unsigned i = 0; i < n; ++i) ctl[CW_TILEE + nt++] = e; b += n * 256u; }
        ctl[CW_BASE + N_EXP] = b; ctl[CW_NT] = nt; }
}
__global__ void __launch_bounds__(256) k_gather(const bf16_t* XH, const unsigned* ctl, const int* asg_e, const int* asg_r, bf16_t* XG) {
    const int t = blockIdx.x, tid = threadIdx.x; const u32x4 v = *(const u32x4*)(XH + (size_t)t * DM + tid * 8);
    for (int i = 0; i < 2; ++i) { const size_t row = ctl[CW_BASE + asg_e[2 * t + i]] + asg_r[2 * t + i]; *(u32x4*)(XG + row * DM + tid * 8) = v; }
}
__global__ void k_silu_mul(const float* GU, const unsigned* ctl, bf16_t* HID) {
    const size_t i = (size_t)blockIdx.x * blockDim.x + threadIdx.x; const size_t row = i >> 10; const int c = (int)(i & 1023);
    if (row >= (size_t)ctl[CW_NT] * 256) return;
    const float gt = GU[row * 2048 + (c >> 7) * 256 + (c & 127)], up = GU[row * 2048 + (c >> 7) * 256 + 128 + (c & 127)];
    HID[row * 1024 + c] = f2bf(gt / (1.f + __expf(-gt)) * up);
}
__global__ void __launch_bounds__(256) k_final(const float* H2, const float* YC, const unsigned* ctl, const int* asg_e, const int* asg_r, const float* asg_w, const float* g, float* out) {
    __shared__ float red[4];
    const int t = blockIdx.x, tid = threadIdx.x;
    const size_t r0 = ctl[CW_BASE + asg_e[2 * t]] + asg_r[2 * t], r1 = ctl[CW_BASE + asg_e[2 * t + 1]] + asg_r[2 * t + 1]; const float w0 = asg_w[2 * t], w1 = asg_w[2 * t + 1];
    float v[8], s = 0.f; for (int i = 0; i < 8; ++i) { const int c = tid + 256 * i; v[i] = H2[(size_t)t * DM + c] + (w0 * YC[r0 * DM + c] + w1 * YC[r1 * DM + c]); s += v[i] * v[i]; }
    for (int o = 32; o > 0; o >>= 1) s += __shfl_xor(s, o);
    if ((tid & 63) == 0) red[tid >> 6] = s;
    __syncthreads();
    const float rs = rsqrtf((red[0] + red[1] + red[2] + red[3]) * (1.f / DM) + NORM_EPS);
    for (int i = 0; i < 8; ++i) out[(size_t)t * DM + tid + 256 * i] = v[i] * rs * g[tid + 256 * i];
}

template <class Epi> static void gemm(hipStream_t st, const bf16_t* A, int lda, const bf16_t* Bt, int ldb, int M, int N, int K, Epi e, const unsigned* ctl = nullptr, int eStrideB = 0) {
    hipLaunchKernelGGL(k_gemm<Epi>, dim3(N / 64, M / 64), dim3(256), 0, st, A, lda, Bt, ldb, K, e, ctl, eStrideB);
}
static int g_grid = 0;
static void launch_mk(hipStream_t st, Args a, int lo, int hi, int li) {
    a.ph_lo = lo; a.ph_hi = hi; a.li = li;
    hipLaunchKernelGGL(mk_fwd, dim3(g_grid), dim3(NWAVES * 64), LDS_BYTES, st, a);
    const hipError_t le = hipPeekAtLastError();
    if (le != hipSuccess) fprintf(stderr, "kernel_launch: mk_fwd launch [%d,%d) failed: %s\n", lo, hi, hipGetErrorName(le));
}
extern "C" void kernel_launch(void* const* d_in, const int* in_sizes, int n_in, void* d_out, int out_size, void* d_ws, size_t ws_size, hipStream_t stream) {
    if (n_in != 34 || ws_size < WS_NEED) { fprintf(stderr, "kernel_launch: need 34 inputs and %zu bytes of workspace (got %d, %zu)\n", (size_t)WS_END, n_in, ws_size); return; }
    if (g_grid == 0) {
        int dev = 0, cus = 0;
        if (hipGetDevice(&dev) != hipSuccess || hipDeviceGetAttribute(&cus, hipDeviceAttributeMultiprocessorCount, dev) != hipSuccess) { fprintf(stderr, "kernel_launch: device query failed\n"); g_grid = -1; return; }
        if (hipFuncSetAttribute((const void*)mk_fwd, hipFuncAttributeMaxDynamicSharedMemorySize, LDS_BYTES) != hipSuccess) { fprintf(stderr, "kernel_launch: hipFuncSetAttribute failed\n"); g_grid = -1; return; }
        int per_cu = 0; (void)hipOccupancyMaxActiveBlocksPerMultiprocessor(&per_cu, (const void*)mk_fwd, NWAVES * 64, LDS_BYTES); (void)hipGetLastError();
        if (per_cu < 1) fprintf(stderr, "kernel_launch: note: occupancy query reports %d workgroups per CU\n", per_cu);
        g_grid = cus;
    }
    if (g_grid < 0) return;
    auto F = [&](int i) { return (const float*)d_in[i]; };
    const float *x = F(0), *mem = F(1); const int* positions = (const int*)d_in[2];
    const float *mix_norm = F(3), *w_in = F(4), *w_out = F(18), *mem_q_norm = F(19), *mem_kv_norm = F(20), *wq = F(21), *wk = F(22), *wv = F(23), *wo = F(24),
                *moe_norm = F(25), *rgw = F(26), *rgb = F(27), *rew = F(28), *reb = F(29), *eg = F(30), *eu = F(31), *ed = F(32), *final_norm = F(33);
    (void)x; (void)mem; (void)positions; (void)mix_norm; (void)w_in; (void)w_out; (void)mem_kv_norm; (void)wq; (void)wk; (void)wv; (void)wo; (void)eg; (void)eu; (void)ed;
    char* ws = (char*)d_ws; hipStream_t st = stream;
    unsigned* ctl = (unsigned*)(ws + WS_CTL); float* rope = (float*)(ws + WS_ROPE);
    bf16_t *WinT = (bf16_t*)(ws + WS_WINT), *WoutT = (bf16_t*)(ws + WS_WOUTT), *WkvT = (bf16_t*)(ws + WS_WKVT), *WqBh = (bf16_t*)(ws + WS_WQBH), *WoTh = (bf16_t*)(ws + WS_WOTH),
           *BtS = (bf16_t*)(ws + WS_BTS), *BtO = (bf16_t*)(ws + WS_BTO), *MEMN = (bf16_t*)(ws + WS_MEMN), *KVh = (bf16_t*)(ws + WS_KVH), *WguT = (bf16_t*)(ws + WS_WGUT), *WdT = (bf16_t*)(ws + WS_WDT),
           *HN1 = (bf16_t*)(ws + WS_HN1), *Pm = (bf16_t*)(ws + WS_PM), *XH = (bf16_t*)(ws + WS_XH), *XN = (bf16_t*)(ws + WS_XN), *PR = (bf16_t*)(ws + WS_PR), *Qb = (bf16_t*)(ws + WS_QB),
           *Kb = (bf16_t*)(ws + WS_KB), *Vb = (bf16_t*)(ws + WS_VB), *O2 = (bf16_t*)(ws + WS_O2), *MIXED = (bf16_t*)(ws + WS_MIXED), *XG = (bf16_t*)(ws + WS_XG), *HID = (bf16_t*)(ws + WS_HID);
    float *H1 = (float*)(ws + WS_H1), *H2 = (float*)(ws + WS_H2), *S0 = (float*)(ws + WS_S0), *Y = (float*)(ws + WS_Y), *BONUS = (float*)(ws + WS_BONUS), *QKraw = (float*)(ws + WS_QKRAW),
          *Sraw = (float*)(ws + WS_SRAW), *YC = (float*)(ws + WS_YC), *GU = (float*)(ws + WS_GU);
    (void)WinT; (void)WoutT; (void)WkvT; (void)WqBh; (void)WoTh; (void)BtS; (void)BtO; (void)MEMN; (void)KVh; (void)WguT; (void)WdT; (void)Pm; (void)XN; (void)QKraw; (void)Sraw; (void)GU; (void)rope; (void)HID;
    int* asg_e = (int*)(ws + WS_ASG); int* asg_r = asg_e + 2 * SEQ; float* asg_w = (float*)(asg_r + 2 * SEQ);
    if (hipMemsetAsync(ctl, 0, CTL_ZERO_BYTES, st) != hipSuccess) { fprintf(stderr, "kernel_launch: memset failed\n"); return; }
    Args a{}; for (int i = 0; i < 34; ++i) a.in[i] = (const float*)d_in[i]; a.out = (float*)d_out; a.ws = (unsigned char*)d_ws;
    int li = 0;
    PrepW P{F(5), F(6), F(7), F(8), F(9), F(10), F(11), F(12), F(13)};
    int pend_lo = -1;
    for (int k = 0; k <= PH_N; ++k) {
        const bool naive = k < PH_N && ((MK_NAIVE_MASK >> k) & 1);
        if (k < PH_N && !naive) { if (pend_lo < 0) pend_lo = k; continue; }
        if (pend_lo >= 0) { launch_mk(st, a, pend_lo, k, li++); pend_lo = -1; }
        if (k == PH_N) break;
        switch (k) {
        case PH_PRO:
            hipLaunchKernelGGL(k_transpose, dim3(RWKV_COLS / 32, DM / 32, 1), dim3(256), 0, st, w_in, DM, IN_COLS, WinT, 0, 0, (size_t)0, 0);
            hipLaunchKernelGGL(k_transpose, dim3(2 * QK_COLS / 32, DM / 32, 1), dim3(256), 0, st, w_in + RWKV_COLS, DM, IN_COLS, WinT + (size_t)RWKV_COLS * DM, 1, 0, (size_t)0, 0);
            hipLaunchKernelGGL(k_transpose, dim3(1024 / 32, DM / 32, 1), dim3(256), 0, st, w_in + RWKV_COLS + 2 * QK_COLS, DM, IN_COLS, WinT + (size_t)(RWKV_COLS + 2 * QK_COLS) * DM, 0, 0, (size_t)0, 0);
            hipLaunchKernelGGL(k_transpose, dim3(DM / 32, DM / 32, 1), dim3(256), 0, st, w_out, DM, DM, WoutT, 0, 0, (size_t)0, 0);
            hipLaunchKernelGGL(k_transpose, dim3(DM / 32, DM / 32, 1), dim3(256), 0, st, wk, DM, DM, WkvT, 0, 0, (size_t)0, 0);
            hipLaunchKernelGGL(k_transpose, dim3(DM / 32, DM / 32, 1), dim3(256), 0, st, wv, DM, DM, WkvT + (size_t)DM * DM, 0, 0, (size_t)0, 0);
            hipLaunchKernelGGL(k_transpose, dim3(DM / 32, MEM_HD / 32, MEM_HEADS), dim3(256), 0, st, wo, MEM_HD, DM, WoTh, 0, 0, (size_t)MEM_HD * DM, 2048);
            hipLaunchKernelGGL(k_wqbh, dim3(DM * DM / 256), dim3(256), 0, st, wq, WqBh);
            hipLaunchKernelGGL(k_transpose, dim3(D_EXP / 32, DM / 32, N_EXP), dim3(256), 0, st, eg, DM, D_EXP, WguT, 2, 0, (size_t)DM * D_EXP, 2048);
            hipLaunchKernelGGL(k_transpose, dim3(D_EXP / 32, DM / 32, N_EXP), dim3(256), 0, st, eu, DM, D_EXP, WguT, 3, 0, (size_t)DM * D_EXP, 2048);
            hipLaunchKernelGGL(k_transpose, dim3(DM / 32, D_EXP / 32, N_EXP), dim3(256), 0, st, ed, D_EXP, DM, WdT, 0, 0, (size_t)DM * D_EXP, 2048);
            hipLaunchKernelGGL(k_rope_table, dim3(SEQ * 32 / 256), dim3(256), 0, st, positions, rope);
            hipLaunchKernelGGL(k_rmsnorm_bf16, dim3(SEQ), dim3(256), 0, st, x, mix_norm, XN);
            hipLaunchKernelGGL(k_rmsnorm_bf16, dim3(MEM_LEN), dim3(256), 0, st, mem, mem_kv_norm, MEMN);
            break;
        case PH_INPROJ:
            gemm(st, XN, DM, WinT, DM, SEQ, IN_COLS, DM, NEpiInProj{PR, QKraw, Vb});
            hipLaunchKernelGGL(k_rope_apply, dim3(SEQ), dim3(256), 0, st, QKraw, rope, Qb, Kb);
            for (int t = 0; t < 8; ++t) gemm(st, MEMN, DM, WkvT + (size_t)t * MEM_HD * DM, DM, MEM_LEN, MEM_HD, DM, NEpiBf{KVh + (size_t)t * MEM_LEN * MEM_HD, MEM_HD});
            break;
        case PH_MEMPRE:
            for (int h = 0; h < MEM_HEADS; ++h) {
                gemm(st, KVh + (size_t)h * MEM_LEN * MEM_HD, MEM_HD, WqBh + (size_t)h * DM * MEM_HD, MEM_HD, MEM_LEN, DM, MEM_HD, NEpiBf{BtS + (size_t)h * MEM_LEN * DM, DM});
                gemm(st, WoTh + (size_t)h * DM * MEM_HD, MEM_HD, KVh + (size_t)(4 + h) * MEM_LEN * MEM_HD, MEM_HD, DM, MEM_LEN, MEM_HD, NEpiBf{BtO + h * MEM_LEN, MEM_HEADS * MEM_LEN}); }
            break;
        case PH_LORA: break;
        case PH_SCANA: hipLaunchKernelGGL(k_prep, dim3(SEQ), dim3(256), 0, st, PR, P, S0, BONUS); break;
        case PH_SCANB: hipLaunchKernelGGL(k_scan, dim3(256), dim3(256), 0, st, S0, Y); break;
        case PH_SCANC: hipLaunchKernelGGL(k_rwkv_post, dim3(SEQ), dim3(256), 0, st, Y, S0, BONUS, F(14), F(15), MIXED); break;
        case PH_ATTN: hipLaunchKernelGGL(k_attn, dim3(SEQ / 64, 16, 4), dim3(64), 0, st, Qb, Kb, Vb, O2); break;
        case PH_POST:
            hipLaunchKernelGGL(k_diff_post, dim3(SEQ), dim3(256), 0, st, O2, F(16), F(17), MIXED);
            break;
        case PH_OUTPROJ: gemm(st, MIXED, DM, WoutT, DM, SEQ, DM, DM, NEpiResid{x, H1, DM}); break;
        case PH_HN1: hipLaunchKernelGGL(k_rmsnorm_bf16, dim3(SEQ), dim3(256), 0, st, H1, mem_q_norm, HN1); break;
        case PH_SCORES:
            gemm(st, HN1, DM, BtS, DM, SEQ, MEM_HEADS * MEM_LEN, DM, NEpiF32{Sraw, MEM_HEADS * MEM_LEN});
            hipLaunchKernelGGL(k_softmax_mem, dim3(SEQ), dim3(256), 0, st, Sraw, Pm);
            break;
        case PH_MEMOUT: gemm(st, Pm, MEM_HEADS * MEM_LEN, BtO, MEM_HEADS * MEM_LEN, SEQ, DM, MEM_HEADS * MEM_LEN, NEpiResid{H1, H2, DM}); break;
        case PH_ROUTER: hipLaunchKernelGGL(k_router, dim3(SEQ), dim3(256), 0, st, H2, moe_norm, rgw, rgb, rew, reb, XH, ctl, asg_e, asg_r, asg_w); break;
        case PH_GATHER:
            hipLaunchKernelGGL(k_moe_offsets, dim3(1), dim3(64), 0, st, ctl);
            hipLaunchKernelGGL(k_gather, dim3(SEQ), dim3(256), 0, st, XH, ctl, asg_e, asg_r, XG);
            break;
        case PH_GATEUP:
            gemm(st, XG, DM, WguT, DM, XG_ROWS, 2048, DM, NEpiF32{GU, 2048}, ctl, 2048);
            hipLaunchKernelGGL(k_silu_mul, dim3(XG_ROWS * 1024 / 256), dim3(256), 0, st, GU, ctl, HID);
            break;
        case PH_DOWN: gemm(st, HID, D_EXP, WdT, D_EXP, XG_ROWS, DM, D_EXP, NEpiF32{YC, DM}, ctl, 2048); break;
        case PH_FINAL: hipLaunchKernelGGL(k_final, dim3(SEQ), dim3(256), 0, st, H2, YC, ctl, asg_e, asg_r, asg_w, final_norm, (float*)d_out); break;
        }
    }
#if MK_PROBE >= 0
#if defined(MK_PROBE_VAR)
    a.pad = MK_PROBE_VAR;
#endif
    for (int r = 0; r < MK_PROBE_REPS; ++r) launch_mk(st, a, MK_PROBE, MK_PROBE + 1, li);
#endif
}
```

```cpp
#include <hip/hip_runtime.h>
#include <stdint.h>
#include <stdio.h>
#include <math.h>

typedef unsigned short bf16_t;
typedef float f32x4 __attribute__((ext_vector_type(4)));
typedef unsigned u32x4 __attribute__((ext_vector_type(4)));

#ifndef MK_NAIVE_MASK
#define MK_NAIVE_MASK 0
#endif
#ifndef MK_PROBE
#define MK_PROBE -1
#endif
#ifndef MK_PROBE_REPS
#define MK_PROBE_REPS 4
#endif

constexpr int SEQ = 8192, DM = 2048, RW = 1024, NH_R = 16, HD_R = 64;
constexpr int RWKV_COLS = 3328, IN_COLS = 6400, QK_COLS = 1024;
constexpr int MEM_LEN = 256, MEM_HEADS = 4, MEM_HD = 512;
constexpr int N_GROUPS = 8, EPG = 8, N_EXP = 64, D_EXP = 1024;
constexpr int XG_ROWS = 32768;
constexpr float NORM_EPS = 1e-6f, LNX_EPS = 64e-5f, SUBLN_EPS = 1e-5f;
constexpr float LAMBDA_INIT = 0.2f;
constexpr float C2 = 0.125f * 1.4426950408889634f;

constexpr size_t MiB = 1u << 20;
constexpr size_t WS_CTL = 0, WS_ROPE = 1 * MiB, WS_WINT = 4 * MiB, WS_WOUTT = 29 * MiB, WS_WKVT = 37 * MiB, WS_WQBH = 53 * MiB, WS_WOTH = 61 * MiB,
                 WS_BTS = 69 * MiB, WS_BTO = 73 * MiB, WS_MEMN = 77 * MiB, WS_KVH = 78 * MiB, WS_ASG = 80 * MiB, WS_BONUS = 81 * MiB,
                 WS_WGUT = 96 * MiB, WS_WDT = 608 * MiB, WS_H1 = 864 * MiB, WS_HN1 = 928 * MiB, WS_PM = 960 * MiB, WS_H2 = 976 * MiB, WS_XH = 1040 * MiB,
                 WS_XN = 1072 * MiB, WS_PR = 1104 * MiB, WS_QB = 1156 * MiB, WS_KB = 1172 * MiB, WS_VB = 1188 * MiB, WS_S0 = 1204 * MiB  ,
                 WS_Y = 1428 * MiB, WS_O2 = 1460 * MiB, WS_MIXED = 1492 * MiB, WS_END = 1524 * MiB;
constexpr size_t WS_XL = WS_S0, WS_WLORA = WS_S0 + 4 * MiB, WS_LG = WS_S0 + 6 * MiB, WS_RPP = WS_S0 + 54 * MiB, WS_YG = WS_S0 + 70 * MiB, WS_PT = WS_S0 + 102 * MiB, WS_QT = WS_S0 + 118 * MiB,
                 WS_SC = WS_S0 + 150 * MiB, WS_EG = WS_S0 + 166 * MiB, WS_EBV = WS_S0 + 182 * MiB;
constexpr size_t WS_PSQ = 84 * MiB;
constexpr size_t WS_RT = 82 * MiB, WS_RS = 83 * MiB;
constexpr size_t WS_QKRAW = WS_H2, WS_SRAW = WS_XH;
#if MK_PROBE >= 0
constexpr size_t WS_XG = 1524 * MiB, WS_HID = 1652 * MiB, WS_YC = 1716 * MiB, WS_GU = WS_YC, WS_NEED = 1972 * MiB;
#else
constexpr size_t WS_XG = 1072 * MiB, WS_HID = 1200 * MiB, WS_YC = 1264 * MiB, WS_GU = WS_YC, WS_NEED = WS_END;
#endif
constexpr size_t CTL_ZERO_BYTES = 1 * MiB;
constexpr int CW_CNT = 0, CW_BASE = 64, CW_NT = 160, CW_TILEE = 192;
constexpr int CW_TMO = 512, CW_CODE = 513;
constexpr int CW_AQ = 1024;
constexpr int CW_BAR = 4096;

__device__ __forceinline__ float bf2f(bf16_t b) { return __uint_as_float((unsigned)b << 16); }
__device__ __forceinline__ bf16_t f2bf(float f) { unsigned u = __float_as_uint(f); return (bf16_t)((u + 0x7fffu + ((u >> 16) & 1u)) >> 16); }
__device__ __forceinline__ float sigmoidf_(float x) { return 1.f / (1.f + __expf(-x)); }
__host__ __device__ __forceinline__ int rope_phys(int d) { return d < 32 ? 8 * (d >> 2) + (d & 3) : 8 * ((d - 32) >> 2) + 4 + ((d - 32) & 3); }
__host__ __device__ __forceinline__ int row_map(int mode, int n) {
    return mode == 1 ? (n & ~63) + rope_phys(n & 63) : mode == 2 ? (n >> 7) * 256 + (n & 127) : mode == 3 ? (n >> 7) * 256 + 128 + (n & 127) : n; }

namespace pg8 {
#define PG8_LAS __attribute__((address_space(3)))
typedef unsigned short bf16_t;
typedef short bf16x8 __attribute__((ext_vector_type(8)));
typedef float f32x4 __attribute__((ext_vector_type(4)));
typedef unsigned u32x4 __attribute__((ext_vector_type(4)));
constexpr int BM = 256, BK = 64, HALF = 128, HTB = HALF * BK * 2  , STAGE_BYTES = 8 * HTB, NXCD = 8, WGM = 8;

__host__ __device__ __forceinline__ int lds_byte(int r, int c) { const int st = (r >> 4) * 2 + (c >> 5), rr = r & 15, cc = c & 31, ob = rr * 64 + cc * 2; return st * 1024 + (ob ^ (((ob >> 9) & 1) << 5)); }
__host__ __device__ __forceinline__ void stage_rc(int b, int& R, int& C) { const int st = b / 1024, sb = b % 1024, swz = sb ^ (((sb >> 9) & 1) << 5); R = (st >> 1) * 16 + swz / 64; C = (st & 1) * 32 + (swz % 64) / 2; }
__host__ __device__ __forceinline__ int perm32(int rho) { const int n = rho >> 4, i = rho & 15; return 8 * (i >> 2) + 4 * n + (i & 3); }

struct Unit { int pm, pn; };
struct Gemm { const bf16_t* A; const bf16_t* Bt; int M, N, K, lda, ldb; };

struct StaticOrder {
    int nM, nN, nwg, G, c;
    __host__ __device__ void init(int M, int N, int G_, int c_) { nM = M / BM; nN = N / BM; nwg = nM * nN; G = G_; c = c_; }
    __host__ __device__ bool next(int i, Unit& u) const {
        const long L = (long)i * G + c; if (L >= nwg) return false;
        int wgid = (int)L; { const int q = nwg / NXCD, r = nwg % NXCD, xcd = wgid % NXCD, off = wgid / NXCD; wgid = (xcd < r ? xcd * (q + 1) : r * (q + 1) + (xcd - r) * q) + off; }
        const int nig = WGM * nN, gid = wgid / nig, fm = gid * WGM, gsz = (nM - fm) < WGM ? (nM - fm) : WGM;
        u.pm = fm + ((wgid % nig) % gsz); u.pn = (wgid % nig) / gsz; return true;
    }
    __device__ __forceinline__ void a_ready(const Unit&) const {}
    __device__ __forceinline__ void done(const Unit&) const {}
};
__device__ __forceinline__ unsigned cvt_pk_bf16(float lo, float hi) { unsigned r; asm volatile("v_cvt_pk_bf16_f32 %0, %1, %2" : "=v"(r) : "v"(lo), "v"(hi)); return r; }
template <class Epi, class Sched, bool ALIGN_EPI = false, bool SP2 = false>
__device__ __forceinline__ void gemm_phase(PG8_LAS unsigned char* lds, const Gemm g, const Sched& S, const Epi& E) {
    const int tid = threadIdx.x, wid = __builtin_amdgcn_readfirstlane(tid >> 6), lane = tid & 63, wr = wid >> 2, wc = wid & 3, fr = lane & 15, fq = lane >> 4;
    const int K = g.K, nt = K / BK;
    unsigned voffA[2], voffB[2];
#pragma unroll
    for (int i = 0; i < 2; ++i) { int R, C; stage_rc(tid * 16 + i * 8192, R, C); const int Rb = Epi::PERM ? ((R & ~31) + perm32(R & 31)) : R;
        voffA[i] = (unsigned)(R * g.lda + C) * 2u; voffB[i] = (unsigned)(Rb * g.ldb + C) * 2u; }
    const size_t kstep = (size_t)(BK * 2);
    const size_t hstepA = (size_t)HALF * g.lda * 2, hstepB = (size_t)HALF * g.ldb * 2;
    const size_t tstepA = 2 * hstepA, tstepB = 2 * hstepB;
    const unsigned ldsw = (unsigned)wid * 1024u;
    const int aoff = lds_byte(wr * 64 + fr, fq * 8), boff = lds_byte(wc * 32 + fr, fq * 8);
#define PG8_SA(b, h) (((b) * 2 + (h)) * HTB)
#define PG8_SB(b, h) ((4 + (b) * 2 + (h)) * HTB)
#define PG8_STAGE(bufoff, gbase, voff) do { _Pragma("unroll") for (int _i = 0; _i < 2; ++_i) \
        __builtin_amdgcn_global_load_lds((const unsigned*)((const char*)(gbase) + (voff)[_i]), (PG8_LAS unsigned*)(lds + (bufoff) + ldsw + _i * 8192), 16, 0, 0); } while (0)
#define PG8_LDA(dst, b, h) do { _Pragma("unroll") for (int m = 0; m < 4; ++m) _Pragma("unroll") for (int k = 0; k < 2; ++k) dst[m][k] = *(const PG8_LAS bf16x8*)(lds + PG8_SA(b, h) + aoff + m * 2048 + k * 1024); } while (0)
#define PG8_LDB(dst, b, h) do { _Pragma("unroll") for (int n = 0; n < 2; ++n) _Pragma("unroll") for (int k = 0; k < 2; ++k) dst[n][k] = *(const PG8_LAS bf16x8*)(lds + PG8_SB(b, h) + boff + n * 2048 + k * 1024); } while (0)
#define PG8_MMA(ai, bj, At, Bt) do { __builtin_amdgcn_s_setprio(1); _Pragma("unroll") for (int m = 0; m < 4; ++m) _Pragma("unroll") for (int n = 0; n < 2; ++n) _Pragma("unroll") for (int k = 0; k < 2; ++k) \
        acc[ai][bj][m][n] = __builtin_amdgcn_mfma_f32_16x16x32_bf16(Bt[n][k], At[m][k], acc[ai][bj][m][n], 0, 0, 0); __builtin_amdgcn_s_setprio(0); } while (0)
#define PG8_WAIT_V(n) asm volatile("s_waitcnt vmcnt(" #n ")" ::: "memory")
#define PG8_WAIT_L(n) asm volatile("s_waitcnt lgkmcnt(" #n ")" ::: "memory")
#define PG8_BAR __builtin_amdgcn_s_barrier()
#define PG8_SCHED __builtin_amdgcn_sched_barrier(0)
    Unit cur, nxt; int ui = 0;
    if (!S.next(0, cur)) return;
    f32x4 acc[2][2][4][2];
#pragma unroll
    for (int a = 0; a < 2; ++a)
#pragma unroll
        for (int b = 0; b < 2; ++b)
#pragma unroll
            for (int m = 0; m < 4; ++m)
#pragma unroll
                for (int n = 0; n < 2; ++n) acc[a][b][m][n] = (f32x4){0.f, 0.f, 0.f, 0.f};
    bf16x8 At[4][2], B0[2][2], B1[2][2];
    const char* cA = (const char*)g.A + (size_t)cur.pm * tstepA; const char* cB = (const char*)g.Bt + (size_t)cur.pn * tstepB;
    S.a_ready(cur);
    if constexpr (SP2) {
        PG8_STAGE(PG8_SB(0, 0), cB, voffB); PG8_STAGE(PG8_SB(0, 1), cB + hstepB, voffB); PG8_STAGE(PG8_SA(0, 0), cA, voffA); PG8_STAGE(PG8_SA(0, 1), cA + hstepA, voffA);
        if (wr == 1) PG8_BAR;
        PG8_WAIT_V(2); PG8_BAR;
        PG8_STAGE(PG8_SB(1, 0), cB + kstep, voffB); PG8_STAGE(PG8_SA(1, 0), cA + kstep, voffA); PG8_STAGE(PG8_SB(1, 1), cB + hstepB + kstep, voffB);
        PG8_WAIT_V(6); PG8_BAR;
    } else {
        PG8_STAGE(PG8_SB(0, 0), cB, voffB); PG8_STAGE(PG8_SA(0, 0), cA, voffA); PG8_STAGE(PG8_SB(0, 1), cB + hstepB, voffB); PG8_STAGE(PG8_SA(0, 1), cA + hstepA, voffA);
        if (wr == 1) PG8_BAR;
        PG8_WAIT_V(4); PG8_BAR;
        PG8_STAGE(PG8_SB(1, 0), cB + kstep, voffB); PG8_STAGE(PG8_SA(1, 0), cA + kstep, voffA); PG8_STAGE(PG8_SB(1, 1), cB + hstepB + kstep, voffB);
        PG8_WAIT_V(6); PG8_BAR;
    }
    for (;;) {
        const bool has_next = S.next(ui + 1, nxt);
        const char* nA = has_next ? (const char*)g.A + (size_t)nxt.pm * tstepA : cA; const char* nB = has_next ? (const char*)g.Bt + (size_t)nxt.pn * tstepB : cB;
        for (int t = 0; t < nt; t += 2) {
            const bool last = (t == nt - 2);
            const char* a1 = cA + (size_t)(t + 1) * kstep;
            const char* a2 = last ? nA : cA + (size_t)(t + 2) * kstep; const char* b2 = last ? nB : cB + (size_t)(t + 2) * kstep;
            const char* a3 = a2 + kstep; const char* b3 = b2 + kstep;
            if (last && has_next) S.a_ready(nxt);
            if constexpr (SP2) {
            PG8_LDB(B0, 0, 0); PG8_LDB(B1, 0, 1); PG8_SCHED; PG8_LDA(At, 0, 0); PG8_STAGE(PG8_SA(1, 1), a1 + hstepA, voffA);
            PG8_WAIT_V(8); PG8_WAIT_L(0); PG8_BAR; PG8_MMA(0, 0, At, B0); PG8_MMA(0, 1, At, B1); PG8_BAR; PG8_SCHED;
            PG8_LDA(At, 0, 1); PG8_STAGE(PG8_SB(0, 0), b2, voffB); PG8_STAGE(PG8_SB(0, 1), b2 + hstepB, voffB); PG8_STAGE(PG8_SA(0, 0), a2, voffA);
            PG8_WAIT_V(8); PG8_WAIT_L(0); PG8_BAR; PG8_MMA(1, 0, At, B0); PG8_MMA(1, 1, At, B1); PG8_BAR; PG8_SCHED;
            PG8_LDB(B0, 1, 0); PG8_LDB(B1, 1, 1); PG8_SCHED; PG8_LDA(At, 1, 0); PG8_STAGE(PG8_SA(0, 1), a2 + hstepA, voffA);
            PG8_WAIT_V(8); PG8_WAIT_L(0); PG8_BAR; PG8_MMA(0, 0, At, B0); PG8_MMA(0, 1, At, B1); PG8_BAR; PG8_SCHED;
            PG8_LDA(At, 1, 1); PG8_STAGE(PG8_SB(1, 0), b3, voffB); PG8_STAGE(PG8_SB(1, 1), b3 + hstepB, voffB); PG8_STAGE(PG8_SA(1, 0), a3, voffA);
            PG8_WAIT_V(8); PG8_WAIT_L(0); PG8_BAR; PG8_MMA(1, 0, At, B0); PG8_MMA(1, 1, At, B1); PG8_BAR; PG8_SCHED;
            } else {
            PG8_LDB(B0, 0, 0); PG8_SCHED; PG8_LDA(At, 0, 0); PG8_STAGE(PG8_SA(1, 1), a1 + hstepA, voffA);
            PG8_WAIT_L(8); PG8_BAR; PG8_WAIT_L(0); PG8_MMA(0, 0, At, B0); PG8_BAR; PG8_SCHED;
            PG8_LDB(B1, 0, 1); PG8_STAGE(PG8_SB(0, 0), b2, voffB);
            PG8_BAR; PG8_WAIT_L(0); PG8_MMA(0, 1, At, B1); PG8_BAR;
            PG8_LDA(At, 0, 1); PG8_STAGE(PG8_SA(0, 0), a2, voffA);
            PG8_BAR; PG8_WAIT_L(0); PG8_MMA(1, 0, At, B0); PG8_BAR; PG8_SCHED;
            PG8_STAGE(PG8_SB(0, 1), b2 + hstepB, voffB);
            PG8_WAIT_V(6); PG8_BAR; PG8_MMA(1, 1, At, B1); PG8_BAR;
            PG8_LDB(B0, 1, 0); PG8_SCHED; PG8_LDA(At, 1, 0); PG8_STAGE(PG8_SA(0, 1), a2 + hstepA, voffA);
            PG8_WAIT_L(8); PG8_BAR; PG8_WAIT_L(0); PG8_MMA(0, 0, At, B0); PG8_BAR; PG8_SCHED;
            PG8_LDB(B1, 1, 1); PG8_STAGE(PG8_SB(1, 0), b3, voffB);
            PG8_BAR; PG8_WAIT_L(0); PG8_MMA(0, 1, At, B1); PG8_BAR;
            PG8_LDA(At, 1, 1); PG8_STAGE(PG8_SA(1, 0), a3, voffA);
            PG8_BAR; PG8_WAIT_L(0); PG8_MMA(1, 0, At, B0); PG8_BAR; PG8_SCHED;
            PG8_STAGE(PG8_SB(1, 1), b3 + hstepB, voffB);
            PG8_WAIT_V(6); PG8_BAR; PG8_MMA(1, 1, At, B1); PG8_BAR;
            }
        }
        if constexpr (ALIGN_EPI) { if (wr == 0) PG8_BAR; }
        if constexpr (!Epi::AFTER_DRAIN) { E(acc, cur, wr, wc, fr, fq); S.done(cur); }
        if (!has_next) break;
#pragma unroll
        for (int a = 0; a < 2; ++a)
#pragma unroll
            for (int b = 0; b < 2; ++b)
#pragma unroll
                for (int m = 0; m < 4; ++m)
#pragma unroll
                    for (int n = 0; n < 2; ++n) acc[a][b][m][n] = (f32x4){0.f, 0.f, 0.f, 0.f};
        cur = nxt; cA = nA; cB = nB; ++ui;
        if constexpr (ALIGN_EPI) { if (wr == 1) PG8_BAR; }
    }
    PG8_WAIT_V(0);
    if constexpr (!ALIGN_EPI) { if (wr == 0) PG8_BAR; }
    PG8_BAR;
    if constexpr (Epi::AFTER_DRAIN) { E.fused(acc, cur, wr, wc, fr, fq, lds, wid, lane); S.done(cur); }
#undef PG8_SA
#undef PG8_SB
#undef PG8_STAGE
#undef PG8_LDA
#undef PG8_LDB
#undef PG8_MMA
#undef PG8_WAIT_V
#undef PG8_WAIT_L
#undef PG8_BAR
#undef PG8_SCHED
}
}
namespace pg8 {
__device__ __forceinline__ u32x4 pack8(const f32x4 v0, const f32x4 v1) { u32x4 w; w.x = cvt_pk_bf16(v0[0], v0[1]); w.y = cvt_pk_bf16(v0[2], v0[3]); w.z = cvt_pk_bf16(v1[0], v1[1]); w.w = cvt_pk_bf16(v1[2], v1[3]); return w; }
struct EpiInProj {
    static constexpr bool PERM = true, AFTER_DRAIN = false;
    bf16_t *PR, *Qb, *Kb, *Vb; const float* rope;
    __device__ __forceinline__ void operator()(const f32x4 (&acc)[2][2][4][2], const Unit& u, int wr, int wc, int fr, int fq) const {
        const int row0 = u.pm * BM + wr * 64 + fr, cl = wc * 32 + 8 * fq;
        if (u.pn < 13 || u.pn >= 21) {
            bf16_t* base; int ldc, colt;
            if (u.pn < 13) { base = PR; ldc = RWKV_COLS; colt = u.pn * 256; } else { base = Vb; ldc = 1024; colt = (u.pn - 21) * 256; }
#pragma unroll
            for (int ai = 0; ai < 2; ++ai)
#pragma unroll
                for (int m = 0; m < 4; ++m) { bf16_t* rowp = base + (size_t)(row0 + ai * HALF + m * 16) * ldc + colt + cl;
#pragma unroll
                    for (int bj = 0; bj < 2; ++bj) *(u32x4*)(rowp + bj * HALF) = pack8(acc[ai][bj][m][0], acc[ai][bj][m][1]); }
        } else {
            const bool isq = u.pn < 17; bf16_t* base = isq ? Qb : Kb; const int colt = (u.pn - (isq ? 13 : 17)) * 256; const float sc = isq ? C2 : 1.f;
            const int j0 = 16 * (wc & 1) + 4 * fq;
#pragma unroll
            for (int ai = 0; ai < 2; ++ai)
#pragma unroll
                for (int m = 0; m < 4; ++m) { const int row = row0 + ai * HALF + m * 16;
                    const f32x4 t0 = *(const f32x4*)(rope + ((size_t)row * 32 + j0) * 2), t1 = *(const f32x4*)(rope + ((size_t)row * 32 + j0) * 2 + 4);
                    const f32x4 cs = {t0[0], t0[2], t1[0], t1[2]}, sn = {t0[1], t0[3], t1[1], t1[3]};
                    bf16_t* rowp = base + (size_t)row * 1024 + colt + cl;
#pragma unroll
                    for (int bj = 0; bj < 2; ++bj) { const f32x4 x1 = acc[ai][bj][m][0], x2 = acc[ai][bj][m][1];
                        const f32x4 lo = (x1 * cs - x2 * sn) * sc, hi = (x1 * sn + x2 * cs) * sc;
                        *(u32x4*)(rowp + bj * HALF) = pack8(lo, hi); } }
        }
    }
};
struct EpiKV {
    static constexpr bool PERM = true, AFTER_DRAIN = false;
    bf16_t* KVh;
    __device__ __forceinline__ void operator()(const f32x4 (&acc)[2][2][4][2], const Unit& u, int wr, int wc, int fr, int fq) const {
        bf16_t* base = KVh + (size_t)(u.pn >> 1) * (MEM_LEN * MEM_HD) + (u.pn & 1) * 256 + wc * 32 + 8 * fq;
#pragma unroll
        for (int ai = 0; ai < 2; ++ai)
#pragma unroll
            for (int m = 0; m < 4; ++m) { bf16_t* rowp = base + (size_t)(wr * 64 + fr + ai * HALF + m * 16) * MEM_HD;
#pragma unroll
                for (int bj = 0; bj < 2; ++bj) *(u32x4*)(rowp + bj * HALF) = pack8(acc[ai][bj][m][0], acc[ai][bj][m][1]); }
    }
};
struct EpiBfGen {
    static constexpr bool PERM = true, AFTER_DRAIN = false;
    bf16_t* C; int ldc, pm_mask, pn_mask, pn_sub;
    __device__ __forceinline__ void operator()(const f32x4 (&acc)[2][2][4][2], const Unit& u, int wr, int wc, int fr, int fq) const {
        bf16_t* base = C + (size_t)((u.pm & pm_mask) * BM + wr * 64 + fr) * ldc + ((u.pn - pn_sub) & pn_mask) * BM + wc * 32 + 8 * fq;
#pragma unroll
        for (int ai = 0; ai < 2; ++ai)
#pragma unroll
            for (int m = 0; m < 4; ++m) { bf16_t* rowp = base + (size_t)(ai * HALF + m * 16) * ldc;
#pragma unroll
                for (int bj = 0; bj < 2; ++bj) *(u32x4*)(rowp + bj * HALF) = pack8(acc[ai][bj][m][0], acc[ai][bj][m][1]); }
    }
};
struct EpiBfGenCS {
    static constexpr bool PERM = true, AFTER_DRAIN = false;
    bf16_t* C; int ldc, pm_mask, pn_mask, pn_sub; const float* cs;
    __device__ __forceinline__ void operator()(const f32x4 (&acc)[2][2][4][2], const Unit& u, int wr, int wc, int fr, int fq) const {
        const int colb = ((u.pn - pn_sub) & pn_mask) * BM + wc * 32 + 8 * fq;
        bf16_t* base = C + (size_t)((u.pm & pm_mask) * BM + wr * 64 + fr) * ldc + colb;
        const f32x4 sa0 = *(const f32x4*)(cs + colb), sa1 = *(const f32x4*)(cs + colb + 4), sb0 = *(const f32x4*)(cs + colb + HALF), sb1 = *(const f32x4*)(cs + colb + HALF + 4);
#pragma unroll
        for (int ai = 0; ai < 2; ++ai)
#pragma unroll
            for (int m = 0; m < 4; ++m) { bf16_t* rowp = base + (size_t)(ai * HALF + m * 16) * ldc;
                *(u32x4*)(rowp) = pack8(acc[ai][0][m][0] * sa0, acc[ai][0][m][1] * sa1); *(u32x4*)(rowp + HALF) = pack8(acc[ai][1][m][0] * sb0, acc[ai][1][m][1] * sb1); }
    }
};
struct EpiResid {
    static constexpr bool PERM = false, AFTER_DRAIN = false;
    const float* base; float* out;
    __device__ __forceinline__ void operator()(const f32x4 (&acc)[2][2][4][2], const Unit& u, int wr, int wc, int fr, int fq) const {
        const int row0 = u.pm * BM + wr * 64 + fr, col0 = u.pn * BM + wc * 32 + 4 * fq;
#pragma unroll
        for (int ai = 0; ai < 2; ++ai)
#pragma unroll
            for (int m = 0; m < 4; ++m) { const size_t off = (size_t)(row0 + ai * HALF + m * 16) * DM + col0;
#pragma unroll
                for (int bj = 0; bj < 2; ++bj)
#pragma unroll
                    for (int n = 0; n < 2; ++n) *(f32x4*)(out + off + bj * HALF + n * 16) = *(const f32x4*)(base + off + bj * HALF + n * 16) + acc[ai][bj][m][n]; }
    }
};
struct EpiResidSq {
    static constexpr bool PERM = true, AFTER_DRAIN = false;
    const float* base; float* out; bf16_t* outb; float* psq;
    __device__ __forceinline__ void operator()(const f32x4 (&acc)[2][2][4][2], const Unit& u, int wr, int wc, int fr, int fq) const {
        const int row0 = u.pm * BM + wr * 64 + fr, col0 = u.pn * BM + wc * 32 + 8 * fq;
#pragma unroll
        for (int ai = 0; ai < 2; ++ai)
#pragma unroll
            for (int m = 0; m < 4; ++m) { const int row = row0 + ai * HALF + m * 16; const size_t off = (size_t)row * DM + col0; float s = 0.f;
#pragma unroll
                for (int bj = 0; bj < 2; ++bj) { const f32x4 v0 = *(const f32x4*)(base + off + bj * HALF) + acc[ai][bj][m][0], v1 = *(const f32x4*)(base + off + bj * HALF + 4) + acc[ai][bj][m][1];
                    *(f32x4*)(out + off + bj * HALF) = v0; *(f32x4*)(out + off + bj * HALF + 4) = v1; *(u32x4*)(outb + off + bj * HALF) = pack8(v0, v1);
                    s += ((v0[0] * v0[0] + v0[1] * v0[1]) + (v0[2] * v0[2] + v0[3] * v0[3])) + ((v1[0] * v1[0] + v1[1] * v1[1]) + (v1[2] * v1[2] + v1[3] * v1[3])); }
                s += __shfl_xor(s, 16); s += __shfl_xor(s, 32);
                if (fq == 0) psq[(size_t)row * 32 + u.pn * 4 + wc] = s; }
    }
};
struct EpiSoftmax {
    static constexpr bool PERM = true, AFTER_DRAIN = true;
    bf16_t* P; float scale_log2e;
    __device__ __forceinline__ void fused(f32x4 (&acc)[2][2][4][2], const Unit& u, int wr, int wc, int fr, int fq, PG8_LAS unsigned char* lds, int wid, int lane) const {
        PG8_LAS float* Pm = (PG8_LAS float*)lds;
        PG8_LAS float* Ps = (PG8_LAS float*)(lds + 4096);
        PG8_LAS float* Rs = (PG8_LAS float*)(lds + 8192);
        { const float* psq = (const float*)((const unsigned char*)P + ((long)WS_PSQ - (long)WS_PM));
          const int t_ = wid * 64 + lane, r_ = t_ >> 1, hf = t_ & 1; const float* pp = psq + (size_t)(u.pm * BM + r_) * 32 + hf * 16; float s = 0.f;
#pragma unroll
          for (int j = 0; j < 4; ++j) { const f32x4 v = *(const f32x4*)(pp + 4 * j); s += (v[0] + v[1]) + (v[2] + v[3]); }
          s += __shfl_xor(s, 1);
          if (!hf) Rs[r_] = rsqrtf(s * (1.f / DM) + NORM_EPS); }
#pragma unroll
        for (int ai = 0; ai < 2; ++ai)
#pragma unroll
            for (int m = 0; m < 4; ++m) { float mx = -3.0e38f;
#pragma unroll
                for (int bj = 0; bj < 2; ++bj)
#pragma unroll
                    for (int n = 0; n < 2; ++n) { acc[ai][bj][m][n] = acc[ai][bj][m][n] * scale_log2e; const f32x4 x = acc[ai][bj][m][n]; mx = fmaxf(mx, fmaxf(fmaxf(x[0], x[1]), fmaxf(x[2], x[3]))); }
                mx = fmaxf(mx, __shfl_xor(mx, 16)); mx = fmaxf(mx, __shfl_xor(mx, 32));
                if (fq == 0) Pm[(ai * HALF + wr * 64 + m * 16 + fr) * 4 + wc] = mx; }
        asm volatile("s_waitcnt lgkmcnt(0)" ::: "memory"); __builtin_amdgcn_s_barrier(); asm volatile("" ::: "memory");
#pragma unroll
        for (int ai = 0; ai < 2; ++ai)
#pragma unroll
            for (int m = 0; m < 4; ++m) { const int r = ai * HALF + wr * 64 + m * 16 + fr; const f32x4 pm4 = *(const PG8_LAS f32x4*)(Pm + r * 4);
                const float mx = fmaxf(fmaxf(pm4[0], pm4[1]), fmaxf(pm4[2], pm4[3])), rsr = Rs[r]; float s = 0.f;
#pragma unroll
                for (int bj = 0; bj < 2; ++bj)
#pragma unroll
                    for (int n = 0; n < 2; ++n) { f32x4 x = acc[ai][bj][m][n];
#pragma unroll
                        for (int i = 0; i < 4; ++i) x[i] = __builtin_amdgcn_exp2f((x[i] - mx) * rsr);
                        acc[ai][bj][m][n] = x; s += (x[0] + x[1]) + (x[2] + x[3]); }
                s += __shfl_xor(s, 16); s += __shfl_xor(s, 32);
                if (fq == 0) Ps[r * 4 + wc] = s; }
        asm volatile("s_waitcnt lgkmcnt(0)" ::: "memory"); __builtin_amdgcn_s_barrier(); asm volatile("" ::: "memory");
        bf16_t* base = P + (size_t)(u.pm * BM) * 1024 + u.pn * BM + wc * 32 + 8 * fq;
#pragma unroll
        for (int ai = 0; ai < 2; ++ai)
#pragma unroll
            for (int m = 0; m < 4; ++m) { const int r = ai * HALF + wr * 64 + m * 16 + fr; const f32x4 ps4 = *(const PG8_LAS f32x4*)(Ps + r * 4);
                const float inv = 1.0f / ((ps4[0] + ps4[1]) + (ps4[2] + ps4[3]));
#pragma unroll
                for (int bj = 0; bj < 2; ++bj) *(u32x4*)(base + (size_t)r * 1024 + bj * HALF) = pack8(acc[ai][bj][m][0] * inv, acc[ai][bj][m][1] * inv); }
    }
};
struct EpiGateUp {
    static constexpr bool PERM = true, AFTER_DRAIN = false;
    bf16_t* HID;
    __device__ __forceinline__ void operator()(const f32x4 (&acc)[2][2][4][2], const Unit& u, int wr, int wc, int fr, int fq) const {
        bf16_t* base = HID + (size_t)(u.pm * BM + wr * 64 + fr) * D_EXP + (u.pn & 7) * HALF + wc * 32 + 8 * fq;
#pragma unroll
        for (int ai = 0; ai < 2; ++ai)
#pragma unroll
            for (int m = 0; m < 4; ++m) { f32x4 h[2];
#pragma unroll
                for (int n = 0; n < 2; ++n) { const f32x4 gt = acc[ai][0][m][n], up = acc[ai][1][m][n];
#pragma unroll
                    for (int i = 0; i < 4; ++i) h[n][i] = gt[i] * __builtin_amdgcn_rcpf(1.0f + __builtin_amdgcn_exp2f(-1.4426950408889634f * gt[i])) * up[i]; }
                *(u32x4*)(base + (size_t)(ai * HALF + m * 16) * D_EXP) = pack8(h[0], h[1]); }
    }
};
struct EpiYC {
    static constexpr bool PERM = false, AFTER_DRAIN = false;
    float* YC;
    __device__ __forceinline__ void operator()(const f32x4 (&acc)[2][2][4][2], const Unit& u, int wr, int wc, int fr, int fq) const {
        float* base = YC + (size_t)(u.pm * BM + wr * 64 + fr) * DM + (u.pn & 7) * BM + wc * 32 + 4 * fq;
#pragma unroll
        for (int ai = 0; ai < 2; ++ai)
#pragma unroll
            for (int m = 0; m < 4; ++m)
#pragma unroll
                for (int bj = 0; bj < 2; ++bj)
#pragma unroll
                    for (int n = 0; n < 2; ++n) *(f32x4*)(base + (size_t)(ai * HALF + m * 16) * DM + bj * HALF + n * 16) = acc[ai][bj][m][n];
    }
};
struct HeadOrderS { int G, c;
    __device__ __forceinline__ bool next(int i, Unit& u) const { const int L = i * G + c; if (L >= 32) return false; u.pm = L >> 3; u.pn = L; return true; }
    __device__ __forceinline__ void a_ready(const Unit&) const {} __device__ __forceinline__ void done(const Unit&) const {} };
struct HeadOrderO { int G, c;
    __device__ __forceinline__ bool next(int i, Unit& u) const { const int L = i * G + c; if (L >= 32) return false; u.pm = L; u.pn = 4 + (L >> 3); return true; }
    __device__ __forceinline__ void a_ready(const Unit&) const {} __device__ __forceinline__ void done(const Unit&) const {} };
struct MoeOrder { const unsigned* ctl; int G, c;
    __device__ __forceinline__ bool next(int i, Unit& u) const { const int L = i * G + c;
        const int nt = (int)__hip_atomic_load(ctl + CW_NT, __ATOMIC_RELAXED, __HIP_MEMORY_SCOPE_AGENT); if (L >= nt * 8) return false;
        u.pm = L >> 3; u.pn = (int)__hip_atomic_load(ctl + CW_TILEE + u.pm, __ATOMIC_RELAXED, __HIP_MEMORY_SCOPE_AGENT) * 8 + (L & 7); return true; }
    __device__ __forceinline__ void a_ready(const Unit&) const {} __device__ __forceinline__ void done(const Unit&) const {} };
}

#include <hip/hip_bf16.h>
#include <cmath>
namespace attn_body {
using bf16=__hip_bfloat16;
using bf16x8=__attribute__((ext_vector_type(8)))short;
using s16x4=__attribute__((ext_vector_type(4)))short;
using f32x16=__attribute__((ext_vector_type(16)))float;
using u32x4=__attribute__((ext_vector_type(4)))unsigned;
constexpr int BATCH=2,NHEAD=16,SEQ=8192,D=64,DM=NHEAD*D;
constexpr int NW=8,QBLK=32,QB=QBLK*NW,KVBLK=64,NQB=SEQ/QB;
constexpr int ATTN_PITCH=DM, ATTN_UNIT_ROWS=QB;
__device__ __forceinline__ int crow(int r,int hi){return (r&3)+8*(r>>2)+4*hi;}
#define SBAR() __builtin_amdgcn_sched_barrier(0)
__device__ __forceinline__ void cmask(f32x16&p0,f32x16&p1,int jb,int qrel,int hi){
  const float NEG=-INFINITY; int kb=64*jb+4*hi;
  #pragma unroll
  for(int r=0;r<16;++r){int kv=kb+(r&3)+8*(r>>2); if(kv>qrel)p0[r]=NEG; if(kv+32>qrel)p1[r]=NEG;}
}

constexpr int NSLOT=3, SLOTB=8192;
constexpr int LDS_K=0, LDS_V=NSLOT*SLOTB, LDS_WS=2*NSLOT*SLOTB, LDS_OST=LDS_WS+NW*64*4, LDS_BYTES=LDS_OST+NW*4096;
constexpr float C2=0.125f*1.4426950408889634f;
__device__ __forceinline__ void glds16(const void*gsrc,unsigned lds_dst){unsigned keep;
  asm volatile("s_mov_b32 %0, m0\n\ts_mov_b32 m0, %2\n\ts_nop 0\n\tglobal_load_lds_dwordx4 %1, off\n\ts_mov_b32 m0, %0":"=&s"(keep):"v"(gsrc),"s"(lds_dst):"memory");}
__device__ __forceinline__ float max3f(float a,float b,float c){float r;asm("v_max3_f32 %0, %1, %2, %3":"=v"(r):"v"(a),"v"(b),"v"(c));return r;}
__device__ __forceinline__ float max2f(float a,float b){float r;asm("v_max_f32_e32 %0, %1, %2":"=v"(r):"v"(a),"v"(b));return r;}
__device__ __forceinline__ float fadd_s(float a,float b){float r;asm("v_add_f32_e32 %0, %1, %2":"=v"(r):"v"(a),"v"(b));return r;}
__device__ __forceinline__ float fsub_s(float a,float b){float r;asm("v_sub_f32_e32 %0, %1, %2":"=v"(r):"v"(a),"v"(b));return r;}
typedef float f32x2_t __attribute__((ext_vector_type(2))); typedef __bf16 bf16x2_t __attribute__((ext_vector_type(2)));
__device__ __forceinline__ unsigned cvtpk_s(float lo,float hi){f32x2_t v={lo,hi};bf16x2_t b=__builtin_convertvector(v,bf16x2_t);return __builtin_bit_cast(unsigned,b);}
#define WAIT_BAR(N) asm volatile("s_waitcnt vmcnt(" #N ") lgkmcnt(0)\n\ts_barrier":::"memory")

__device__ __forceinline__ void qkt(f32x16&p0,f32x16&p1,const char*Kslot,const bf16x8*qr,const f32x16&negm,int r32,int hi){
  const char*kb=Kslot+hi*1024+r32*16;
  #pragma unroll
  for(int d0=0;d0<4;++d0){
    const bf16x8 b0=*reinterpret_cast<const bf16x8*>(kb+d0*2048);
    const bf16x8 b1=*reinterpret_cast<const bf16x8*>(kb+d0*2048+512);
    if(d0==0){p0=__builtin_amdgcn_mfma_f32_32x32x16_bf16(b0,qr[0],negm,0,0,0);p1=__builtin_amdgcn_mfma_f32_32x32x16_bf16(b1,qr[0],negm,0,0,0);}
    else{p0=__builtin_amdgcn_mfma_f32_32x32x16_bf16(b0,qr[d0],p0,0,0,0);p1=__builtin_amdgcn_mfma_f32_32x32x16_bf16(b1,qr[d0],p1,0,0,0);}}
}
typedef __attribute__((address_space(3))) const char* lds_cptr;
typedef short v4i16_t __attribute__((ext_vector_type(4)));
__device__ __forceinline__ void kload8(bf16x8*kf,lds_cptr kp){
  kf[0]=*(const __attribute__((address_space(3))) bf16x8*)(kp);      kf[1]=*(const __attribute__((address_space(3))) bf16x8*)(kp+512);
  kf[2]=*(const __attribute__((address_space(3))) bf16x8*)(kp+2048); kf[3]=*(const __attribute__((address_space(3))) bf16x8*)(kp+2560);
  kf[4]=*(const __attribute__((address_space(3))) bf16x8*)(kp+4096); kf[5]=*(const __attribute__((address_space(3))) bf16x8*)(kp+4608);
  kf[6]=*(const __attribute__((address_space(3))) bf16x8*)(kp+6144); kf[7]=*(const __attribute__((address_space(3))) bf16x8*)(kp+6656);
}
__device__ __forceinline__ void kload2(bf16x8*kf,lds_cptr kp,int j){ kf[2*j]=*(const __attribute__((address_space(3))) bf16x8*)(kp+j*2048); kf[2*j+1]=*(const __attribute__((address_space(3))) bf16x8*)(kp+j*2048+512); }
__device__ __forceinline__ s16x4 vtr(lds_cptr p){ return __builtin_bit_cast(s16x4,__builtin_amdgcn_ds_read_tr16_b64_v4i16((__attribute__((address_space(3))) v4i16_t*)p)); }
__device__ __forceinline__ float rowmax(const f32x16&p0,const f32x16&p1){
  float a=max3f(p0[0],p0[1],p1[0]),b=max3f(p0[2],p0[3],p1[1]);a=max3f(a,p1[2],p1[3]);
  #pragma unroll
  for(int r=4;r<16;r+=4){a=max3f(a,p0[r],p0[r+1]);b=max3f(b,p0[r+2],p0[r+3]);a=max3f(a,p1[r],p1[r+1]);b=max3f(b,p1[r+2],p1[r+3]);}
  const float m=max2f(a,b);
  auto rr=__builtin_amdgcn_permlane32_swap(__float_as_uint(m),__float_as_uint(m),false,false);
  return max2f(__uint_as_float(rr[0]),__uint_as_float(rr[1]));
}
__device__ __forceinline__ void pv(f32x16*o,int vb,bf16x8 pa0,bf16x8 pa1,bf16x8 pa2,bf16x8 pa3){
  #pragma unroll
  for(int d0=0;d0<2;++d0){s16x4 lo[4],hi[4];
    #pragma unroll
    for(int ks=0;ks<4;++ks){
      asm volatile("ds_read_b64_tr_b16 %0,%1 offset:%c2":"=&v"(lo[ks]):"v"(vb),"i"(d0*4096+ks*1024):"memory");
      asm volatile("ds_read_b64_tr_b16 %0,%1 offset:%c2":"=&v"(hi[ks]):"v"(vb),"i"(d0*4096+ks*1024+512):"memory");}
    asm volatile("s_waitcnt lgkmcnt(0)":::"memory");SBAR();
    #define PK(k) (bf16x8){lo[k][0],lo[k][1],lo[k][2],lo[k][3],hi[k][0],hi[k][1],hi[k][2],hi[k][3]}
    o[d0]=__builtin_amdgcn_mfma_f32_32x32x16_bf16(pa0,PK(0),o[d0],0,0,0);
    o[d0]=__builtin_amdgcn_mfma_f32_32x32x16_bf16(pa1,PK(1),o[d0],0,0,0);
    o[d0]=__builtin_amdgcn_mfma_f32_32x32x16_bf16(pa2,PK(2),o[d0],0,0,0);
    o[d0]=__builtin_amdgcn_mfma_f32_32x32x16_bf16(pa3,PK(3),o[d0],0,0,0);
    #undef PK
  }
}

#ifndef ATTN_STORE16
#define ATTN_STORE16(p,v) (*(u32x4*)(p)=(v))
#endif
template<int THRL> __device__ __forceinline__ void attn_unit(int b,int h,int qb,const bf16*Q,const bf16*__restrict__ K,const bf16*__restrict__ V,bf16*O,char*shm){
  const int tid=threadIdx.x,lane=tid&63,r32=lane&31,hi=lane>>5; const int wid=__builtin_amdgcn_readfirstlane(tid>>6);
  const long rowbase=(long)b*SEQ; const int q0=qb*QB;
  const bf16*Qw=Q+(rowbase+q0+wid*QBLK)*DM+h*D;
  const bf16*Kh=K+rowbase*DM+h*D,*Vh=V+rowbase*DM+h*D;
  const unsigned lds0=(unsigned)(uintptr_t)shm;
  float*wsf=(float*)(shm+LDS_WS)+wid*64;
  const bf16*ksrc=Kh+(long)lane*DM+wid*8;
  const bf16*vsrc=Vh+(long)(16*(wid&3)+(lane>>2))*DM+(wid>>2)*32+(lane&3)*8;
  const unsigned kdst=lds0+LDS_K+wid*1024, vdst=lds0+LDS_V+wid*1024;
  #define DMA_K(t,slot) glds16(ksrc+(long)(t)*KVBLK*DM,(unsigned)__builtin_amdgcn_readfirstlane(kdst+(slot)))
  #define DMA_V(t,slot) glds16(vsrc+(long)(t)*KVBLK*DM,(unsigned)__builtin_amdgcn_readfirstlane(vdst+(slot)))
  const int vb0=(int)(lds0+LDS_V)+((lane>>4)&1)*32+(lane&3)*8+(4*hi+((lane&15)>>2))*64;
  const char*Kbase=shm+LDS_K; bf16x8 kf[8];
  const lds_cptr shm3=(lds_cptr)shm; const lds_cptr kp0=shm3+LDS_K+hi*1024+r32*16; const lds_cptr vp0=shm3+LDS_V+((lane>>4)&1)*32+(lane&3)*8+(4*hi+((lane&15)>>2))*64;
  const int NT=(q0+QB)/KVBLK;
  DMA_K(0,0);DMA_V(0,0);DMA_K(1,SLOTB);
  bf16x8 qr[4];
  #pragma unroll
  for(int d0=0;d0<4;++d0)qr[d0]=*reinterpret_cast<const bf16x8*>(&Qw[(long)r32*DM+d0*16+hi*8]);
  float mhat=0.f,l_reg=0.f;f32x16 o[2];o[0]=f32x16{};o[1]=f32x16{};f32x16 negm=f32x16{};asm volatile("":"+v"(negm));
  const int qrel=wid*QBLK+r32;
  #define CMASK(P0,P1,t) do{int jb_=(t)-(NT-4); if(jb_>=0)cmask(P0,P1,jb_,qrel,hi);}while(0)
  bool resc=false;
  #define START(P0,P1) do{ const float rm=rowmax(P0,P1); resc=false; \
    { const float dl=rm; mhat=fadd_s(mhat,dl); \
      _Pragma("unroll") for(int r=0;r<16;++r){P0[r]=fsub_s(P0[r],dl);P1[r]=fsub_s(P1[r],dl);} \
      _Pragma("unroll") for(int r=0;r<16;++r)negm[r]=-mhat; asm volatile("":"+v"(negm)); } \
    _Pragma("unroll") for(int r=0;r<16;++r)P0[r]=__builtin_amdgcn_exp2f(P0[r]); }while(0)
  #define RESC() do{ if(resc){ asm volatile("s_waitcnt lgkmcnt(0)":::"memory"); \
      _Pragma("unroll") for(int d_=0;d_<2;++d_) _Pragma("unroll") for(int r=0;r<16;++r)o[d_][r]*=wsf[crow(r,hi)]; } }while(0)
  f32x16 pA0,pA1,pB0,pB1;
  int sl_prev=0,sl_cur=0,sl_next=SLOTB;
  #define ROT() do{sl_prev=sl_cur;sl_cur=sl_next;sl_next=(sl_next==(NSLOT-1)*SLOTB)?0:sl_next+SLOTB;}while(0)
  DMA_K(2,2*SLOTB);
  WAIT_BAR(3);
  qkt(pA0,pA1,Kbase,qr,negm,r32,hi);asm volatile("s_nop 15\n\ts_nop 7":"+v"(pA0),"+v"(pA1));CMASK(pA0,pA1,0);
  START(pA0,pA1);
  _Pragma("unroll") for(int r=0;r<16;++r)pA1[r]=__builtin_amdgcn_exp2f(pA1[r]);
  WAIT_BAR(0);
  DMA_K(3,0);DMA_V(1,SLOTB);
  ROT();
  kload8(kf,kp0+sl_cur);
  WAIT_BAR(2);
  s16x4 vlo[8],vhi[8]; u32x4 pw0,pw1,pw2,pw3;
  #define PKW(P,B) cvtpk_s(P[B],P[B+1])
  #define PAF(k) __builtin_bit_cast(bf16x8,pw##k)
  #define VFR(i) (bf16x8){vlo[i][0],vlo[i][1],vlo[i][2],vlo[i][3],vhi[i][0],vhi[i][1],vhi[i][2],vhi[i][3]}
  #define PIN(x) asm volatile("":"+v"(x))
  #define MX3(a,b,c) __builtin_fmaxf(__builtin_fmaxf((a),(b)),(c))
  #define GAPA(MF,A0,A1,A2,A3,W0,W1,PW) do{ MF; sacc+=A0; sacc+=A1; sacc+=A2; sacc+=A3; PIN(sacc); W0; W1; PIN(PW); SBAR(); }while(0)
  #define EX(v) __builtin_amdgcn_exp2f(v)
  #define GAPB(MF,X,B) do{ MF; X[B]=EX(X[B]); X[B+1]=EX(X[B+1]); X[B+2]=EX(X[B+2]); X[B+3]=EX(X[B+3]); PIN(X); SBAR(); }while(0)
  #define VRD(i) do{ vlo[i]=vtr(vp_+(((i)>>2)*4096+((i)&3)*1024)); vhi[i]=vtr(vp_+(((i)>>2)*4096+((i)&3)*1024+512)); }while(0)
  #define KRD(G,j) do{ if(G){ kload2(kf,kp0+sl_next,j); SBAR(); } }while(0)
  #define STEP(C0,C1,P0,P1,t,GK,GV,GL) do{ SBAR(); \
    const lds_cptr vp_=vp0+sl_prev; \
    VRD(0); SBAR(); float sacc=(P0[0]+P0[1]); \
    GAPA(C0=__builtin_amdgcn_mfma_f32_32x32x16_bf16(kf[0],qr[0],negm,0,0,0), P0[2],P0[3],P0[4],P0[5],     pw0[0]=PKW(P0,0), pw0[1]=PKW(P0,2), pw0); \
    VRD(4); SBAR(); GAPA(C1=__builtin_amdgcn_mfma_f32_32x32x16_bf16(kf[1],qr[0],negm,0,0,0), P0[6],P0[7],P0[8],P0[9],     pw0[2]=PKW(P0,4), pw0[3]=PKW(P0,6), pw0); \
    VRD(1); SBAR(); GAPA(C0=__builtin_amdgcn_mfma_f32_32x32x16_bf16(kf[2],qr[1],C0,0,0,0),   P0[10],P0[11],P0[12],P0[13], pw1[0]=PKW(P0,8), pw1[1]=PKW(P0,10), pw1); \
    VRD(5); SBAR(); GAPA(C1=__builtin_amdgcn_mfma_f32_32x32x16_bf16(kf[3],qr[1],C1,0,0,0),   P0[14],P0[15],P1[0],P1[1],   pw1[2]=PKW(P0,12),pw1[3]=PKW(P0,14), pw1); \
    VRD(2); SBAR(); GAPA(C0=__builtin_amdgcn_mfma_f32_32x32x16_bf16(kf[4],qr[2],C0,0,0,0),   P1[2],P1[3],P1[4],P1[5],     pw2[0]=PKW(P1,0), pw2[1]=PKW(P1,2), pw2); \
    VRD(6); SBAR(); GAPA(C1=__builtin_amdgcn_mfma_f32_32x32x16_bf16(kf[5],qr[2],C1,0,0,0),   P1[6],P1[7],P1[8],P1[9],     pw2[2]=PKW(P1,4), pw2[3]=PKW(P1,6), pw2); \
    VRD(3); SBAR(); GAPA(C0=__builtin_amdgcn_mfma_f32_32x32x16_bf16(kf[6],qr[3],C0,0,0,0),   P1[10],P1[11],P1[12],P1[13], pw3[0]=PKW(P1,8), pw3[1]=PKW(P1,10), pw3); \
    VRD(7); SBAR(); GAPA(C1=__builtin_amdgcn_mfma_f32_32x32x16_bf16(kf[7],qr[3],C1,0,0,0),   P1[14],P1[15],0.f,0.f,       pw3[2]=PKW(P1,12),pw3[3]=PKW(P1,14), pw3); \
    l_reg+=sacc; \
    if(GK){DMA_K((t)+3,sl_cur);} if(GV){DMA_V((t)+1,sl_next);} \
    CMASK(C0,C1,t); \
    { float a=MX3(C0[0],C0[1],C1[0]),b=MX3(C0[2],C0[3],C1[1]); a=MX3(a,C1[2],C1[3]); \
      _Pragma("unroll") for(int r=4;r<16;r+=4){a=MX3(a,C0[r],C0[r+1]);b=MX3(b,C0[r+2],C0[r+3]);a=MX3(a,C1[r],C1[r+1]);b=MX3(b,C1[r+2],C1[r+3]);} \
      float rm=__builtin_fmaxf(a,b); { auto rr=__builtin_amdgcn_permlane32_swap(__float_as_uint(rm),__float_as_uint(rm),false,false); rm=__builtin_fmaxf(__uint_as_float(rr[0]),__uint_as_float(rr[1])); } \
      resc=false; \
      if(__builtin_expect(__any(rm>(float)THRL),0)){ const float dl=__builtin_fmaxf(rm,0.f); mhat+=dl; \
        _Pragma("unroll") for(int r=0;r<16;++r){C0[r]-=dl;C1[r]-=dl;} \
        _Pragma("unroll") for(int r=0;r<16;++r)negm[r]=-mhat; asm volatile("":"+v"(negm)); \
        const float f=__builtin_amdgcn_exp2f(-dl); l_reg*=f; if(hi==0)wsf[r32]=f; resc=true; } } \
    SBAR(); \
    GAPB(o[0]=__builtin_amdgcn_mfma_f32_32x32x16_bf16(PAF(0),VFR(0),o[0],0,0,0), C0,0); \
    GAPB(o[1]=__builtin_amdgcn_mfma_f32_32x32x16_bf16(PAF(0),VFR(4),o[1],0,0,0), C0,4); \
    KRD(GL,0); GAPB(o[0]=__builtin_amdgcn_mfma_f32_32x32x16_bf16(PAF(1),VFR(1),o[0],0,0,0), C0,8); \
    KRD(GL,1); GAPB(o[1]=__builtin_amdgcn_mfma_f32_32x32x16_bf16(PAF(1),VFR(5),o[1],0,0,0), C0,12); \
    KRD(GL,2); GAPB(o[0]=__builtin_amdgcn_mfma_f32_32x32x16_bf16(PAF(2),VFR(2),o[0],0,0,0), C1,0); \
    KRD(GL,3); GAPB(o[1]=__builtin_amdgcn_mfma_f32_32x32x16_bf16(PAF(2),VFR(6),o[1],0,0,0), C1,4); \
    GAPB(o[0]=__builtin_amdgcn_mfma_f32_32x32x16_bf16(PAF(3),VFR(3),o[0],0,0,0), C1,8); \
    GAPB(o[1]=__builtin_amdgcn_mfma_f32_32x32x16_bf16(PAF(3),VFR(7),o[1],0,0,0), C1,12); \
    }while(0)
  int t=1;
  #undef CMASK
  #define CMASK(P0,P1,t) do{}while(0)
  for(;t+5<NT;t+=2){
    STEP(pB0,pB1,pA0,pA1,t,true,true,true);     WAIT_BAR(2); RESC(); ROT();
    STEP(pA0,pA1,pB0,pB1,t+1,true,true,true);   WAIT_BAR(2); RESC(); ROT();
  }
  #undef CMASK
  #define CMASK(P0,P1,t) do{int jb_=(t)-(NT-4); if(jb_>=0)cmask(P0,P1,jb_,qrel,hi);}while(0)
  #define ENDW(tt) do{ if((tt)+3<NT){WAIT_BAR(2);} else if((tt)+2<NT){WAIT_BAR(1);} else {WAIT_BAR(0);} }while(0)
  for(;t+1<NT;t+=2){
    STEP(pB0,pB1,pA0,pA1,t,(t+3<NT),(t+1<NT),(t+1<NT));       ENDW(t);   RESC(); ROT();
    STEP(pA0,pA1,pB0,pB1,t+1,(t+4<NT),(t+2<NT),(t+2<NT));     ENDW(t+1); RESC(); ROT();
  }
  STEP(pB0,pB1,pA0,pA1,NT-1,false,false,false); RESC();
  { float sacc=pB0[0]+pB0[1]; _Pragma("unroll") for(int r=2;r<16;++r)sacc+=pB0[r]; _Pragma("unroll") for(int r=0;r<16;++r)sacc+=pB1[r]; l_reg+=sacc;
    pw0=(u32x4){PKW(pB0,0),PKW(pB0,2),PKW(pB0,4),PKW(pB0,6)};pw1=(u32x4){PKW(pB0,8),PKW(pB0,10),PKW(pB0,12),PKW(pB0,14)};pw2=(u32x4){PKW(pB1,0),PKW(pB1,2),PKW(pB1,4),PKW(pB1,6)};pw3=(u32x4){PKW(pB1,8),PKW(pB1,10),PKW(pB1,12),PKW(pB1,14)};
    SBAR(); pv(o,vb0+sl_cur,PAF(0),PAF(1),PAF(2),PAF(3)); }
  #undef PKW
  #undef PAF
  #undef VFR
  #undef PIN
  #undef MX3
  #undef GAPA
  #undef GAPB
  #undef EX
  #undef VRD
  #undef KRD
  #undef STEP
  #undef ENDW
  {auto rr=__builtin_amdgcn_permlane32_swap(__float_as_uint(l_reg),__float_as_uint(l_reg),false,false);l_reg=__uint_as_float(rr[0])+__uint_as_float(rr[1]);}
  if(hi==0)wsf[32+r32]=l_reg;asm volatile("s_waitcnt lgkmcnt(0)":::"memory");
  float rli[16];
  #pragma unroll
  for(int r=0;r<16;++r)rli[r]=__builtin_amdgcn_rcpf(wsf[32+crow(r,hi)]);
  bf16*Ow=O+(rowbase+q0+wid*QBLK)*DM+h*D;
  { bf16*stg=(bf16*)(shm+LDS_OST)+wid*2048;
    #pragma unroll
    for(int r=0;r<16;++r){const int orow=crow(r,hi);
      #pragma unroll
      for(int d0=0;d0<2;++d0)stg[orow*64+d0*32+r32]=__float2bfloat16(o[d0][r]*rli[r]);}
    asm volatile("s_waitcnt lgkmcnt(0)":::"memory");
    #pragma unroll
    for(int i=0;i<4;++i){const int row=i*8+(lane>>3),ch=lane&7; const u32x4 v=*(const u32x4*)(stg+row*64+ch*8); ATTN_STORE16(Ow+(long)row*DM+ch*8,v);} }
  asm volatile("s_waitcnt lgkmcnt(0)\n\ts_barrier":::"memory");
  #undef DMA_K
  #undef DMA_V
  #undef CMASK
  #undef START
  #undef RESC
  #undef ROT
}
constexpr int ATTN_LDS_BYTES=LDS_BYTES;
struct AttnTensors { const bf16* Q; const bf16* K; const bf16* V; bf16* O; };
struct AttnUnit { int bh; int qb; };
struct StaticOrder {
  int vcu;
  __device__ __forceinline__ explicit StaticOrder(int grid,int block):vcu((block%8)*(grid/8)+block/8){}
  __device__ __forceinline__ bool next(int i,AttnUnit&u)const{ if(i>=4)return false; const int s=vcu&7; u.bh=vcu>>3; u.qb=(i==0)?s:(i==1)?15-s:(i==2)?16+s:31-s; return true; }
  __device__ __forceinline__ void a_ready(const AttnUnit&)const{}
  __device__ __forceinline__ void done(const AttnUnit&)const{}
};
struct QueueOrder {
  unsigned* head; volatile __attribute__((address_space(3))) unsigned* slot; int grp;
  __device__ __forceinline__ bool next(int,AttnUnit&u)const{
    __syncthreads();
    if(threadIdx.x==0) slot[0]=__hip_atomic_fetch_add(head+64*grp,1u,__ATOMIC_RELAXED,__HIP_MEMORY_SCOPE_AGENT);
    __syncthreads();
    const unsigned q=slot[0]; if(q>=128u)return false;
    u.qb=31-(int)(q>>2); u.bh=4*grp+(int)(q&3u); return true; }
  __device__ __forceinline__ void a_ready(const AttnUnit&)const{}
  __device__ __forceinline__ void done(const AttnUnit&)const{}
};
template<class Sched,int THRL=8> __device__ __forceinline__ void attn_phase(char*lds,const AttnTensors&T,const Sched&S){
  AttnUnit u;
  for(int i=0;S.next(i,u);++i){ S.a_ready(u); { const int st=u.bh, h=(st>>1)&15, e=st&1, hv=(((st>>2)&7)<<1)+e; attn_unit<THRL>(st>>5,h,u.qb,T.Q,T.K,T.V+(hv-h)*D,T.O+(size_t)e*SEQ*DM,lds); } S.done(u); }
}
#undef SBAR
#undef WAIT_BAR
}
#define GAS __attribute__((address_space(1)))
#define LAS __attribute__((address_space(3)))
typedef unsigned short bf16;
typedef unsigned v4u __attribute__((ext_vector_type(4)));
typedef short bf16x8 __attribute__((ext_vector_type(8)));
typedef GAS unsigned gu32;
typedef GAS unsigned long long gu64;
#define RLX_AGENT __ATOMIC_RELAXED, __HIP_MEMORY_SCOPE_AGENT
#define LDS_WAIT() asm volatile("s_waitcnt lgkmcnt(0)" ::: "memory")
#define VM_WAIT() asm volatile("s_waitcnt vmcnt(0)" ::: "memory")
__device__ __forceinline__ unsigned long long rt() { return __builtin_amdgcn_s_memrealtime(); }

#define XB_TMO      128
#define XB_XCNT(j)  (256  + 64 * (j))
#define XB_XSUB(j)  (1280 + 64 * (j))
#define XB_XGEN(j)  (2304 + 64 * (j))
#define XB_TOP      3328
#define XB_TOPGEN   3392
#define XCD_BAR_WORDS 3456
#define XB_SPIN_CAP (1u << 18)

__device__ __forceinline__ unsigned xb_ld(unsigned* p)              { return __hip_atomic_load(p, __ATOMIC_RELAXED, __HIP_MEMORY_SCOPE_AGENT); }
__device__ __forceinline__ unsigned xb_add(unsigned* p, unsigned v) { return __hip_atomic_fetch_add(p, v, __ATOMIC_RELAXED, __HIP_MEMORY_SCOPE_AGENT); }
__device__ __forceinline__ unsigned xb_xcc_id() { return (unsigned)__builtin_amdgcn_s_getreg((3 << 11) | 20) & 0xFu; }
#define XB_SPIN(cond, bar) do { unsigned _sp = 0; while (cond) { __builtin_amdgcn_s_sleep(1); \
    if ((++_sp & 255u) == 0u) { if (xb_ld(&(bar)[XB_TMO])) break; if (_sp > XB_SPIN_CAP) { atomicAdd(&(bar)[XB_TMO], 1u); break; } } } } while (0)

struct XcdBarrier {
    unsigned* bar; unsigned x;
    volatile LAS unsigned* st;
};

__device__ __forceinline__ XcdBarrier xcd_barrier_post(unsigned* bar, volatile LAS unsigned* st) {
    XcdBarrier b; b.bar = bar; b.x = xb_xcc_id(); b.st = st;
    if (threadIdx.x == 0) (void)xb_add(&bar[XB_XCNT(b.x)], 1u);
    return b;
}
__device__ __forceinline__ void xcd_barrier_complete(unsigned* bar, unsigned x, unsigned& nloc, unsigned& nx) {
    const unsigned G = gridDim.x * gridDim.y * gridDim.z;
    unsigned sum, cnt, mine, sp = 0u;
    for (;;) {
        sum = 0u; cnt = 0u; mine = 0u;
#pragma unroll
        for (unsigned j = 0; j < 16; ++j) { const unsigned c = xb_ld(&bar[XB_XCNT(j)]); sum += c; cnt += (c > 0u) ? 1u : 0u; mine = (j == x) ? c : mine; }
        if (sum == G) break;
        __builtin_amdgcn_s_sleep(1);
        if ((++sp & 255u) == 0u) { if (xb_ld(&bar[XB_TMO])) break; if (sp > XB_SPIN_CAP) { atomicAdd(&bar[XB_TMO], 1u); break; } }
    }
    nloc = mine > 0u ? mine : 1u; nx = cnt > 0u ? cnt : 1u;
}

__device__ __forceinline__ void xcd_barrier(const XcdBarrier& b) {
    asm volatile("s_waitcnt vmcnt(0)" ::: "memory");
    __syncthreads();
    if (threadIdx.x == 0) {
        unsigned* bar = b.bar;
        __builtin_amdgcn_s_waitcnt(0);
        unsigned nloc = b.st[0], nx = b.st[1];
        if (nloc == 0u) { xcd_barrier_complete(bar, b.x, nloc, nx); b.st[0] = nloc; b.st[1] = nx; }
        const unsigned old = xb_add(&bar[XB_XSUB(b.x)], 1u);
        const unsigned gen = old / nloc;
        if (old + 1u == (gen + 1u) * nloc) {
            __builtin_amdgcn_fence(__ATOMIC_RELEASE, "agent");
            asm volatile("s_waitcnt vmcnt(0)" ::: "memory");
            const unsigned og = xb_add(&bar[XB_TOP], 1u);
            const unsigned tg = og / nx;
            if (og + 1u == (tg + 1u) * nx) xb_add(&bar[XB_TOPGEN], 1u);
            else XB_SPIN(xb_ld(&bar[XB_TOPGEN]) == tg, bar);
            __builtin_amdgcn_fence(__ATOMIC_ACQUIRE, "agent");
            xb_add(&bar[XB_XGEN(b.x)], 1u);
            asm volatile("s_waitcnt vmcnt(0)" ::: "memory");
        } else {
            XB_SPIN(xb_ld(&bar[XB_XGEN(b.x)]) == gen, bar);
            __builtin_amdgcn_fence(__ATOMIC_ACQUIRE, "agent");
            asm volatile("s_waitcnt vmcnt(0)" ::: "memory");
        }
    }
    __syncthreads();
}

__device__ __forceinline__ unsigned pk2(float lo, float hi) { return (unsigned)f2bf(lo) | ((unsigned)f2bf(hi) << 16); }
#define DPP_ADD(v, ctrl) v += __builtin_bit_cast(float, __builtin_amdgcn_update_dpp(0, __builtin_bit_cast(int, v), ctrl, 0xf, 0xf, true))
__device__ __forceinline__ float rowpair_sum(float v) { float a = v, b = v; asm("s_nop 1\n\tv_permlane16_swap_b32 %0, %1" : "+v"(a), "+v"(b)); return a + b; }
__device__ __forceinline__ float wave_allsum(float v) {
    DPP_ADD(v, 0xB1);
    DPP_ADD(v, 0x4E);
    DPP_ADD(v, 0x141);
    DPP_ADD(v, 0x140);
    v = rowpair_sum(v);
    { float a = v, b = v; asm("s_nop 1\n\tv_permlane32_swap_b32 %0, %1" : "+v"(a), "+v"(b)); v = a + b; }
    return v;
}
__device__ __forceinline__ float row16_sum(float v) { DPP_ADD(v, 0xB1); DPP_ADD(v, 0x4E); DPP_ADD(v, 0x141); DPP_ADD(v, 0x140); return v; }
struct PrepW { const float *mu, *w0, *w2, *a0, *a2, *g2, *k_k, *k_a, *r_k; };

__device__ __forceinline__ void prep_token_a(const bf16_t* PR, const PrepW& P, int t, int lt, LAS float* xs) {
    const bf16_t* cur = PR + (size_t)t * RWKV_COLS; const int c = 3072 + lt;
    const float a = bf2f(cur[c]), p = t > 0 ? bf2f(cur[c - RWKV_COLS]) : 0.f, v = a + (p - a) * P.mu[c];
    xs[lt] = lt < 64 ? tanhf(v) : (lt < 128 ? v : sigmoidf_(v));
}
__device__ __forceinline__ void prep_token_b(const bf16_t* PR, const PrepW& P, int t, int lt, const LAS float* xs, float* S0, float* BONUS) {
    const bf16_t* cur = PR + (size_t)t * RWKV_COLS;
    float lw[4], la[4], lg[4] = {0.f, 0.f, 0.f, 0.f};
#pragma unroll
    for (int i = 0; i < 4; ++i) { lw[i] = P.w0[lt * 4 + i]; la[i] = P.a0[lt * 4 + i]; }
#pragma unroll 4
    for (int j = 0; j < 64; ++j) { const f32x4 w = *(const GAS f32x4*)(P.w2 + (size_t)j * RW + lt * 4), a = *(const GAS f32x4*)(P.a2 + (size_t)j * RW + lt * 4); const float x0 = xs[j], x1 = xs[64 + j];
#pragma unroll
        for (int i = 0; i < 4; ++i) { lw[i] += x0 * w[i]; la[i] += x1 * a[i]; } }
#pragma unroll 4
    for (int j = 0; j < 128; ++j) { const f32x4 g = *(const GAS f32x4*)(P.g2 + (size_t)j * RW + lt * 4); const float x2 = xs[128 + j];
#pragma unroll
        for (int i = 0; i < 4; ++i) lg[i] += x2 * g[i]; }
    float r[4], k0[4], v[4], kk[4], a[4], ss = 0.f;
#pragma unroll
    for (int i = 0; i < 4; ++i) { const int c = lt * 4 + i;
        { const float x = bf2f(cur[c]), p = t > 0 ? bf2f(cur[c - RWKV_COLS]) : 0.f; r[i] = x + (p - x) * P.mu[c]; }
        { const float x = bf2f(cur[1024 + c]), p = t > 0 ? bf2f(cur[1024 + c - RWKV_COLS]) : 0.f; k0[i] = x + (p - x) * P.mu[1024 + c]; }
        { const float x = bf2f(cur[2048 + c]), p = t > 0 ? bf2f(cur[2048 + c - RWKV_COLS]) : 0.f; v[i] = x + (p - x) * P.mu[2048 + c]; }
        a[i] = sigmoidf_(la[i]); kk[i] = k0[i] * P.k_k[c]; ss += kk[i] * kk[i]; }
    ss = row16_sum(ss);
    const float inv = 1.f / fmaxf(sqrtf(ss), 1e-12f);
    float bon = 0.f; const size_t ob = (size_t)t * RW + lt * 4; constexpr size_t SS = (size_t)SEQ * RW;
    f32x4 o_r, o_w, o_k, o_v, o_a, o_b, o_g;
#pragma unroll
    for (int i = 0; i < 4; ++i) { const int c = lt * 4 + i;
        const float x = -lw[i], sp = fmaxf(x, 0.f) + log1pf(__expf(-fabsf(x))), wraw = -sp - 0.5f, dec = __expf(-__expf(wraw));
        const float kn = kk[i] * inv, k = k0[i] * (1.f + (a[i] - 1.f) * P.k_a[c]);
        bon += r[i] * k * P.r_k[c];
        o_r[i] = r[i]; o_w[i] = dec; o_k[i] = k; o_v[i] = v[i]; o_a[i] = -kn; o_b[i] = kn * a[i]; o_g[i] = lg[i]; }
    *(GAS f32x4*)(S0 + 0 * SS + ob) = o_r; *(GAS f32x4*)(S0 + 1 * SS + ob) = o_w; *(GAS f32x4*)(S0 + 2 * SS + ob) = o_k; *(GAS f32x4*)(S0 + 3 * SS + ob) = o_v;
    *(GAS f32x4*)(S0 + 4 * SS + ob) = o_a; *(GAS f32x4*)(S0 + 5 * SS + ob) = o_b; *(GAS f32x4*)(S0 + 6 * SS + ob) = o_g;
    bon = row16_sum(bon);
    if ((lt & 15) == 0) BONUS[t * 16 + (lt >> 4)] = bon;
}
__device__ __forceinline__ void scan_row(const float* S0, float* Y, int h, int vr, int lane) {
    constexpr size_t SS = (size_t)SEQ * RW; constexpr int U = 8;
    const GAS float* pr = (const GAS float*)S0 + h * 64 + lane; const GAS float* pv = (const GAS float*)S0 + 3 * SS + h * 64 + vr;
    float s = 0.f, yacc = 0.f;
    float cr[U], cw[U], ck[U], ca[U], cb[U], cv[U];
#pragma unroll
    for (int u = 0; u < U; ++u) { const size_t o = (size_t)u * RW; cr[u] = pr[o]; cw[u] = pr[SS + o]; ck[u] = pr[2 * SS + o]; ca[u] = pr[4 * SS + o]; cb[u] = pr[5 * SS + o]; cv[u] = pv[o]; }
    for (int t0 = 0; t0 < SEQ; t0 += U) {
        float nr[U], nw[U], nk[U], na[U], nb[U], nv[U];
        const int tn = (t0 + U < SEQ) ? t0 + U : t0;
#pragma unroll
        for (int u = 0; u < U; ++u) { const size_t o = (size_t)(tn + u) * RW; nr[u] = pr[o]; nw[u] = pr[SS + o]; nk[u] = pr[2 * SS + o]; na[u] = pr[4 * SS + o]; nb[u] = pr[5 * SS + o]; nv[u] = pv[o]; }
#pragma unroll
        for (int u = 0; u < U; ++u) {
            const float sa = wave_allsum(s * ca[u]);
            s = s * cw[u] + sa * cb[u] + cv[u] * ck[u];
            const float y = wave_allsum(s * cr[u]);
            yacc = (lane == ((t0 + u) & 63)) ? y : yacc; }
        if (((t0 + U) & 63) == 0) ((GAS float*)Y)[(size_t)(t0 + U - 64 + lane) * RW + h * 64 + vr] = yacc;
#pragma unroll
        for (int u = 0; u < U; ++u) { cr[u] = nr[u]; cw[u] = nw[u]; ck[u] = nk[u]; ca[u] = na[u]; cb[u] = nb[u]; cv[u] = nv[u]; }
    }
}
__device__ __forceinline__ void diff_post_token(const bf16_t* O2, float lam, const float* subln_w, bf16_t* MIXED, int t, int lt) {
    const int h = lt >> 5, d0 = (lt & 31) * 4; const bf16_t* ob2 = O2 + (size_t)(d0 >> 6) * SEQ * 1024 + (size_t)t * 1024 + (d0 & 63);
    const unsigned long long a = *(const GAS unsigned long long*)(ob2 + (2 * h) * 64), b = *(const GAS unsigned long long*)(ob2 + (2 * h + 1) * 64);
    f32x4 o; float q = 0.f;
#pragma unroll
    for (int i = 0; i < 4; ++i) { o[i] = bf2f((bf16_t)(a >> (16 * i))) - lam * bf2f((bf16_t)(b >> (16 * i))); q += o[i] * o[i]; }
    q = rowpair_sum(row16_sum(q));
    const float rs = rsqrtf(q * (1.f / 128.f) + SUBLN_EPS) * (1.f - LAMBDA_INIT); const f32x4 sw = *(const GAS f32x4*)(subln_w + d0);
    o = o * rs * sw;
    *(GAS unsigned long long*)(MIXED + (size_t)t * DM + 1024 + h * 128 + d0) = (unsigned long long)pk2(o[0], o[1]) | ((unsigned long long)pk2(o[2], o[3]) << 32);
}
typedef short bf16x8_t __attribute__((ext_vector_type(8)));
typedef float f32x16_t __attribute__((ext_vector_type(16)));
__device__ __forceinline__ int swz(int row, int k) { return row * 128 + ((((k >> 3) ^ row) & 7) << 4) + ((k & 7) << 1); }
__device__ __forceinline__ void mm64(const LAS unsigned char* Aop, const LAS unsigned char* Bop, int ta, int tb0, int lane, f32x4 (&acc)[2]) {
    const int fr = lane & 15, fq = lane >> 4;
    const bf16x8_t a0 = *(const LAS bf16x8_t*)(Aop + swz(16 * ta + fr, 8 * fq)), a1 = *(const LAS bf16x8_t*)(Aop + swz(16 * ta + fr, 32 + 8 * fq));
#pragma unroll
    for (int t = 0; t < 2; ++t) {
        const bf16x8_t b0 = *(const LAS bf16x8_t*)(Bop + swz(16 * (tb0 + t) + fr, 8 * fq)), b1 = *(const LAS bf16x8_t*)(Bop + swz(16 * (tb0 + t) + fr, 32 + 8 * fq));
        acc[t] = __builtin_amdgcn_mfma_f32_16x16x32_bf16(a0, b0, acc[t], 0, 0, 0);
        acc[t] = __builtin_amdgcn_mfma_f32_16x16x32_bf16(a1, b1, acc[t], 0, 0, 0); }
}
__device__ __forceinline__ unsigned long long pk4(const f32x4 v) { return (unsigned long long)pk2(v[0], v[1]) | ((unsigned long long)pk2(v[2], v[3]) << 32); }
__device__ __forceinline__ f32x4 up4(unsigned long long w) { f32x4 r; r[0] = bf2f((bf16_t)w); r[1] = bf2f((bf16_t)(w >> 16)); r[2] = bf2f((bf16_t)(w >> 32)); r[3] = bf2f((bf16_t)(w >> 48)); return r; }
__device__ __forceinline__ float sum8(float v) { DPP_ADD(v, 0xB1); DPP_ADD(v, 0x4E); DPP_ADD(v, 0x141); return v; }
constexpr int SA_AT = 0, SA_BT = 8192, SA_KT = 16384, SA_RT = 24576, SA_ATT = 32768, SA_VTT = 40960, SA_BPT = 49152, SA_KPT = 57344, SA_M1 = 65536, SA_TT = 81920, SA_M2T = 90112,
              SA_M3 = 98304, SA_LW = 106496, SA_TOT = 122880, SA_END = 124928;
constexpr int SA_X1 = SA_AT, SA_WT = SA_BT, SA_G = SA_KT, SA_KPPT = SA_M3;
struct ScanW { const float *mu, *w0, *a0, *k_k, *k_a, *r_k; };
struct ScanBufs { const bf16_t* PR; const bf16_t* LG; bf16_t* RPP; float* YG; bf16_t* PT; float* QT; bf16_t* EG; bf16_t* EBV; };
constexpr int NCHUNK = SEQ / 64;

__device__ __forceinline__ void scanA_unit(LAS unsigned char* L, const ScanW& W, const ScanBufs& B, int h, int c, int tid, int wave, int lane) {
    const int tau = tid >> 3, n0 = (tid & 7) * 8, t = c * 64 + tau, ch = h * 64 + n0;
    float r_[8], km[8], v_[8], a_[8], b_[8], lw[8];
    {
        const bf16_t* cur = B.PR + (size_t)t * RWKV_COLS + ch; const bool hasp = t > 0;
        const u32x4 cr = *(const GAS u32x4*)(cur), ck = *(const GAS u32x4*)(cur + 1024), cv = *(const GAS u32x4*)(cur + 2048);
        u32x4 pr = {0u, 0u, 0u, 0u}, pk = pr, pv = pr;
        if (hasp) { pr = *(const GAS u32x4*)(cur - RWKV_COLS); pk = *(const GAS u32x4*)(cur - RWKV_COLS + 1024); pv = *(const GAS u32x4*)(cur - RWKV_COLS + 2048); }
        const bf16_t* lgp = B.LG + (size_t)t * 3072 + ch;
        const u32x4 gw = *(const GAS u32x4*)(lgp), ga = *(const GAS u32x4*)(lgp + 1024), gg = *(const GAS u32x4*)(lgp + 2048);
        float k0[8], eta[8], g_[8], ss = 0.f;
#pragma unroll
        for (int e = 0; e < 8; ++e) { const int sh = (e & 1) * 16, q = e >> 1;
            const float xr = __uint_as_float((cr[q] >> sh) << 16), xk = __uint_as_float((ck[q] >> sh) << 16), xv = __uint_as_float((cv[q] >> sh) << 16);
            const float yr = __uint_as_float((pr[q] >> sh) << 16), yk = __uint_as_float((pk[q] >> sh) << 16), yv = __uint_as_float((pv[q] >> sh) << 16);
            r_[e] = xr + (yr - xr) * W.mu[ch + e]; k0[e] = xk + (yk - xk) * W.mu[1024 + ch + e]; v_[e] = xv + (yv - xv) * W.mu[2048 + ch + e];
            const float l_w = W.w0[ch + e] + __uint_as_float((gw[q] >> sh) << 16), l_a = W.a0[ch + e] + __uint_as_float((ga[q] >> sh) << 16); g_[e] = __uint_as_float((gg[q] >> sh) << 16);
            const float x = -l_w, sp = fmaxf(x, 0.f) + log1pf(__expf(-fabsf(x)));
            lw[e] = -__expf(-sp - 0.5f);
            eta[e] = sigmoidf_(l_a); const float kk = k0[e] * W.k_k[ch + e]; a_[e] = kk; ss += kk * kk; }
        ss = sum8(ss); const float inv = 1.f / fmaxf(sqrtf(ss), 1e-12f); float bon = 0.f;
#pragma unroll
        for (int e = 0; e < 8; ++e) { const float kn = a_[e] * inv; km[e] = k0[e] * (1.f + (eta[e] - 1.f) * W.k_a[ch + e]); a_[e] = -kn; b_[e] = kn * eta[e]; bon += r_[e] * km[e] * W.r_k[ch + e]; }
        bon = sum8(bon);
        { u32x4 og, ob;
#pragma unroll
          for (int q = 0; q < 4; ++q) { og[q] = pk2(g_[2 * q], g_[2 * q + 1]); ob[q] = pk2(bon * v_[2 * q], bon * v_[2 * q + 1]); }
          *(GAS u32x4*)(B.EG + (size_t)t * RW + ch) = og; *(GAS u32x4*)(B.EBV + (size_t)t * RW + ch) = ob; }
        LAS float* LW = (LAS float*)(L + SA_LW) + tau * 64 + n0;
        *(LAS f32x4*)(LW) = (f32x4){lw[0], lw[1], lw[2], lw[3]}; *(LAS f32x4*)(LW + 4) = (f32x4){lw[4], lw[5], lw[6], lw[7]};
    }
    __syncthreads();
    {
        const int n = tid & 63, part = tid >> 6; LAS float* LW = (LAS float*)(L + SA_LW); LAS float* TOT = (LAS float*)(L + SA_TOT);
        float p[8]; float run = 0.f;
#pragma unroll
        for (int j = 0; j < 8; ++j) { run += LW[(8 * part + j) * 64 + n]; p[j] = run; }
        TOT[part * 64 + n] = run;
        __syncthreads();
        float off = 0.f;
#pragma unroll
        for (int q = 0; q < 8; ++q) off += (q < part) ? TOT[q * 64 + n] : 0.f;
#pragma unroll
        for (int j = 0; j < 8; ++j) LW[(8 * part + j) * 64 + n] = off + p[j];
    }
    __syncthreads();
    {
        const LAS float* LWr = (const LAS float*)(L + SA_LW) + tau * 64 + n0; const LAS float* LWe = (const LAS float*)(L + SA_LW) + 63 * 64 + n0;
        float at[8], bt[8], kt[8], rt[8], bp[8], kp[8];
#pragma unroll
        for (int e = 0; e < 8; ++e) { const float La = LWr[e], Le = LWe[e], eL = __expf(La), eLp = __expf(La - lw[e]), eI = __expf(-La), eE = __expf(Le - La);
            at[e] = a_[e] * eLp; bt[e] = b_[e] * eI; kt[e] = km[e] * eI; rt[e] = r_[e] * eL; bp[e] = b_[e] * eE; kp[e] = km[e] * eE; }
        const int o = swz(tau, n0);
        { u32x4 w;
#pragma unroll
          for (int q = 0; q < 4; ++q) w[q] = pk2(at[2 * q], at[2 * q + 1]);
          *(LAS u32x4*)(L + SA_AT + o) = w;
#pragma unroll
          for (int q = 0; q < 4; ++q) w[q] = pk2(bt[2 * q], bt[2 * q + 1]);
          *(LAS u32x4*)(L + SA_BT + o) = w;
#pragma unroll
          for (int q = 0; q < 4; ++q) w[q] = pk2(kt[2 * q], kt[2 * q + 1]);
          *(LAS u32x4*)(L + SA_KT + o) = w;
#pragma unroll
          for (int q = 0; q < 4; ++q) w[q] = pk2(rt[2 * q], rt[2 * q + 1]);
          *(LAS u32x4*)(L + SA_RT + o) = w; }
#pragma unroll
        for (int e = 0; e < 8; ++e) { const int ot = swz(n0 + e, tau);
            *(LAS bf16_t*)(L + SA_ATT + ot) = f2bf(at[e]); *(LAS bf16_t*)(L + SA_VTT + ot) = f2bf(v_[e]); *(LAS bf16_t*)(L + SA_BPT + ot) = f2bf(bp[e]); *(LAS bf16_t*)(L + SA_KPT + ot) = f2bf(kp[e]); }
    }
    __syncthreads();
    const int ta = wave >> 1, tb0 = 2 * (wave & 1), fr = lane & 15, fq = lane >> 4, i0 = 16 * ta + 4 * fq;
    f32x4 g4[2] = {{0.f, 0.f, 0.f, 0.f}, {0.f, 0.f, 0.f, 0.f}};
    {
        f32x4 d1[2] = {{0.f, 0.f, 0.f, 0.f}, {0.f, 0.f, 0.f, 0.f}}, d1t[2] = {{0.f, 0.f, 0.f, 0.f}, {0.f, 0.f, 0.f, 0.f}}, d2[2] = {{0.f, 0.f, 0.f, 0.f}, {0.f, 0.f, 0.f, 0.f}}, d3[2] = {{0.f, 0.f, 0.f, 0.f}, {0.f, 0.f, 0.f, 0.f}};
        mm64(L + SA_BT, L + SA_AT, ta, tb0, lane, d1); mm64(L + SA_AT, L + SA_BT, ta, tb0, lane, d1t); mm64(L + SA_AT, L + SA_KT, ta, tb0, lane, d2); mm64(L + SA_BT, L + SA_RT, ta, tb0, lane, d3); mm64(L + SA_KT, L + SA_RT, ta, tb0, lane, g4);
#pragma unroll
        for (int t2 = 0; t2 < 2; ++t2) { const int j = 16 * (tb0 + t2) + fr; f32x4 r0;
#pragma unroll
            for (int q = 0; q < 4; ++q) { const int i = i0 + q; if (!(i < j)) d1[t2][q] = 0.f; if (!(j < i)) { d1t[t2][q] = 0.f; d2[t2][q] = 0.f; } if (!(i <= j)) { d3[t2][q] = 0.f; g4[t2][q] = 0.f; } r0[q] = d1t[t2][q] + (i == j ? 1.f : 0.f); }
            *(LAS unsigned long long*)(L + SA_M1 + swz(j, i0)) = pk4(d1[t2]);
            *(LAS unsigned long long*)(L + SA_M1 + 8192 + swz(j, i0)) = pk4(d1t[t2]);
            *(LAS unsigned long long*)(L + SA_TT + swz(j, i0)) = pk4(r0);
            *(LAS unsigned long long*)(L + SA_M2T + swz(j, i0)) = pk4(d2[t2]);
            *(LAS unsigned long long*)(L + SA_M3 + swz(j, i0)) = pk4(d3[t2]); }
    }
    __syncthreads();
    {
#define INV_SQUARE(Lp, Up, Ln, Un, needU) do { f32x4 e1[2] = {{0.f, 0.f, 0.f, 0.f}, {0.f, 0.f, 0.f, 0.f}}, e2[2] = {{0.f, 0.f, 0.f, 0.f}, {0.f, 0.f, 0.f, 0.f}}; \
        mm64(L + (Up), L + (Lp), ta, tb0, lane, e1); if (needU) mm64(L + (Lp), L + (Up), ta, tb0, lane, e2); \
        _Pragma("unroll") for (int t2 = 0; t2 < 2; ++t2) { const int j = 16 * (tb0 + t2) + fr; *(LAS unsigned long long*)(L + (Ln) + swz(j, i0)) = pk4(e1[t2]); if (needU) *(LAS unsigned long long*)(L + (Un) + swz(j, i0)) = pk4(e2[t2]); } } while (0)
#define INV_ACC(Lk, Rp, Rn) do { f32x4 e3[2] = {{0.f, 0.f, 0.f, 0.f}, {0.f, 0.f, 0.f, 0.f}}; mm64(L + (Lk), L + (Rp), ta, tb0, lane, e3); \
        _Pragma("unroll") for (int t2 = 0; t2 < 2; ++t2) { const int j = 16 * (tb0 + t2) + fr; *(LAS unsigned long long*)(L + (Rn) + swz(j, i0)) = pk4(e3[t2] + up4(*(const LAS unsigned long long*)(L + (Rp) + swz(j, i0)))); } } while (0)
        INV_SQUARE(SA_M1, SA_M1 + 8192, SA_AT, SA_BT, true);                                        __syncthreads();
        INV_ACC(SA_AT, SA_TT, SA_KT); INV_SQUARE(SA_AT, SA_BT, SA_M1, SA_M1 + 8192, true);          __syncthreads();
        INV_ACC(SA_M1, SA_KT, SA_TT); INV_SQUARE(SA_M1, SA_M1 + 8192, SA_AT, SA_BT, true);          __syncthreads();
        INV_ACC(SA_AT, SA_TT, SA_KT); INV_SQUARE(SA_AT, SA_BT, SA_M1, SA_M1 + 8192, true);          __syncthreads();
        INV_ACC(SA_M1, SA_KT, SA_TT); INV_SQUARE(SA_M1, SA_M1 + 8192, SA_AT, SA_BT, false);         __syncthreads();
        INV_ACC(SA_AT, SA_TT, SA_KT);
#undef INV_SQUARE
#undef INV_ACC
    }
    __syncthreads();
    {
        f32x4 dx[2] = {{0.f, 0.f, 0.f, 0.f}, {0.f, 0.f, 0.f, 0.f}}, dw[2] = {{0.f, 0.f, 0.f, 0.f}, {0.f, 0.f, 0.f, 0.f}};
        mm64(L + SA_KT, L + SA_M3, ta, tb0, lane, dx); mm64(L + SA_KT, L + SA_BPT, ta, tb0, lane, dw);
#pragma unroll
        for (int t2 = 0; t2 < 2; ++t2) { const int j = 16 * (tb0 + t2) + fr;
            *(LAS unsigned long long*)(L + SA_X1 + swz(j, i0)) = pk4(dx[t2]);
            *(LAS unsigned long long*)(L + SA_WT + swz(j, i0)) = pk4(dw[t2]); }
    }
    __syncthreads();
    const size_t ub = ((size_t)h * NCHUNK + c) * 4096;
    {
        f32x4 dr[2] = {{0.f, 0.f, 0.f, 0.f}, {0.f, 0.f, 0.f, 0.f}}, dp[2] = {{0.f, 0.f, 0.f, 0.f}, {0.f, 0.f, 0.f, 0.f}}, dk[2] = {{0.f, 0.f, 0.f, 0.f}, {0.f, 0.f, 0.f, 0.f}};
        mm64(L + SA_ATT, L + SA_X1, ta, tb0, lane, dr); mm64(L + SA_M2T, L + SA_X1, ta, tb0, lane, g4); mm64(L + SA_ATT, L + SA_WT, ta, tb0, lane, dp); mm64(L + SA_M2T, L + SA_WT, ta, tb0, lane, dk);
        const LAS float* LWe = (const LAS float*)(L + SA_LW) + 63 * 64;
        f32x4 rk[2], kk2[2];
#pragma unroll
        for (int t2 = 0; t2 < 2; ++t2) { const int j = 16 * (tb0 + t2) + fr; rk[t2] = up4(*(const LAS unsigned long long*)(L + SA_RT + swz(j, i0))); kk2[t2] = up4(*(const LAS unsigned long long*)(L + SA_KPT + swz(j, i0))); }
        __syncthreads();
#pragma unroll
        for (int t2 = 0; t2 < 2; ++t2) { const int j = 16 * (tb0 + t2) + fr;
            dr[t2] = dr[t2] + rk[t2]; dk[t2] = dk[t2] + kk2[t2];
#pragma unroll
            for (int q = 0; q < 4; ++q) if (i0 + q == j) dp[t2][q] += __expf(LWe[j]);
            *(GAS unsigned long long*)(B.RPP + ub + j * 64 + i0) = pk4(dr[t2]);
            *(GAS unsigned long long*)(B.PT + ub + (((i0 >> 4) * 64 + j) * 2 + ((i0 >> 2) & 1)) * 8 + ((i0 >> 3) & 1) * 4) = pk4(dp[t2]);
            *(LAS unsigned long long*)(L + SA_G + swz(j, i0)) = pk4(g4[t2]);
            *(LAS unsigned long long*)(L + SA_KPPT + swz(j, i0)) = pk4(dk[t2]); }
    }
    __syncthreads();
    {
        f32x4 dy[2] = {{0.f, 0.f, 0.f, 0.f}, {0.f, 0.f, 0.f, 0.f}}, dq[2] = {{0.f, 0.f, 0.f, 0.f}, {0.f, 0.f, 0.f, 0.f}};
        mm64(L + SA_VTT, L + SA_G, ta, tb0, lane, dy); mm64(L + SA_KPPT, L + SA_VTT, ta, tb0, lane, dq);
#pragma unroll
        for (int t2 = 0; t2 < 2; ++t2) { const int j = 16 * (tb0 + t2) + fr;
            *(GAS f32x4*)(B.YG + ub + j * 64 + i0) = dy[t2];
            *(GAS f32x4*)(B.QT + ub + (((i0 >> 3) * 64 + j) * 2 + ((i0 >> 2) & 1)) * 4) = dq[t2]; }
    }
    __syncthreads();
}
__device__ __forceinline__ unsigned long long ld8(const bf16_t* p) { return *(const GAS unsigned long long*)p; }
__device__ __forceinline__ void scanB_wave(const bf16_t* PT, const float* QT, bf16_t* SC, int h, int ib, int lane) {
    const int c31 = lane & 31, hh = lane >> 5;
    f32x16_t xa[2];
#pragma unroll
    for (int r = 0; r < 16; ++r) { xa[0][r] = 0.f; xa[1][r] = 0.f; }
    u32x4 pa[2][2][2]; f32x4 qa[2][4];
    auto loadPQ = [&](int c, u32x4 (&p)[2][2][2], f32x4 (&q)[2][4]) {
        const size_t ub = ((size_t)h * NCHUNK + c) * 4096;
#pragma unroll
        for (int a = 0; a < 2; ++a) {
#pragma unroll
            for (int nb = 0; nb < 2; ++nb)
#pragma unroll
                for (int s = 0; s < 2; ++s) p[a][nb][s] = *(const GAS u32x4*)(PT + ub + (((2 * nb + s) * 64 + 32 * a + c31) * 2 + hh) * 8);
#pragma unroll
            for (int g = 0; g < 4; ++g) q[a][g] = *(const GAS f32x4*)(QT + ub + (((4 * a + g) * 64 + 32 * ib + c31) * 2 + hh) * 4); }
    };
    auto step = [&](int c, const u32x4 (&p)[2][2][2], const f32x4 (&q)[2][4]) {
        const size_t ub = ((size_t)h * NCHUNK + c) * 4096;
        bf16x8_t bfrag[2][2];
#pragma unroll
        for (int nb = 0; nb < 2; ++nb) {
#pragma unroll
            for (int s = 0; s < 2; ++s) { u32x4 w;
#pragma unroll
                for (int z = 0; z < 4; ++z) w[z] = pg8::cvt_pk_bf16(xa[nb][8 * s + 2 * z], xa[nb][8 * s + 2 * z + 1]);
                bfrag[nb][s] = __builtin_bit_cast(bf16x8_t, w);
                *(GAS unsigned long long*)(SC + ub + ((4 * nb + 2 * s + 0) * 64 + 32 * ib + c31) * 8 + 4 * hh) = (unsigned long long)w[0] | ((unsigned long long)w[1] << 32);
                *(GAS unsigned long long*)(SC + ub + ((4 * nb + 2 * s + 1) * 64 + 32 * ib + c31) * 8 + 4 * hh) = (unsigned long long)w[2] | ((unsigned long long)w[3] << 32); } }
#pragma unroll
        for (int a = 0; a < 2; ++a) { f32x16_t ya;
#pragma unroll
            for (int r = 0; r < 16; ++r) ya[r] = q[a][r >> 2][r & 3];
#pragma unroll
            for (int nb = 0; nb < 2; ++nb)
#pragma unroll
                for (int s = 0; s < 2; ++s) ya = __builtin_amdgcn_mfma_f32_32x32x16_bf16(__builtin_bit_cast(bf16x8_t, p[a][nb][s]), bfrag[nb][s], ya, 0, 0, 0);
            xa[a] = ya; }
    };
    u32x4 pb[2][2][2]; f32x4 qb[2][4];
    loadPQ(0, pa, qa);
    for (int c = 0; c < NCHUNK; c += 2) {
        loadPQ(c + 1, pb, qb);
        step(c, pa, qa);
        loadPQ(c + 2 < NCHUNK ? c + 2 : c + 1, pa, qa);
        step(c + 1, pb, qb);
    }
}
__device__ __forceinline__ void scanC_unit(LAS unsigned char* L, const bf16_t* SC, const bf16_t* RPP, const float* YG, const bf16_t* EG, const bf16_t* EBV, const float* lnx_w, const float* lnx_b, bf16_t* MIXED,
                                           int h, int c, int tid, int wave, int lane) {
    const size_t ub = ((size_t)h * NCHUNK + c) * 4096;
    { const int row = tid >> 3, k0 = (tid & 7) * 8, srow = tid & 63, sc8 = tid >> 6;
      *(LAS u32x4*)(L + swz(srow, 8 * sc8)) = *(const GAS u32x4*)(SC + ub + (sc8 * 64 + srow) * 8);
      *(LAS u32x4*)(L + 8192 + swz(row, k0)) = *(const GAS u32x4*)(RPP + ub + row * 64 + k0); }
    __syncthreads();
    { const int ta = wave >> 1, tb0 = 2 * (wave & 1), fr = lane & 15, fq = lane >> 4, i0 = 16 * ta + 4 * fq;
      f32x4 d[2] = {{0.f, 0.f, 0.f, 0.f}, {0.f, 0.f, 0.f, 0.f}};
      mm64(L, L + 8192, ta, tb0, lane, d);
#pragma unroll
      for (int t2 = 0; t2 < 2; ++t2) { const int j = 16 * (tb0 + t2) + fr; *(LAS f32x4*)(L + 16384 + (j * 64 + i0) * 4) = d[t2] + *(const GAS f32x4*)(YG + ub + j * 64 + i0); } }
    __syncthreads();
    { const int tau = tid >> 3, i8 = (tid & 7) * 8, t = c * 64 + tau, ch = h * 64 + i8;
      f32x4 y0 = *(const LAS f32x4*)(L + 16384 + (tau * 64 + i8) * 4), y1 = *(const LAS f32x4*)(L + 16384 + (tau * 64 + i8 + 4) * 4);
      const float mean = sum8(((y0[0] + y0[1]) + (y0[2] + y0[3])) + ((y1[0] + y1[1]) + (y1[2] + y1[3]))) * (1.f / 64.f);
      y0 = y0 - mean; y1 = y1 - mean;
      const float rstd = rsqrtf(sum8(((y0[0] * y0[0] + y0[1] * y0[1]) + (y0[2] * y0[2] + y0[3] * y0[3])) + ((y1[0] * y1[0] + y1[1] * y1[1]) + (y1[2] * y1[2] + y1[3] * y1[3]))) * (1.f / 64.f) + LNX_EPS);
      const u32x4 eg = *(const GAS u32x4*)(EG + (size_t)t * RW + ch), eb = *(const GAS u32x4*)(EBV + (size_t)t * RW + ch);
      const f32x4 w0 = *(const GAS f32x4*)(lnx_w + ch), w1 = *(const GAS f32x4*)(lnx_w + ch + 4), b0 = *(const GAS f32x4*)(lnx_b + ch), b1 = *(const GAS f32x4*)(lnx_b + ch + 4);
      float o[8];
#pragma unroll
      for (int e = 0; e < 8; ++e) { const int sh = (e & 1) * 16, q = e >> 1; const float g = __uint_as_float((eg[q] >> sh) << 16), bv = __uint_as_float((eb[q] >> sh) << 16);
          const float yv = e < 4 ? y0[e & 3] : y1[e & 3], lw = e < 4 ? w0[e & 3] : w1[e & 3], lb = e < 4 ? b0[e & 3] : b1[e & 3];
          o[e] = (yv * rstd * lw + lb + bv) * g; }
      u32x4 w;
#pragma unroll
      for (int q = 0; q < 4; ++q) w[q] = pk2(o[2 * q], o[2 * q + 1]);
      *(GAS u32x4*)(MIXED + (size_t)t * DM + ch) = w; }
    __syncthreads();
}
constexpr int MS_ROWS = 320, MS_AP = MS_ROWS / 64  , MS_A = 0, MS_B = 49152, MS_STAGE = 65536;
#define MS_BAR() do { asm volatile("s_waitcnt lgkmcnt(0)" ::: "memory"); __builtin_amdgcn_s_barrier(); asm volatile("" ::: "memory"); } while (0)
template <int MODE>
__device__ __forceinline__ void moe_stream_unit(LAS unsigned char* L, const bf16_t* A, int lda_, const float* W0, const float* W1, int ldw_, int ncol0, int K, int row0, int cnt, bf16_t* HID, float* YC, int tid, int wave, int lane) {
    constexpr int nK = MODE == 0 ? DM / 64 : D_EXP / 64, lda = MODE == 0 ? DM : D_EXP, ldw = MODE == 0 ? D_EXP : DM;
    static_assert(nK % 2 == 0 && nK >= 6, "K-loop rotation");
    (void)K; (void)lda_; (void)ldw_; (void)YC;
    typedef unsigned u32x2_t __attribute__((ext_vector_type(2)));
    const int fr = lane & 15, fq = lane >> 4, wn = wave >> 2, wm = (wave + 2 * wn) & 3;
    const int mh = __builtin_amdgcn_readfirstlane(wave & 1), kq = __builtin_amdgcn_readfirstlane(wave >> 1);
    const float* wbase = (MODE == 0 ? (mh ? W1 : W0) : W0 + mh * 64) + ncol0 + (size_t)(16 * kq) * ldw;
    const __amdgpu_buffer_rsrc_t wrsrc = __builtin_amdgcn_make_buffer_rsrc((void*)wbase, 0, 0x7fffffff, 0x00020000);
    const unsigned wlane = (unsigned)((fq * 4 * ldw + fr * 4) * 4), alane = (unsigned)(((tid >> 3) * lda + (tid & 7) * 8) * 2);
    const int awoff = (tid >> 3) * 128 + (((tid & 7) ^ ((tid >> 3) & 7)) << 4);
    const int bwrow = (mh * 64 + 4 * fr) * 128 + (fq & 1) * 8, bwc = (kq * 2 + (fq >> 1)) ^ (fr & 7) ^ ((fr & 1) << 2);
    const int offk0 = fr * 128 + (((0 + fq) ^ (fr & 7)) << 4) + wm * 2048, offk1 = fr * 128 + (((4 + fq) ^ (fr & 7)) << 4) + wm * 2048;
    const int bnb = MS_B + (MODE == 0 ? 2 * wn : 4 * wn) * 2048;
    const int bkx = fr * 128 + ((fq ^ (fr & 7) ^ (fr >> 2)) << 4) + bnb, bky = bkx ^ 64;
    for (int pass0 = 0; pass0 < cnt; pass0 += MS_ROWS) {
        const int rows = (cnt - pass0) < MS_ROWS ? (cnt - pass0) : MS_ROWS, ntiles = (rows + 15) >> 4;
      auto body = [&](auto nmt_, auto nap_) __attribute__((always_inline)) {
        constexpr int NMT = decltype(nmt_)::value, NAP = decltype(nap_)::value;
        const bf16_t* Ap = A + (size_t)(row0 + pass0) * lda;
        const __amdgpu_buffer_rsrc_t arsrc = __builtin_amdgcn_make_buffer_rsrc((void*)Ap, 0, rows * lda * 2, 0x00020000);
        u32x4 a0[NAP]; f32x4 b0[4];
        f32x4 acc[NMT][4];
#pragma unroll
        for (int i = 0; i < NMT; ++i)
#pragma unroll
            for (int t = 0; t < 4; ++t) acc[i][t] = (f32x4){0.f, 0.f, 0.f, 0.f};
#define MS_LOADA(kt, ar) do { _Pragma("unroll") for (int i = 0; i < NAP; ++i) ar[i] = __builtin_bit_cast(u32x4, __builtin_amdgcn_raw_buffer_load_b128(arsrc, alane, (unsigned)(((64 * i) * lda + (kt) * 64) * 2), 0)); } while (0)
#define MS_LOADW(kt, b) do { _Pragma("unroll") for (int j = 0; j < 4; ++j) b[j] = __builtin_bit_cast(f32x4, __builtin_amdgcn_raw_buffer_load_b128(wrsrc, wlane, (unsigned)((((kt) * 64 + j) * ldw) * 4), 2  )); } while (0)
#define MS_WRITE(st, ar, b) do { _Pragma("unroll") for (int i = 0; i < NAP; ++i) *(LAS u32x4*)(L + awoff + ((st) * MS_STAGE + MS_A + i * 8192)) = ar[i]; \
            _Pragma("unroll") for (int c = 0; c < 4; ++c) { const u32x2_t w_ = {pg8::cvt_pk_bf16(b[0][c], b[1][c]), pg8::cvt_pk_bf16(b[2][c], b[3][c])}; \
                *(LAS u32x2_t*)(L + bwrow + ((bwc ^ c) << 4) + ((st) * MS_STAGE + MS_B + c * 128)) = w_; } } while (0)
        LAS unsigned char* const ak00 = L + offk0 + MS_A, * const ak01 = L + offk1 + MS_A, * const ak10 = L + offk0 + MS_STAGE + MS_A, * const ak11 = L + offk1 + MS_STAGE + MS_A;
        LAS unsigned char* const bk0x = L + bkx, * const bk0y = L + bky, * const bk1x = L + bkx + MS_STAGE, * const bk1y = L + bky + MS_STAGE;
#define MS_DSR(dst, base, off) asm volatile("ds_read_b128 %0, %1 offset:%2" : "=v"(dst) : "v"(base), "n"(off) : "memory")
#define MS_BOFF(t) ((MODE == 0 ? (((t) < 2 ? 0 : 4) + ((t) & 1)) : (t)) * 2048)
#define MS_RD(F, st, ks) do { _Pragma("unroll") for (int i = 0; i < NMT; ++i) MS_DSR(F##a[i], ((st) ? ((ks) ? ak11 : ak10) : ((ks) ? ak01 : ak00)), i * 8192); \
            _Pragma("unroll") for (int t = 0; t < 4; ++t) MS_DSR(F##b[t], ((st) ? ((((ks) ^ t) & 1) ? bk1y : bk1x) : ((((ks) ^ t) & 1) ? bk0y : bk0x)), MS_BOFF(t)); } while (0)
#define MS_TIE8(F) "+v"(F##a[0]), "+v"(F##a[1]), "+v"(F##a[2]), "+v"(F##a[3]), "+v"(F##b[0]), "+v"(F##b[1]), "+v"(F##b[2]), "+v"(F##b[3])
#define MS_WAITL(n, F) do { if constexpr (NMT == 5) asm volatile("s_waitcnt lgkmcnt(" #n ")" : MS_TIE8(F), "+v"(F##a[NMT - 1]) :: "memory"); else asm volatile("s_waitcnt lgkmcnt(" #n ")" : MS_TIE8(F) :: "memory"); } while (0)
#define MS_WAITN(F) do { if constexpr (NMT == 5) asm volatile("s_waitcnt lgkmcnt(9)" : MS_TIE8(F), "+v"(F##a[NMT - 1]) :: "memory"); else asm volatile("s_waitcnt lgkmcnt(8)" : MS_TIE8(F) :: "memory"); } while (0)
#define MS_BART(F) do { if constexpr (NMT == 5) asm volatile("s_waitcnt lgkmcnt(0)\n\ts_barrier" : MS_TIE8(F), "+v"(F##a[NMT - 1]) :: "memory"); else asm volatile("s_waitcnt lgkmcnt(0)\n\ts_barrier" : MS_TIE8(F) :: "memory"); } while (0)
#define MS_MM(F) do { _Pragma("unroll") for (int i = 0; i < NMT; ++i) \
            _Pragma("unroll") for (int t = 0; t < 4; ++t) acc[i][t] = __builtin_amdgcn_mfma_f32_16x16x32_bf16(F##b[t], F##a[i], acc[i][t], 0, 0, 0); } while (0)
#define MS_SB() __builtin_amdgcn_sched_barrier(0)
#define MS_ITER(st, WR, LD) do { MS_RD(f1, st, 1); MS_WAITN(f0); MS_MM(f0); MS_SB(); WR; LD; MS_BART(f1); MS_RD(f0, 1 - (st), 0); MS_MM(f1); MS_SB(); } while (0)
        bf16x8_t f0a[NMT], f0b[4], f1a[NMT], f1b[4];
        MS_LOADA(0, a0); MS_LOADW(0, b0);
        MS_WRITE(0, a0, b0); MS_LOADA(1, a0); MS_LOADW(1, b0);
        MS_BAR();
        MS_RD(f0, 0, 0);
        int kt = 0;
        for (; kt + 4 <= nK; kt += 2) {
            MS_ITER(0, MS_WRITE(1, a0, b0), { MS_LOADA(kt + 2, a0); MS_LOADW(kt + 2, b0); });
            MS_ITER(1, MS_WRITE(0, a0, b0), { MS_LOADA(kt + 3, a0); MS_LOADW(kt + 3, b0); });
        }
        MS_ITER(0, MS_WRITE(1, a0, b0), (void)0);
        MS_RD(f1, 1, 1); MS_WAITN(f0); MS_MM(f0); MS_WAITL(0, f1); MS_MM(f1);
#undef MS_ITER
#undef MS_SB
#undef MS_BART
#undef MS_WAITL
#undef MS_WAITN
#undef MS_TIE8
#undef MS_DSR
#undef MS_MM
#undef MS_RD
#undef MS_BOFF
#undef MS_LOADA
#undef MS_LOADW
#undef MS_WRITE
        const __amdgpu_buffer_rsrc_t orsrc = __builtin_amdgcn_make_buffer_rsrc((void*)HID, 0, 0x7fffffff, 0x00020000);
        const unsigned olane = MODE == 0 ? (unsigned)((fr * D_EXP + 4 * fq) * 2) : (unsigned)((fr * DM + 4 * fq) * 2);
#pragma unroll
        for (int i = 0; i < NMT; ++i) { const int mt = wm + 4 * i; if (mt < ntiles) { const unsigned rowb = (unsigned)(row0 + pass0 + 16 * mt);
            if (MODE == 0) {
#pragma unroll
                for (int t = 0; t < 2; ++t) { f32x4 hv;
#pragma unroll
                    for (int r = 0; r < 4; ++r) { const float gt = acc[i][t][r]; hv[r] = gt * __builtin_amdgcn_rcpf(1.0f + __builtin_amdgcn_exp2f(-1.4426950408889634f * gt)) * acc[i][t + 2][r]; }
                    const u32x2_t w2 = {pg8::cvt_pk_bf16(hv[0], hv[1]), pg8::cvt_pk_bf16(hv[2], hv[3])};
                    __builtin_amdgcn_raw_buffer_store_b64(w2, orsrc, olane, (rowb * D_EXP + ncol0 + 16 * (2 * wn + t)) * 2u, 0); }
            } else {
#pragma unroll
                for (int t = 0; t < 4; ++t) { const u32x2_t w2 = {pg8::cvt_pk_bf16(acc[i][t][0], acc[i][t][1]), pg8::cvt_pk_bf16(acc[i][t][2], acc[i][t][3])};
                    __builtin_amdgcn_raw_buffer_store_b64(w2, orsrc, olane, (rowb * DM + ncol0 + 16 * (4 * wn + t)) * 2u, 0); }
            } } }
      };
        if (rows <= 256) body(std::integral_constant<int, 4>{}, std::integral_constant<int, 4>{});
        else body(std::integral_constant<int, 5>{}, std::integral_constant<int, 5>{});
    }
}
constexpr int NWAVES = 8;
constexpr int RING_OFF = 0, RING_BYTES = 131072;
constexpr int LDSCTL_OFF = RING_BYTES, MISC_OFF = LDSCTL_OFF + 320;
constexpr int LDS_BYTES = 147456;
enum Phase { PH_PRO = 0, PH_INPROJ = 1, PH_MEMPRE = 2, PH_LORA = 3, PH_SCANA = 4, PH_SCANB = 5, PH_SCANC = 6, PH_ATTN = 7, PH_POST = 8, PH_OUTPROJ = 9, PH_HN1 = 10, PH_SCORES = 11, PH_MEMOUT = 12,
             PH_ROUTER = 13, PH_GATHER = 14, PH_GATEUP = 15, PH_DOWN = 16, PH_FINAL = 17, PH_N = 18, PH_X1 = 18, PH_X2 = 19, PH_X3 = 20 };

__device__ __forceinline__ float wave_sum(float v) {
#pragma unroll
    for (int o = 1; o < 64; o <<= 1) v += __shfl_xor(v, o);
    return v;
}
__device__ __forceinline__ void tr_item(const float* W, int pitch, int ncols, int K, bf16_t* WT, int ldt, int mode, LAS float* scr, int item, int lane) {
    const int nblk = ncols / 32, kb = item / nblk, nb = item % nblk, k0 = 64 * kb, n0 = 32 * nb;
#pragma unroll 8
    for (int i = 0; i < 32; ++i) { const int kk = 2 * i + (lane >> 5); scr[kk * 33 + (lane & 31)] = W[(size_t)(k0 + kk) * pitch + n0 + (lane & 31)]; }
    LDS_WAIT(); asm volatile("" ::: "memory");
    const int c = lane & 7;
#pragma unroll
    for (int j = 0; j < 4; ++j) { const int n = (lane >> 3) + 8 * j; const LAS float* s = scr + (8 * c) * 33 + n;
        v4u o; o.x = pk2(s[0 * 33], s[1 * 33]); o.y = pk2(s[2 * 33], s[3 * 33]); o.z = pk2(s[4 * 33], s[5 * 33]); o.w = pk2(s[6 * 33], s[7 * 33]);
        *(GAS v4u*)(WT + (size_t)row_map(mode, n0 + n) * ldt + k0 + 8 * c) = o; }
    LDS_WAIT(); asm volatile("" ::: "memory");
}
__device__ __forceinline__ void tr_job(const float* W, int pitch, int ncols, int K, bf16_t* WT, int mode, int nmat, size_t wstride, size_t tstride, LAS float* scr, int gw, int NGW, int lane, int ldt = 0) {
    if (ldt == 0) ldt = K;
    const int per = (K / 64) * (ncols / 32), total = per * nmat;
    for (int it = gw; it < total; it += NGW) { const int mat = it / per, r = it - mat * per; tr_item(W + (size_t)mat * wstride, pitch, ncols, K, WT + (size_t)mat * tstride, ldt, mode, scr, r, lane); }
}
__device__ __forceinline__ void rms_row_bf16(const float* xrow, const float* g, bf16_t* orow, int lane) {
    const GAS f32x4* xr = (const GAS f32x4*)xrow + lane; const GAS f32x4* gr = (const GAS f32x4*)g + lane;
    f32x4 v[8]; float s = 0.f;
#pragma unroll
    for (int j = 0; j < 8; ++j) { v[j] = xr[64 * j]; s += (v[j].x * v[j].x + v[j].y * v[j].y) + (v[j].z * v[j].z + v[j].w * v[j].w); }
    const float rs = rsqrtf(wave_sum(s) * (1.f / DM) + NORM_EPS);
    GAS unsigned long long* o8 = (GAS unsigned long long*)orow + lane;
#pragma unroll
    for (int j = 0; j < 8; ++j) { const f32x4 gg = gr[64 * j]; o8[64 * j] = (unsigned long long)pk2(v[j].x * rs * gg.x, v[j].y * rs * gg.y) | ((unsigned long long)pk2(v[j].z * rs * gg.z, v[j].w * rs * gg.w) << 32); }
}

__device__ __forceinline__ const float* inf_fresh(const float* p) { asm volatile("" : "+s"(p)); return p; }
struct Args { const float* in[34]; float* out; unsigned char* ws; int ph_lo, ph_hi, li, pad; };
__global__ void __launch_bounds__(NWAVES * 64, 2) mk_fwd(Args args) {
    extern __shared__ __attribute__((aligned(16))) unsigned char lds[];
    LAS unsigned char* const L = (LAS unsigned char*)lds;
    volatile LAS unsigned* const MISC = (volatile LAS unsigned*)(L + MISC_OFF);
    const int tid = threadIdx.x, lane = tid & 63, wave = __builtin_amdgcn_readfirstlane(tid >> 6);
    const int G = gridDim.x; const int bx = blockIdx.x; const int vcu = __builtin_amdgcn_readfirstlane((G % 8 == 0) ? (bx % 8) * (G / 8) + bx / 8 : bx);
    unsigned char* ws = args.ws;
    gu32* ctl = (gu32*)(ws + WS_CTL);
    for (int u = tid; u < (LDS_BYTES - LDSCTL_OFF) / 4; u += NWAVES * 64) ((LAS unsigned*)(L + LDSCTL_OFF))[u] = 0u;
    __syncthreads();
    XcdBarrier bar = xcd_barrier_post((unsigned*)(ctl + CW_BAR) + args.li * XCD_BAR_WORDS, MISC + 8);
    const int lo = args.ph_lo, hi = args.ph_hi;
#define IN(k) (lo <= (k) && (k) < hi)
#define FRESH_IDS int tid_f_ = (int)threadIdx.x; asm volatile("" : "+v"(tid_f_)); const int tid = tid_f_, lane = tid_f_ & 63; (void)tid; (void)lane
#define SEAM(k) do { if ((k) + 1 < hi) xcd_barrier(bar); } while (0)
    const int gw = vcu * NWAVES + wave, NGW = G * NWAVES;
#define WSP(T, off) ((T*)(ws + (off)))
#define INF(i) (args.in[i])
    if (IN(PH_PRO)) {
        FRESH_IDS;
        LAS float* scr = (LAS float*)(L + RING_OFF + wave * 16384);
        tr_job(INF(4), IN_COLS, RWKV_COLS, DM, WSP(bf16_t, WS_WINT), 0, 1, 0, 0, scr, gw, NGW, lane);
        tr_job(INF(4) + RWKV_COLS, IN_COLS, 2 * QK_COLS, DM, WSP(bf16_t, WS_WINT) + (size_t)RWKV_COLS * DM, 1, 1, 0, 0, scr, gw, NGW, lane);
        tr_job(INF(4) + RWKV_COLS + 2 * QK_COLS, IN_COLS, 1024, DM, WSP(bf16_t, WS_WINT) + (size_t)(RWKV_COLS + 2 * QK_COLS) * DM, 0, 1, 0, 0, scr, gw, NGW, lane);
        tr_job(INF(22), DM, DM, DM, WSP(bf16_t, WS_WKVT), 0, 1, 0, 0, scr, gw, NGW, lane);
        tr_job(INF(23), DM, DM, DM, WSP(bf16_t, WS_WKVT) + (size_t)DM * DM, 0, 1, 0, 0, scr, gw, NGW, lane);
        for (int i = gw * 64 + lane; i < SEQ * 32; i += NGW * 64) { const int t = i >> 5, j = i & 31;
            const double inv = pow(10000.0, -(double)j / 32.0), ang = (double)((const int*)INF(2))[t] * inv;
            WSP(float, WS_ROPE)[2 * i] = (float)cos(ang); WSP(float, WS_ROPE)[2 * i + 1] = (float)sin(ang); }
        for (int m = gw; m < SEQ; m += NGW) rms_row_bf16(INF(0) + (size_t)m * DM, INF(3), WSP(bf16_t, WS_XN) + (size_t)m * DM, lane);
        for (int m = gw; m < MEM_LEN; m += NGW) rms_row_bf16(INF(1) + (size_t)m * DM, INF(20), WSP(bf16_t, WS_MEMN) + (size_t)m * DM, lane);
        SEAM(PH_PRO);
    }
    if (IN(PH_INPROJ)) {
        FRESH_IDS;
        { pg8::Gemm g{WSP(bf16_t, WS_XN), WSP(bf16_t, WS_WINT), SEQ, IN_COLS, DM, DM, DM}; pg8::StaticOrder S; S.init(SEQ, IN_COLS, G, bx);
          pg8::EpiInProj E{WSP(bf16_t, WS_PR), WSP(bf16_t, WS_QB), WSP(bf16_t, WS_KB), WSP(bf16_t, WS_VB), WSP(float, WS_ROPE)};
          pg8::gemm_phase<pg8::EpiInProj, pg8::StaticOrder, true, true>(L + RING_OFF, g, S, E); }
        { pg8::Gemm g{WSP(bf16_t, WS_MEMN), WSP(bf16_t, WS_WKVT), MEM_LEN, 2 * DM, DM, DM, DM}; pg8::StaticOrder S; S.init(MEM_LEN, 2 * DM, G, (bx + G - 32) % G);
          pg8::EpiKV E{WSP(bf16_t, WS_KVH)};
          pg8::gemm_phase<pg8::EpiKV, pg8::StaticOrder, true, true>(L + RING_OFF, g, S, E); }
        if (bx >= 48 || G <= 48) { const int gw2 = (G > 48 ? bx - 48 : bx) * NWAVES + wave, NGW2 = (G > 48 ? G - 48 : G) * NWAVES;
            __syncthreads();
            LAS float* scr = (LAS float*)(L + RING_OFF + wave * 16384);
            tr_job(INF(18), DM, DM, DM, WSP(bf16_t, WS_WOUTT), 0, 1, 0, 0, scr, gw2, NGW2, lane);
            tr_job(INF(24), DM, DM, MEM_HD, WSP(bf16_t, WS_WOTH), 0, MEM_HEADS, (size_t)MEM_HD * DM, (size_t)DM * MEM_HD, scr, gw2, NGW2, lane);
            for (int i = gw2 * 64 + lane; i < 80 * DM; i += NGW2 * 64) { const int col = i >> 11, k = i & 2047;
                const float w = col < 8 ? INF(26)[(size_t)k * 8 + col] : (col < 72 ? INF(28)[(size_t)k * 64 + col - 8] : 0.f);
                WSP(float, WS_RT)[i] = w * INF(25)[k]; }
            tr_job(INF(7), RW, RW, 64, WSP(bf16_t, WS_WLORA), 0, 1, 0, 0, scr, gw2, NGW2, lane, 256);
            tr_job(INF(9), RW, RW, 64, WSP(bf16_t, WS_WLORA) + (size_t)1024 * 256 + 64, 0, 1, 0, 0, scr, gw2, NGW2, lane, 256);
            tr_job(INF(10), RW, RW, 128, WSP(bf16_t, WS_WLORA) + (size_t)2048 * 256 + 128, 0, 1, 0, 0, scr, gw2, NGW2, lane, 256);
            for (int i = gw2 * 64 + lane; i < 3072 * 32; i += NGW2 * 64) { const int n = i >> 5, col = (i & 31) * 8, sec = n >> 10;
                const bool inblk = (sec == 0 && col < 64) || (sec == 1 && col >= 64 && col < 128) || (sec == 2 && col >= 128);
                if (!inblk) *(GAS v4u*)(WSP(bf16_t, WS_WLORA) + (size_t)n * 256 + col) = (v4u){0u, 0u, 0u, 0u}; }
            for (int i = gw2 * 64 + lane; i < DM * DM / 8; i += NGW2 * 64) { const int k = i >> 8, gc = (i & 255) * 8, h = gc >> 9, d = gc & 511;
                const f32x4 a = *(const GAS f32x4*)(INF(21) + (size_t)k * DM + gc), b = *(const GAS f32x4*)(INF(21) + (size_t)k * DM + gc + 4);
                v4u o; o.x = pk2(a.x, a.y); o.y = pk2(a.z, a.w); o.z = pk2(b.x, b.y); o.w = pk2(b.z, b.w);
                *(GAS v4u*)(WSP(bf16_t, WS_WQBH) + ((size_t)h * DM + k) * MEM_HD + d) = o; }
        }
        SEAM(PH_INPROJ);
    }
    if (IN(PH_MEMPRE)) {
        FRESH_IDS;
        {
            const float* mu = INF(5);
            for (int i = (bx * NWAVES * 64 + tid); i < SEQ * 32; i += G * NWAVES * 64) { const int t = i >> 5, j0 = (i & 31) * 8;
                const bf16_t* cur = WSP(bf16_t, WS_PR) + (size_t)t * RWKV_COLS + 3072 + j0;
                const u32x4 cv = *(const GAS u32x4*)cur; u32x4 pv = {0u, 0u, 0u, 0u}; if (t > 0) pv = *(const GAS u32x4*)(cur - RWKV_COLS);
                float o[8];
#pragma unroll
                for (int e = 0; e < 8; ++e) { const int sh = (e & 1) * 16, q = e >> 1; const float x = __uint_as_float((cv[q] >> sh) << 16), p = __uint_as_float((pv[q] >> sh) << 16), v = x + (p - x) * mu[3072 + j0 + e];
                    o[e] = j0 < 64 ? tanhf(v) : (j0 < 128 ? v : sigmoidf_(v)); }
                u32x4 w;
#pragma unroll
                for (int q = 0; q < 4; ++q) w[q] = pk2(o[2 * q], o[2 * q + 1]);
                *(GAS u32x4*)(WSP(bf16_t, WS_XL) + (size_t)t * 256 + j0) = w; }
        }
        SEAM(PH_MEMPRE);
    }
    if (IN(PH_LORA)) {
        FRESH_IDS;
        pg8::Gemm g{WSP(bf16_t, WS_XL), WSP(bf16_t, WS_WLORA), SEQ, 3072, 256, 256, 256}; pg8::StaticOrder S; S.init(SEQ, 3072, G, bx);
        pg8::EpiBfGen E{WSP(bf16_t, WS_LG), 3072, 0xffff, 0xffff, 0};
        pg8::gemm_phase<pg8::EpiBfGen, pg8::StaticOrder, false, true>(L + RING_OFF, g, S, E);
        { pg8::Gemm g{WSP(bf16_t, WS_KVH), WSP(bf16_t, WS_WQBH), MEM_HEADS * MEM_LEN, MEM_HEADS * DM, MEM_HD, MEM_HD, MEM_HD}; pg8::HeadOrderS S{G, (bx + G - 128 % G) % G};
          pg8::EpiBfGenCS E{WSP(bf16_t, WS_BTS), DM, 0xffff, 7, 0, INF(19)};
          pg8::gemm_phase<pg8::EpiBfGenCS, pg8::HeadOrderS, true, true>(L + RING_OFF, g, S, E); }
        { pg8::Gemm g{WSP(bf16_t, WS_WOTH), WSP(bf16_t, WS_KVH), MEM_HEADS * DM, 2 * MEM_HEADS * MEM_LEN, MEM_HD, MEM_HD, MEM_HD}; pg8::HeadOrderO S{G, (bx + G - 160 % G) % G};
          pg8::EpiBfGen E{WSP(bf16_t, WS_BTO), MEM_HEADS * MEM_LEN, 7, 0xffff, 4};
          pg8::gemm_phase<pg8::EpiBfGen, pg8::HeadOrderO, true, true>(L + RING_OFF, g, S, E); }
        SEAM(PH_LORA);
    }
    if (IN(PH_SCANA)) {
        FRESH_IDS;
        const ScanW W{INF(5), INF(6), INF(8), INF(11), INF(12), INF(13)};
        const ScanBufs B{WSP(bf16_t, WS_PR), WSP(bf16_t, WS_LG), WSP(bf16_t, WS_RPP), WSP(float, WS_YG), WSP(bf16_t, WS_PT), WSP(float, WS_QT), WSP(bf16_t, WS_EG), WSP(bf16_t, WS_EBV)};
        for (int u = bx; u < NH_R * NCHUNK; u += G) scanA_unit(L + RING_OFF, W, B, u / NCHUNK, u % NCHUNK, tid, wave, lane);
        SEAM(PH_SCANA);
    }
    if (IN(PH_SCANB)) {
        FRESH_IDS;
        if (wave == 0 && bx < 2 * NH_R) scanB_wave(WSP(bf16_t, WS_PT), WSP(float, WS_QT), WSP(bf16_t, WS_SC), bx >> 1, bx & 1, lane);
        {
            static_assert(attn_body::ATTN_LDS_BYTES <= RING_BYTES, "attention body LDS");
            const attn_body::AttnTensors AT{(const attn_body::bf16*)WSP(bf16_t, WS_QB), (const attn_body::bf16*)WSP(bf16_t, WS_KB), (const attn_body::bf16*)WSP(bf16_t, WS_VB), (attn_body::bf16*)WSP(bf16_t, WS_O2)};
            const attn_body::QueueOrder S{(unsigned*)(ctl + CW_AQ), MISC + 16, bx & 7};
            attn_body::attn_phase<attn_body::QueueOrder>((char*)lds + RING_OFF, AT, S);
        }
        SEAM(PH_SCANB);
    }
    if (IN(PH_SCANC)) {
        FRESH_IDS;
        for (int u = bx; u < NH_R * NCHUNK; u += G)
            scanC_unit(L + RING_OFF, WSP(bf16_t, WS_SC), WSP(bf16_t, WS_RPP), WSP(float, WS_YG), WSP(bf16_t, WS_EG), WSP(bf16_t, WS_EBV), INF(14), INF(15), WSP(bf16_t, WS_MIXED), u / NCHUNK, u % NCHUNK, tid, wave, lane);
        __syncthreads();
    }
    if (IN(PH_POST)) {
        FRESH_IDS;
        const float* lp = INF(16); const float lam = __expf(wave_allsum(lp[lane] * lp[64 + lane])) - __expf(wave_allsum(lp[128 + lane] * lp[192 + lane])) + LAMBDA_INIT;
        const int hw = tid >> 8, lt = tid & 255;
        for (int t = bx * 2 + hw; t < SEQ; t += 2 * G) diff_post_token(WSP(bf16_t, WS_O2), lam, INF(17), WSP(bf16_t, WS_MIXED), t, lt);
        SEAM(PH_POST);
    }
    if (IN(PH_OUTPROJ)) {
        FRESH_IDS;
        pg8::Gemm g{WSP(bf16_t, WS_MIXED), WSP(bf16_t, WS_WOUTT), SEQ, DM, DM, DM, DM}; pg8::StaticOrder S; S.init(SEQ, DM, G, bx);
        pg8::EpiResidSq E{INF(0), WSP(float, WS_H1), WSP(bf16_t, WS_HN1), WSP(float, WS_PSQ)};
        pg8::gemm_phase<pg8::EpiResidSq, pg8::StaticOrder, false, true>(L + RING_OFF, g, S, E);
        SEAM(PH_OUTPROJ);
    }
    if (IN(PH_HN1)) {
        FRESH_IDS;
    }
    if (IN(PH_SCORES)) {
        FRESH_IDS;
        pg8::Gemm g{WSP(bf16_t, WS_HN1), WSP(bf16_t, WS_BTS), SEQ, MEM_HEADS * MEM_LEN, DM, DM, DM}; pg8::StaticOrder S; S.init(SEQ, MEM_HEADS * MEM_LEN, G, bx);
        pg8::EpiSoftmax E{WSP(bf16_t, WS_PM), 0.044194173824159216f * 1.4426950408889634f};
        pg8::gemm_phase<pg8::EpiSoftmax, pg8::StaticOrder, false, true>(L + RING_OFF, g, S, E);
        SEAM(PH_SCORES);
    }
    if (IN(PH_MEMOUT)) {
        FRESH_IDS;
        pg8::Gemm g{WSP(bf16_t, WS_PM), WSP(bf16_t, WS_BTO), SEQ, DM, MEM_HEADS * MEM_LEN, MEM_HEADS * MEM_LEN, MEM_HEADS * MEM_LEN}; pg8::StaticOrder S; S.init(SEQ, DM, G, bx);
        pg8::EpiResid E{WSP(float, WS_H1), WSP(float, WS_H2)};
        pg8::gemm_phase<pg8::EpiResid, pg8::StaticOrder, false, true>(L + RING_OFF, g, S, E);
        SEAM(PH_MEMOUT);
    }
    if (IN(PH_ROUTER)) {
        FRESH_IDS;
        LAS float* part = (LAS float*)(L + RING_OFF);
        LAS float* ssq = (LAS float*)(L + RING_OFF + 40960);
        const int tl = wave >> 2, kq = wave & 3, fr = lane & 15, fq = lane >> 4;
        int* asg_e = WSP(int, WS_ASG); int* asg_r = asg_e + 2 * SEQ; float* asg_w = (float*)(asg_r + 2 * SEQ);
        for (int it = 0; it < (SEQ / 32 + G - 1) / G; ++it) { const int blk = it * G + bx; const bool on = blk < SEQ / 32; const int t0 = blk * 32 + tl * 16;
            __syncthreads();
            if (on) {
                f32x4 acc[5]; float sq = 0.f;
#pragma unroll
                for (int ct = 0; ct < 5; ++ct) acc[ct] = (f32x4){0.f, 0.f, 0.f, 0.f};
                const GAS float* ap = (const GAS float*)WSP(float, WS_H2) + (size_t)(t0 + fr) * DM + kq * 512 + 4 * fq;
                const GAS float* bp = (const GAS float*)WSP(float, WS_RT) + (size_t)fr * DM + kq * 512 + 4 * fq;
#pragma unroll 2
                for (int kb = 0; kb < 32; ++kb) { const f32x4 av = *(const GAS f32x4*)(ap + kb * 16); f32x4 bv[5];
#pragma unroll
                    for (int ct = 0; ct < 5; ++ct) bv[ct] = *(const GAS f32x4*)(bp + (size_t)ct * 16 * DM + kb * 16);
                    sq += (av[0] * av[0] + av[1] * av[1]) + (av[2] * av[2] + av[3] * av[3]);
#pragma unroll
                    for (int j = 0; j < 4; ++j)
#pragma unroll
                        for (int ct = 0; ct < 5; ++ct) acc[ct] = __builtin_amdgcn_mfma_f32_16x16x4f32(av[j], bv[ct][j], acc[ct], 0, 0, 0); }
                sq = rowpair_sum(sq); { float a2 = sq, b2 = sq; asm("s_nop 1\n\tv_permlane32_swap_b32 %0, %1" : "+v"(a2), "+v"(b2)); sq = a2 + b2; }
                if (fq == 0) ssq[(tl * 4 + kq) * 16 + fr] = sq;
#pragma unroll
                for (int ct = 0; ct < 5; ++ct)
#pragma unroll
                    for (int r = 0; r < 4; ++r) part[((tl * 4 + kq) * 16 + 4 * fq + r) * 80 + ct * 16 + fr] = acc[ct][r]; }
            __syncthreads();
            if (on && tid < 32) { const int tk = tid & 15, tt = tid >> 4, t = blk * 32 + tt * 16 + tk;
                const float s = (ssq[(tt * 4 + 0) * 16 + tk] + ssq[(tt * 4 + 1) * 16 + tk]) + (ssq[(tt * 4 + 2) * 16 + tk] + ssq[(tt * 4 + 3) * 16 + tk]);
                const float rs = rsqrtf(s * (1.f / DM) + NORM_EPS); WSP(float, WS_RS)[t] = rs;
                const LAS float* p0 = part + ((tt * 4 + 0) * 16 + tk) * 80; const float *bg = INF(27), *be = INF(29);
#define LGT(c) ((((p0[c] + p0[1280 + (c)]) + (p0[2560 + (c)] + p0[3840 + (c)])) * rs) + ((c) < 8 ? bg[c] : be[(c) - 8]))
                float gl[8];
#pragma unroll
                for (int i = 0; i < 8; ++i) gl[i] = LGT(i);
                int gi = 0; float gm = gl[0];
#pragma unroll
                for (int i = 1; i < 8; ++i) if (gl[i] > gm) { gm = gl[i]; gi = i; }
                float gs = 0.f;
#pragma unroll
                for (int i = 0; i < 8; ++i) gs += expf(gl[i] - gm);
                const float gwt = 1.f / gs;
                float el[8];
                for (int i = 0; i < 8; ++i) el[i] = LGT(8 + gi * 8 + i);
                int i0 = 0; for (int i = 1; i < 8; ++i) if (el[i] > el[i0]) i0 = i;
                int i1 = -1; for (int i = 0; i < 8; ++i) if (i != i0 && (i1 < 0 || el[i] > el[i1])) i1 = i;
#undef LGT
                const float p1 = expf(el[i1] - el[i0]), w0 = gwt / (1.f + p1), w1 = gwt * p1 / (1.f + p1);
                const int e0 = gi * 8 + i0, e1 = gi * 8 + i1;
                asg_e[2 * t] = e0; asg_e[2 * t + 1] = e1; asg_w[2 * t] = w0; asg_w[2 * t + 1] = w1;
                asg_r[2 * t] = (int)atomicAdd((unsigned*)(ctl + CW_CNT + e0), 1u); asg_r[2 * t + 1] = (int)atomicAdd((unsigned*)(ctl + CW_CNT + e1), 1u); } }
        SEAM(PH_ROUTER);
    }
    if (IN(PH_GATHER)) {
        FRESH_IDS;
        LAS unsigned* sb = (LAS unsigned*)(L + RING_OFF);
        if (wave == 0) {
            const unsigned n = (__hip_atomic_load(ctl + CW_CNT + lane, RLX_AGENT) + 255u) / 256u; unsigned inc = n;
#pragma unroll
            for (int o = 1; o < 64; o <<= 1) { const unsigned v = (unsigned)__shfl_up((int)inc, o); if (lane >= o) inc += v; }
            const unsigned b = (inc - n) * 256u; sb[lane] = b;
            if (bx == 0) __hip_atomic_store(ctl + CW_BASE + lane, b, RLX_AGENT); }
        __syncthreads();
        const int* asg_e = WSP(int, WS_ASG); const int* asg_r = asg_e + 2 * SEQ;
        for (int t = gw; t < SEQ; t += NGW) { const GAS f32x4* src = (const GAS f32x4*)(WSP(float, WS_H2) + (size_t)t * DM) + lane; const GAS f32x4* gp = (const GAS f32x4*)INF(25) + lane; const float rs = WSP(float, WS_RS)[t];
            unsigned long long r[8];
#pragma unroll
            for (int i = 0; i < 8; ++i) { const f32x4 v = src[64 * i] * gp[64 * i] * rs; r[i] = (unsigned long long)pk2(v[0], v[1]) | ((unsigned long long)pk2(v[2], v[3]) << 32); }
#pragma unroll
            for (int j = 0; j < 2; ++j) { const size_t row = sb[asg_e[2 * t + j]] + (unsigned)asg_r[2 * t + j]; GAS unsigned long long* dst = (GAS unsigned long long*)(WSP(bf16_t, WS_XG) + row * DM) + lane;
#pragma unroll
                for (int i = 0; i < 8; ++i) dst[64 * i] = r[i]; } }
        SEAM(PH_GATHER);
    }
    if (IN(PH_GATEUP)) {
        FRESH_IDS;
        for (int u = vcu; u < N_EXP * 16; u += G) { const int e = u >> 4, nt = u & 15;
            const int cnt = __builtin_amdgcn_readfirstlane((int)__hip_atomic_load(ctl + CW_CNT + e, RLX_AGENT)), row0 = __builtin_amdgcn_readfirstlane((int)__hip_atomic_load(ctl + CW_BASE + e, RLX_AGENT));
            moe_stream_unit<0>(L + RING_OFF, WSP(bf16_t, WS_XG), DM, INF(30) + (size_t)e * DM * D_EXP, INF(31) + (size_t)e * DM * D_EXP, D_EXP, 64 * nt, DM, row0, cnt, WSP(bf16_t, WS_HID), nullptr, tid, wave, lane); }
        SEAM(PH_GATEUP);
    }
    if (IN(PH_DOWN)) {
        FRESH_IDS;
        for (int u = vcu; u < N_EXP * 16; u += G) { const int e = u >> 4, nt = u & 15;
            const int cnt = __builtin_amdgcn_readfirstlane((int)__hip_atomic_load(ctl + CW_CNT + e, RLX_AGENT)), row0 = __builtin_amdgcn_readfirstlane((int)__hip_atomic_load(ctl + CW_BASE + e, RLX_AGENT));
            moe_stream_unit<1>(L + RING_OFF, WSP(bf16_t, WS_HID), D_EXP, INF(32) + (size_t)e * D_EXP * DM, nullptr, DM, 128 * nt, D_EXP, row0, cnt, WSP(bf16_t, WS_YC), nullptr, tid, wave, lane); }
        SEAM(PH_DOWN);
    }
    if (IN(PH_FINAL)) {
        FRESH_IDS;
        __syncthreads();
        LAS unsigned* sb = (LAS unsigned*)(L + RING_OFF);
        if (tid < N_EXP) sb[tid] = __hip_atomic_load(ctl + CW_BASE + tid, RLX_AGENT);
        __syncthreads();
        const int* asg_e = WSP(int, WS_ASG); const int* asg_r = asg_e + 2 * SEQ; const float* asg_w = (const float*)(asg_r + 2 * SEQ);
        for (int t = gw; t < SEQ; t += NGW) {
            const size_t r0 = sb[asg_e[2 * t]] + (unsigned)asg_r[2 * t], r1 = sb[asg_e[2 * t + 1]] + (unsigned)asg_r[2 * t + 1]; const float w0 = asg_w[2 * t], w1 = asg_w[2 * t + 1];
            const GAS f32x4* hp = (const GAS f32x4*)(WSP(float, WS_H2) + (size_t)t * DM) + lane; typedef unsigned u32x2_t __attribute__((ext_vector_type(2)));
            const GAS u32x2_t* y0 = (const GAS u32x2_t*)(WSP(bf16_t, WS_YC) + r0 * DM) + lane; const GAS u32x2_t* y1 = (const GAS u32x2_t*)(WSP(bf16_t, WS_YC) + r1 * DM) + lane;
            f32x4 v[8]; float s = 0.f;
#pragma unroll
            for (int j = 0; j < 8; ++j) { const u32x2_t ya = y0[64 * j], yb = y1[64 * j];
                const f32x4 fa = {__uint_as_float(ya[0] << 16), __uint_as_float(ya[0] & 0xffff0000u), __uint_as_float(ya[1] << 16), __uint_as_float(ya[1] & 0xffff0000u)};
                const f32x4 fb = {__uint_as_float(yb[0] << 16), __uint_as_float(yb[0] & 0xffff0000u), __uint_as_float(yb[1] << 16), __uint_as_float(yb[1] & 0xffff0000u)};
                v[j] = hp[64 * j] + (fa * w0 + fb * w1); s += (v[j][0] * v[j][0] + v[j][1] * v[j][1]) + (v[j][2] * v[j][2] + v[j][3] * v[j][3]); }
            const float rs = rsqrtf(wave_allsum(s) * (1.f / DM) + NORM_EPS); const GAS f32x4* gp = (const GAS f32x4*)INF(33) + lane; GAS f32x4* op = (GAS f32x4*)(args.out + (size_t)t * DM) + lane;
#pragma unroll
            for (int j = 0; j < 8; ++j) op[64 * j] = v[j] * rs * gp[64 * j]; }
    }
#if MK_PROBE >= 18
    if (IN(PH_X1) || IN(PH_X2) || IN(PH_X3)) {
        f32x4 s = {0.f, 0.f, 0.f, 0.f};
        if (IN(PH_X1)) {
#ifndef MK_XW
#define MK_XW 4
#endif
            if (wave < MK_XW) for (int u = vcu; u < N_EXP * 16; u += G) { const int e = u >> 4, nt = u & 15;
                for (int m = 0; m < 2; ++m) { const float* wb = (m ? INF(31) : INF(30)) + (size_t)e * DM * D_EXP + 64 * nt + (lane & 15) * 4;
                for (int k0 = wave * 4 + (lane >> 4); k0 < DM; k0 += 16 * 4 * MK_XW) { f32x4 v[16];
#pragma unroll
                    for (int j = 0; j < 16; ++j) v[j] = *(const GAS f32x4*)(wb + (size_t)(k0 + 4 * MK_XW * j) * D_EXP);
#pragma unroll
                    for (int j = 0; j < 16; ++j) s += v[j]; } } } }
        if (IN(PH_X2)) {
        FRESH_IDS;
            const size_t total = (size_t)N_EXP * DM * D_EXP / 4;
            for (int m = 0; m < 2; ++m) { const GAS f32x4* p = (const GAS f32x4*)(m ? INF(31) : INF(30));
                for (size_t i = (size_t)gw * 64 + lane; i < total; i += (size_t)NGW * 64 * 8) { f32x4 v[8];
#pragma unroll
                    for (int j = 0; j < 8; ++j) { const size_t q = i + (size_t)j * NGW * 64; v[j] = q < total ? p[q] : (f32x4){0.f, 0.f, 0.f, 0.f}; }
#pragma unroll
                    for (int j = 0; j < 8; ++j) s += v[j]; } } }
        if (IN(PH_X3)) {
        FRESH_IDS;
            for (int u = vcu; u < N_EXP * 16; u += G) { const int e = u >> 4, kb = u & 15;
                for (int m = 0; m < 2; ++m) { const GAS f32x4* p = (const GAS f32x4*)((m ? INF(31) : INF(30)) + (size_t)e * DM * D_EXP + (size_t)kb * 128 * D_EXP);
                    for (int i = tid; i < 128 * D_EXP / 4; i += 512 * 8) { f32x4 v[8];
#pragma unroll
                        for (int j = 0; j < 8; ++j) v[j] = p[i + 512 * j];
#pragma unroll
                        for (int j = 0; j < 8; ++j) s += v[j]; } } } }
        if (s[0] + s[1] + s[2] + s[3] == 123.456f) WSP(float, WS_RS)[SEQ + tid] = s[0];
    }
#endif
#undef IN
#undef SEAM
#undef FRESH_IDS
#undef WSP
#undef INF
}

__global__ void k_transpose(const float* W, int K, int N, bf16_t* WT, int mode, int rowoff, size_t wstride, int rows_per_z) {
    __shared__ float t[32][33];
    W += (size_t)blockIdx.z * wstride; rowoff += blockIdx.z * rows_per_z;
    const int n0 = blockIdx.x * 32, k0 = blockIdx.y * 32, tx = threadIdx.x & 31, ty = threadIdx.x >> 5;
    for (int i = 0; i < 4; ++i) t[ty + 8 * i][tx] = W[(size_t)(k0 + ty + 8 * i) * N + n0 + tx];
    __syncthreads();
    for (int i = 0; i < 4; ++i) { const int n = n0 + ty + 8 * i; int r = n;
        if (mode == 1) r = (n & ~63) + rope_phys(n & 63);
        else if (mode == 2) r = (n >> 7) * 256 + (n & 127);
        else if (mode == 3) r = (n >> 7) * 256 + 128 + (n & 127);
        WT[(size_t)(rowoff + r) * K + k0 + tx] = f2bf(t[tx][ty + 8 * i]); }
}
__global__ void k_wqbh(const float* wq, bf16_t* O) { const size_t i = (size_t)blockIdx.x * blockDim.x + threadIdx.x; const int k = (int)(i >> 11), n = (int)(i & 2047); O[((size_t)(n >> 9) * DM + k) * MEM_HD + (n & 511)] = f2bf(wq[i]); }
__global__ void k_rmsnorm_bf16(const float* x, const float* g, bf16_t* out) {
    __shared__ float red[4];
    const float* xr = x + (size_t)blockIdx.x * DM; const int tid = threadIdx.x;
    float v[8]; float s = 0.f;
    for (int i = 0; i < 8; ++i) { v[i] = xr[tid + 256 * i]; s += v[i] * v[i]; }
    for (int o = 32; o > 0; o >>= 1) s += __shfl_xor(s, o);
    if ((tid & 63) == 0) red[tid >> 6] = s;
    __syncthreads();
    const float rs = rsqrtf((red[0] + red[1] + red[2] + red[3]) * (1.f / DM) + NORM_EPS);
    for (int i = 0; i < 8; ++i) out[(size_t)blockIdx.x * DM + tid + 256 * i] = f2bf(v[i] * rs * g[tid + 256 * i]);
}
__global__ void k_rope_table(const int* pos, float* tab) {
    const int i = blockIdx.x * blockDim.x + threadIdx.x; if (i >= SEQ * 32) return;
    const int t = i >> 5, j = i & 31;
    const double inv = pow(10000.0, -(double)j / 32.0), ang = (double)pos[t] * inv;
    tab[2 * i] = (float)cos(ang); tab[2 * i + 1] = (float)sin(ang);
}

struct NEpiInProj { bf16_t* PR; float* QKraw; bf16_t* Vb;
    __device__ void operator()(int m, int n, const float* v) const {
        if (n < RWKV_COLS) { for (int i = 0; i < 4; ++i) PR[(size_t)m * RWKV_COLS + n + i] = f2bf(v[i]); }
        else if (n < RWKV_COLS + 2 * QK_COLS) { for (int i = 0; i < 4; ++i) QKraw[(size_t)m * 2048 + (n - RWKV_COLS) + i] = v[i]; }
        else { for (int i = 0; i < 4; ++i) Vb[(size_t)m * 1024 + (n - RWKV_COLS - 2 * QK_COLS) + i] = f2bf(v[i]); } } };
struct NEpiBf { bf16_t* C; int ldc; int pad = 0; __device__ void operator()(int m, int n, const float* v) const { for (int i = 0; i < 4; ++i) C[(size_t)m * ldc + n + i] = f2bf(v[i]); } };
struct NEpiF32 { float* C; int ldc; int pad = 0; __device__ void operator()(int m, int n, const float* v) const { for (int i = 0; i < 4; ++i) C[(size_t)m * ldc + n + i] = v[i]; } };
struct NEpiResid { const float* base; float* out; int ldc; int pad = 0; __device__ void operator()(int m, int n, const float* v) const { for (int i = 0; i < 4; ++i) out[(size_t)m * ldc + n + i] = base[(size_t)m * ldc + n + i] + v[i]; } };

template <class Epi>
__global__ void __launch_bounds__(256) k_gemm(const bf16_t* A, int lda, const bf16_t* Bt, int ldb, int K, Epi epi, const unsigned* ctl, int eStrideB) {
    __shared__ float As[32][68], Bs[32][68];
    const int tid = threadIdx.x, m0 = blockIdx.y * 64, n0 = blockIdx.x * 64;
    if (ctl) { if ((m0 >> 8) >= (int)ctl[CW_NT]) return; Bt += (size_t)ctl[CW_TILEE + (m0 >> 8)] * eStrideB * ldb; }
    const int lr = tid >> 2, lc = (tid & 3) * 8;
    const int ty = tid >> 4, tx = tid & 15;
    float acc[4][4] = {};
    for (int k0 = 0; k0 < K; k0 += 32) {
        const u32x4 av = *(const u32x4*)(A + (size_t)(m0 + lr) * lda + k0 + lc);
        const u32x4 bv = *(const u32x4*)(Bt + (size_t)(n0 + lr) * ldb + k0 + lc);
        __syncthreads();
        for (int i = 0; i < 4; ++i) { As[lc + 2 * i][lr] = __uint_as_float(av[i] << 16); As[lc + 2 * i + 1][lr] = __uint_as_float(av[i] & 0xffff0000u);
                                      Bs[lc + 2 * i][lr] = __uint_as_float(bv[i] << 16); Bs[lc + 2 * i + 1][lr] = __uint_as_float(bv[i] & 0xffff0000u); }
        __syncthreads();
#pragma unroll 8
        for (int k = 0; k < 32; ++k) { const f32x4 a = *(const f32x4*)&As[k][ty * 4], b = *(const f32x4*)&Bs[k][tx * 4];
            for (int i = 0; i < 4; ++i) for (int j = 0; j < 4; ++j) acc[i][j] += a[i] * b[j]; }
    }
    for (int i = 0; i < 4; ++i) epi(m0 + ty * 4 + i, n0 + tx * 4, acc[i]);
}

__global__ void k_rope_apply(const float* QKraw, const float* tab, bf16_t* Qb, bf16_t* Kb) {
    const int t = blockIdx.x;
    for (int idx = threadIdx.x; idx < 1024; idx += 256) { const int which = idx >> 9, sh = (idx >> 5) & 15, j = idx & 31;
        const int plo = 8 * (j >> 2) + (j & 3), phi = plo + 4;
        const float* src = QKraw + (size_t)t * 2048 + which * 1024 + sh * 64;
        const float x1 = src[plo], x2 = src[phi], c = tab[((size_t)t * 32 + j) * 2], s = tab[((size_t)t * 32 + j) * 2 + 1];
        const float sc = which == 0 ? C2 : 1.f;
        bf16_t* dst = (which == 0 ? Qb : Kb) + (size_t)t * 1024 + sh * 64;
        dst[plo] = f2bf((x1 * c - x2 * s) * sc); dst[phi] = f2bf((x1 * s + x2 * c) * sc); }
}

__global__ void __launch_bounds__(256) k_prep(const bf16_t* PR, PrepW P, float* S0, float* BONUS) {
    __shared__ float xs[256];
    const int t = blockIdx.x, tid = threadIdx.x;
    const bf16_t* cur = PR + (size_t)t * RWKV_COLS; const bf16_t* prv = cur - RWKV_COLS;
    auto shifted = [&](int c) { const float a = bf2f(cur[c]), p = t > 0 ? bf2f(prv[c]) : 0.f; return a + (p - a) * P.mu[c]; };
    { const float v = shifted(3072 + tid); xs[tid] = tid < 64 ? tanhf(v) : (tid < 128 ? v : sigmoidf_(v)); }
    __syncthreads();
    float lw[4], la[4], lg[4] = {0.f, 0.f, 0.f, 0.f};
    for (int i = 0; i < 4; ++i) { lw[i] = P.w0[tid * 4 + i]; la[i] = P.a0[tid * 4 + i]; }
#pragma unroll 4
    for (int j = 0; j < 64; ++j) { const f32x4 w = *(const f32x4*)(P.w2 + (size_t)j * RW + tid * 4), a = *(const f32x4*)(P.a2 + (size_t)j * RW + tid * 4);
        for (int i = 0; i < 4; ++i) { lw[i] += xs[j] * w[i]; la[i] += xs[64 + j] * a[i]; } }
#pragma unroll 4
    for (int j = 0; j < 128; ++j) { const f32x4 g = *(const f32x4*)(P.g2 + (size_t)j * RW + tid * 4); for (int i = 0; i < 4; ++i) lg[i] += xs[128 + j] * g[i]; }
    float r[4], k0[4], v[4], kk[4], a[4], ss = 0.f;
    for (int i = 0; i < 4; ++i) { const int c = tid * 4 + i; r[i] = shifted(c); k0[i] = shifted(1024 + c); v[i] = shifted(2048 + c);
        a[i] = sigmoidf_(la[i]); kk[i] = k0[i] * P.k_k[c]; ss += kk[i] * kk[i]; }
    for (int o = 1; o < 16; o <<= 1) ss += __shfl_xor(ss, o);
    const float inv = 1.f / fmaxf(sqrtf(ss), 1e-12f);
    float bon = 0.f; const size_t ob = (size_t)t * RW + tid * 4; constexpr size_t SS = (size_t)SEQ * RW;
    for (int i = 0; i < 4; ++i) { const int c = tid * 4 + i;
        const float x = -lw[i], sp = fmaxf(x, 0.f) + log1pf(__expf(-fabsf(x))), wraw = -sp - 0.5f, dec = __expf(-__expf(wraw));
        const float kn = kk[i] * inv, k = k0[i] * (1.f + (a[i] - 1.f) * P.k_a[c]);
        bon += r[i] * k * P.r_k[c];
        S0[0 * SS + ob + i] = r[i]; S0[1 * SS + ob + i] = dec; S0[2 * SS + ob + i] = k; S0[3 * SS + ob + i] = v[i];
        S0[4 * SS + ob + i] = -kn; S0[5 * SS + ob + i] = kn * a[i]; S0[6 * SS + ob + i] = lg[i]; }
    for (int o = 1; o < 16; o <<= 1) bon += __shfl_xor(bon, o);
    if ((tid & 15) == 0) BONUS[t * 16 + (tid >> 4)] = bon;
}
__global__ void __launch_bounds__(256) k_scan(const float* S0, float* Y) {
    const int w = blockIdx.x * 4 + (threadIdx.x >> 6), lane = threadIdx.x & 63, h = w >> 6, vr = w & 63;
    constexpr size_t SS = (size_t)SEQ * RW;
    const float* pr = S0 + h * 64 + lane; float s = 0.f;
    for (int t = 0; t < SEQ; ++t) { const size_t o = (size_t)t * RW;
        const float r = pr[o], wd = pr[SS + o], k = pr[2 * SS + o], a = pr[4 * SS + o], b = pr[5 * SS + o], v = S0[3 * SS + o + h * 64 + vr];
        float sa = s * a; for (int x = 32; x > 0; x >>= 1) sa += __shfl_xor(sa, x);
        s = s * wd + sa * b + v * k;
        float y = s * r; for (int x = 32; x > 0; x >>= 1) y += __shfl_xor(y, x);
        if (lane == 0) Y[o + h * 64 + vr] = y; }
}
__global__ void __launch_bounds__(256) k_rwkv_post(const float* Y, const float* S0, const float* BONUS, const float* lnx_w, const float* lnx_b, bf16_t* MIXED) {
    const int t = blockIdx.x, tid = threadIdx.x; constexpr size_t SS = (size_t)SEQ * RW; const size_t ob = (size_t)t * RW + tid * 4;
    float y[4], s = 0.f; for (int i = 0; i < 4; ++i) { y[i] = Y[ob + i]; s += y[i]; }
    for (int o = 1; o < 16; o <<= 1) s += __shfl_xor(s, o);
    const float mean = s * (1.f / 64.f); float q = 0.f; for (int i = 0; i < 4; ++i) { y[i] -= mean; q += y[i] * y[i]; }
    for (int o = 1; o < 16; o <<= 1) q += __shfl_xor(q, o);
    const float rstd = rsqrtf(q * (1.f / 64.f) + LNX_EPS), bon = BONUS[t * 16 + (tid >> 4)];
    for (int i = 0; i < 4; ++i) { const int c = tid * 4 + i; const float o = (y[i] * rstd * lnx_w[c] + lnx_b[c] + bon * S0[3 * SS + ob + i]) * S0[6 * SS + ob + i];
        MIXED[(size_t)t * DM + c] = f2bf(o); }
}
__global__ void __launch_bounds__(64) k_attn(const bf16_t* Qb, const bf16_t* Kb, const bf16_t* Vb, bf16_t* O2) {
    const int row = blockIdx.x * 64 + threadIdx.x, sh = blockIdx.y, qt = blockIdx.z;
    float q[64], o[32]; for (int d = 0; d < 64; ++d) q[d] = bf2f(Qb[(size_t)row * 1024 + sh * 64 + d]);
    for (int d = 0; d < 32; ++d) o[d] = 0.f;
    float m = -1e30f, l = 0.f; const int jmax = blockIdx.x * 64 + 63;
    const bf16_t* kp = Kb + sh * 64; const bf16_t* vp = Vb + (sh >> 1) * 128 + qt * 32;
    for (int j = 0; j <= jmax; ++j) {
        float s = 0.f; for (int d = 0; d < 64; ++d) s += q[d] * bf2f(kp[(size_t)j * 1024 + d]);
        if (j <= row) { const float mn = fmaxf(m, s), f = exp2f(m - mn), p = exp2f(s - mn); l = l * f + p; m = mn;
            for (int d = 0; d < 32; ++d) o[d] = o[d] * f + p * bf2f(vp[(size_t)j * 1024 + d]); } }
    const float il = 1.f / l;
    for (int d = 0; d < 32; ++d) O2[(size_t)(qt >> 1) * SEQ * 1024 + (size_t)row * 1024 + sh * 64 + (qt & 1) * 32 + d] = f2bf(o[d] * il);
}
__global__ void __launch_bounds__(256) k_diff_post(const bf16_t* O2, const float* lambdas, const float* subln_w, bf16_t* MIXED) {
    __shared__ float lamsh;
    const int t = blockIdx.x, tid = threadIdx.x;
    if (tid < 64) { float a = lambdas[tid] * lambdas[64 + tid], b = lambdas[128 + tid] * lambdas[192 + tid];
        for (int o = 32; o > 0; o >>= 1) { a += __shfl_xor(a, o); b += __shfl_xor(b, o); }
        if (tid == 0) lamsh = expf(a) - expf(b) + LAMBDA_INIT; }
    __syncthreads();
    const float lam = lamsh; const int h = tid >> 5, d0 = (tid & 31) * 4;
    float o[4], q = 0.f;
    const bf16_t* ob = O2 + (size_t)(d0 >> 6) * SEQ * 1024 + (size_t)t * 1024 + (d0 & 63);
    for (int i = 0; i < 4; ++i) { o[i] = bf2f(ob[(2 * h) * 64 + i]) - lam * bf2f(ob[(2 * h + 1) * 64 + i]); q += o[i] * o[i]; }
    for (int x = 1; x < 32; x <<= 1) q += __shfl_xor(q, x);
    const float rs = rsqrtf(q * (1.f / 128.f) + SUBLN_EPS) * (1.f - LAMBDA_INIT);
    for (int i = 0; i < 4; ++i) MIXED[(size_t)t * DM + 1024 + h * 128 + d0 + i] = f2bf(o[i] * rs * subln_w[d0 + i]);
}
__global__ void __launch_bounds__(256) k_softmax_mem(const float* Sraw, bf16_t* Pm) {
    const int t = blockIdx.x, tid = threadIdx.x, h = tid >> 6;
    const float sc = 0.044194173824159216f;
    float v[4], m = -1e30f; for (int i = 0; i < 4; ++i) { v[i] = Sraw[(size_t)t * 1024 + h * 256 + (tid & 63) + 64 * i] * sc; m = fmaxf(m, v[i]); }
    for (int o = 32; o > 0; o >>= 1) m = fmaxf(m, __shfl_xor(m, o));
    float s = 0.f; for (int i = 0; i < 4; ++i) { v[i] = __expf(v[i] - m); s += v[i]; }
    for (int o = 32; o > 0; o >>= 1) s += __shfl_xor(s, o);
    const float il = 1.f / s; for (int i = 0; i < 4; ++i) Pm[(size_t)t * 1024 + h * 256 + (tid & 63) + 64 * i] = f2bf(v[i] * il);
}
__global__ void __launch_bounds__(256) k_router(const float* H2, const float* g, const float* wg, const float* bg, const float* we, const float* be, bf16_t* XH, unsigned* ctl, int* asg_e, int* asg_r, float* asg_w) {
    __shared__ float hn[DM]; __shared__ float red[4]; __shared__ float lg[72];
    const int t = blockIdx.x, tid = threadIdx.x; const float* xr = H2 + (size_t)t * DM;
    float v[8], s = 0.f; for (int i = 0; i < 8; ++i) { v[i] = xr[tid + 256 * i]; s += v[i] * v[i]; }
    for (int o = 32; o > 0; o >>= 1) s += __shfl_xor(s, o);
    if ((tid & 63) == 0) red[tid >> 6] = s;
    __syncthreads();
    const float rs = rsqrtf((red[0] + red[1] + red[2] + red[3]) * (1.f / DM) + NORM_EPS);
    for (int i = 0; i < 8; ++i) { const float x = v[i] * rs * g[tid + 256 * i]; hn[tid + 256 * i] = x; XH[(size_t)t * DM + tid + 256 * i] = f2bf(x); }
    __syncthreads();
    if (tid < 72) { float a = 0.f;
        if (tid < 8) { for (int k = 0; k < DM; ++k) a += hn[k] * wg[(size_t)k * 8 + tid]; a += bg[tid]; }
        else { for (int k = 0; k < DM; ++k) a += hn[k] * we[(size_t)k * 64 + tid - 8]; a += be[tid - 8]; }
        lg[tid] = a; }
    __syncthreads();
    if (tid == 0) {
        int gi = 0; float gm = lg[0]; for (int i = 1; i < 8; ++i) if (lg[i] > gm) { gm = lg[i]; gi = i; }
        float gs = 0.f; for (int i = 0; i < 8; ++i) gs += expf(lg[i] - gm);
        const float gw = 1.f / gs;
        const float* el = lg + 8 + gi * 8; int i0 = 0; for (int i = 1; i < 8; ++i) if (el[i] > el[i0]) i0 = i;
        int i1 = -1; for (int i = 0; i < 8; ++i) if (i != i0 && (i1 < 0 || el[i] > el[i1])) i1 = i;
        const float p1 = expf(el[i1] - el[i0]), w0 = gw / (1.f + p1), w1 = gw * p1 / (1.f + p1);
        const int e0 = gi * 8 + i0, e1 = gi * 8 + i1;
        asg_e[2 * t] = e0; asg_e[2 * t + 1] = e1; asg_w[2 * t] = w0; asg_w[2 * t + 1] = w1;
        asg_r[2 * t] = (int)atomicAdd(&ctl[CW_CNT + e0], 1u); asg_r[2 * t + 1] = (int)atomicAdd(&ctl[CW_CNT + e1], 1u); }
}
__global__ void k_moe_offsets(unsigned* ctl) {
    if (threadIdx.x == 0) { unsigned b = 0; int nt = 0;
        for (int e = 0; e < N_EXP; ++e) { ctl[CW_BASE + e] = b; const unsigned n = (ctl[CW_CNT + e] + 255u) / 256u; for (unsigned i = 0; i < n; ++i) ctl[CW_TILEE + nt++] = e; b += n * 256u; }
        ctl[CW_BASE + N_EXP] = b; ctl[CW_NT] = nt; }
}
__global__ void __launch_bounds__(256) k_gather(const bf16_t* XH, const unsigned* ctl, const int* asg_e, const int* asg_r, bf16_t* XG) {
    const int t = blockIdx.x, tid = threadIdx.x; const u32x4 v = *(const u32x4*)(XH + (size_t)t * DM + tid * 8);
    for (int i = 0; i < 2; ++i) { const size_t row = ctl[CW_BASE + asg_e[2 * t + i]] + asg_r[2 * t + i]; *(u32x4*)(XG + row * DM + tid * 8) = v; }
}
__global__ void k_silu_mul(const float* GU, const unsigned* ctl, bf16_t* HID) {
    const size_t i = (size_t)blockIdx.x * blockDim.x + threadIdx.x; const size_t row = i >> 10; const int c = (int)(i & 1023);
    if (row >= (size_t)ctl[CW_NT] * 256) return;
    const float gt = GU[row * 2048 + (c >> 7) * 256 + (c & 127)], up = GU[row * 2048 + (c >> 7) * 256 + 128 + (c & 127)];
    HID[row * 1024 + c] = f2bf(gt / (1.f + __expf(-gt)) * up);
}
__global__ void __launch_bounds__(256) k_final(const float* H2, const float* YC, const unsigned* ctl, const int* asg_e, const int* asg_r, const float* asg_w, const float* g, float* out) {
    __shared__ float red[4];
    const int t = blockIdx.x, tid = threadIdx.x;
    const size_t r0 = ctl[CW_BASE + asg_e[2 * t]] + asg_r[2 * t], r1 = ctl[CW_BASE + asg_e[2 * t + 1]] + asg_r[2 * t + 1]; const float w0 = asg_w[2 * t], w1 = asg_w[2 * t + 1];
    float v[8], s = 0.f; for (int i = 0; i < 8; ++i) { const int c = tid + 256 * i; v[i] = H2[(size_t)t * DM + c] + (w0 * YC[r0 * DM + c] + w1 * YC[r1 * DM + c]); s += v[i] * v[i]; }
    for (int o = 32; o > 0; o >>= 1) s += __shfl_xor(s, o);
    if ((tid & 63) == 0) red[tid >> 6] = s;
    __syncthreads();
    const float rs = rsqrtf((red[0] + red[1] + red[2] + red[3]) * (1.f / DM) + NORM_EPS);
    for (int i = 0; i < 8; ++i) out[(size_t)t * DM + tid + 256 * i] = v[i] * rs * g[tid + 256 * i];
}

template <class Epi> static void gemm(hipStream_t st, const bf16_t* A, int lda, const bf16_t* Bt, int ldb, int M, int N, int K, Epi e, const unsigned* ctl = nullptr, int eStrideB = 0) {
    hipLaunchKernelGGL(k_gemm<Epi>, dim3(N / 64, M / 64), dim3(256), 0, st, A, lda, Bt, ldb, K, e, ctl, eStrideB);
}
static int g_grid = 0;
static void launch_mk(hipStream_t st, Args a, int lo, int hi, int li) {
    a.ph_lo = lo; a.ph_hi = hi; a.li = li;
    hipLaunchKernelGGL(mk_fwd, dim3(g_grid), dim3(NWAVES * 64), LDS_BYTES, st, a);
    const hipError_t le = hipPeekAtLastError();
    if (le != hipSuccess) fprintf(stderr, "kernel_launch: mk_fwd launch [%d,%d) failed: %s\n", lo, hi, hipGetErrorName(le));
}
extern "C" void kernel_launch(void* const* d_in, const int* in_sizes, int n_in, void* d_out, int out_size, void* d_ws, size_t ws_size, hipStream_t stream) {
    if (n_in != 34 || ws_size < WS_NEED) { fprintf(stderr, "kernel_launch: need 34 inputs and %zu bytes of workspace (got %d, %zu)\n", (size_t)WS_END, n_in, ws_size); return; }
    if (g_grid == 0) {
        int dev = 0, cus = 0;
        if (hipGetDevice(&dev) != hipSuccess || hipDeviceGetAttribute(&cus, hipDeviceAttributeMultiprocessorCount, dev) != hipSuccess) { fprintf(stderr, "kernel_launch: device query failed\n"); g_grid = -1; return; }
        if (hipFuncSetAttribute((const void*)mk_fwd, hipFuncAttributeMaxDynamicSharedMemorySize, LDS_BYTES) != hipSuccess) { fprintf(stderr, "kernel_launch: hipFuncSetAttribute failed\n"); g_grid = -1; return; }
        int per_cu = 0; (void)hipOccupancyMaxActiveBlocksPerMultiprocessor(&per_cu, (const void*)mk_fwd, NWAVES * 64, LDS_BYTES); (void)hipGetLastError();
        if (per_cu < 1) fprintf(stderr, "kernel_launch: note: occupancy query reports %d workgroups per CU\n", per_cu);
        g_grid = cus;
    }
    if (g_grid < 0) return;
    auto F = [&](int i) { return (const float*)d_in[i]; };
    const float *x = F(0), *mem = F(1); const int* positions = (const int*)d_in[2];
    const float *mix_norm = F(3), *w_in = F(4), *w_out = F(18), *mem_q_norm = F(19), *mem_kv_norm = F(20), *wq = F(21), *wk = F(22), *wv = F(23), *wo = F(24),
                *moe_norm = F(25), *rgw = F(26), *rgb = F(27), *rew = F(28), *reb = F(29), *eg = F(30), *eu = F(31), *ed = F(32), *final_norm = F(33);
    (void)x; (void)mem; (void)positions; (void)mix_norm; (void)w_in; (void)w_out; (void)mem_kv_norm; (void)wq; (void)wk; (void)wv; (void)wo; (void)eg; (void)eu; (void)ed;
    char* ws = (char*)d_ws; hipStream_t st = stream;
    unsigned* ctl = (unsigned*)(ws + WS_CTL); float* rope = (float*)(ws + WS_ROPE);
    bf16_t *WinT = (bf16_t*)(ws + WS_WINT), *WoutT = (bf16_t*)(ws + WS_WOUTT), *WkvT = (bf16_t*)(ws + WS_WKVT), *WqBh = (bf16_t*)(ws + WS_WQBH), *WoTh = (bf16_t*)(ws + WS_WOTH),
           *BtS = (bf16_t*)(ws + WS_BTS), *BtO = (bf16_t*)(ws + WS_BTO), *MEMN = (bf16_t*)(ws + WS_MEMN), *KVh = (bf16_t*)(ws + WS_KVH), *WguT = (bf16_t*)(ws + WS_WGUT), *WdT = (bf16_t*)(ws + WS_WDT),
           *HN1 = (bf16_t*)(ws + WS_HN1), *Pm = (bf16_t*)(ws + WS_PM), *XH = (bf16_t*)(ws + WS_XH), *XN = (bf16_t*)(ws + WS_XN), *PR = (bf16_t*)(ws + WS_PR), *Qb = (bf16_t*)(ws + WS_QB),
           *Kb = (bf16_t*)(ws + WS_KB), *Vb = (bf16_t*)(ws + WS_VB), *O2 = (bf16_t*)(ws + WS_O2), *MIXED = (bf16_t*)(ws + WS_MIXED), *XG = (bf16_t*)(ws + WS_XG), *HID = (bf16_t*)(ws + WS_HID);
    float *H1 = (float*)(ws + WS_H1), *H2 = (float*)(ws + WS_H2), *S0 = (float*)(ws + WS_S0), *Y = (float*)(ws + WS_Y), *BONUS = (float*)(ws + WS_BONUS), *QKraw = (float*)(ws + WS_QKRAW),
          *Sraw = (float*)(ws + WS_SRAW), *YC = (float*)(ws + WS_YC), *GU = (float*)(ws + WS_GU);
    (void)WinT; (void)WoutT; (void)WkvT; (void)WqBh; (void)WoTh; (void)BtS; (void)BtO; (void)MEMN; (void)KVh; (void)WguT; (void)WdT; (void)Pm; (void)XN; (void)QKraw; (void)Sraw; (void)GU; (void)rope; (void)HID;
    int* asg_e = (int*)(ws + WS_ASG); int* asg_r = asg_e + 2 * SEQ; float* asg_w = (float*)(asg_r + 2 * SEQ);
    if (hipMemsetAsync(ctl, 0, CTL_ZERO_BYTES, st) != hipSuccess) { fprintf(stderr, "kernel_launch: memset failed\n"); return; }
    Args a{}; for (int i = 0; i < 34; ++i) a.in[i] = (const float*)d_in[i]; a.out = (float*)d_out; a.ws = (unsigned char*)d_ws;
    int li = 0;
    PrepW P{F(5), F(6), F(7), F(8), F(9), F(10), F(11), F(12), F(13)};
    int pend_lo = -1;
    for (int k = 0; k <= PH_N; ++k) {
        const bool naive = k < PH_N && ((MK_NAIVE_MASK >> k) & 1);
        if (k < PH_N && !naive) { if (pend_lo < 0) pend_lo = k; continue; }
        if (pend_lo >= 0) { launch_mk(st, a, pend_lo, k, li++); pend_lo = -1; }
        if (k == PH_N) break;
        switch (k) {
        case PH_PRO:
            hipLaunchKernelGGL(k_transpose, dim3(RWKV_COLS / 32, DM / 32, 1), dim3(256), 0, st, w_in, DM, IN_COLS, WinT, 0, 0, (size_t)0, 0);
            hipLaunchKernelGGL(k_transpose, dim3(2 * QK_COLS / 32, DM / 32, 1), dim3(256), 0, st, w_in + RWKV_COLS, DM, IN_COLS, WinT + (size_t)RWKV_COLS * DM, 1, 0, (size_t)0, 0);
            hipLaunchKernelGGL(k_transpose, dim3(1024 / 32, DM / 32, 1), dim3(256), 0, st, w_in + RWKV_COLS + 2 * QK_COLS, DM, IN_COLS, WinT + (size_t)(RWKV_COLS + 2 * QK_COLS) * DM, 0, 0, (size_t)0, 0);
            hipLaunchKernelGGL(k_transpose, dim3(DM / 32, DM / 32, 1), dim3(256), 0, st, w_out, DM, DM, WoutT, 0, 0, (size_t)0, 0);
            hipLaunchKernelGGL(k_transpose, dim3(DM / 32, DM / 32, 1), dim3(256), 0, st, wk, DM, DM, WkvT, 0, 0, (size_t)0, 0);
            hipLaunchKernelGGL(k_transpose, dim3(DM / 32, DM / 32, 1), dim3(256), 0, st, wv, DM, DM, WkvT + (size_t)DM * DM, 0, 0, (size_t)0, 0);
            hipLaunchKernelGGL(k_transpose, dim3(DM / 32, MEM_HD / 32, MEM_HEADS), dim3(256), 0, st, wo, MEM_HD, DM, WoTh, 0, 0, (size_t)MEM_HD * DM, 2048);
            hipLaunchKernelGGL(k_wqbh, dim3(DM * DM / 256), dim3(256), 0, st, wq, WqBh);
            hipLaunchKernelGGL(k_transpose, dim3(D_EXP / 32, DM / 32, N_EXP), dim3(256), 0, st, eg, DM, D_EXP, WguT, 2, 0, (size_t)DM * D_EXP, 2048);
            hipLaunchKernelGGL(k_transpose, dim3(D_EXP / 32, DM / 32, N_EXP), dim3(256), 0, st, eu, DM, D_EXP, WguT, 3, 0, (size_t)DM * D_EXP, 2048);
            hipLaunchKernelGGL(k_transpose, dim3(DM / 32, D_EXP / 32, N_EXP), dim3(256), 0, st, ed, D_EXP, DM, WdT, 0, 0, (size_t)DM * D_EXP, 2048);
            hipLaunchKernelGGL(k_rope_table, dim3(SEQ * 32 / 256), dim3(256), 0, st, positions, rope);
            hipLaunchKernelGGL(k_rmsnorm_bf16, dim3(SEQ), dim3(256), 0, st, x, mix_norm, XN);
            hipLaunchKernelGGL(k_rmsnorm_bf16, dim3(MEM_LEN), dim3(256), 0, st, mem, mem_kv_norm, MEMN);
            break;
        case PH_INPROJ:
            gemm(st, XN, DM, WinT, DM, SEQ, IN_COLS, DM, NEpiInProj{PR, QKraw, Vb});
            hipLaunchKernelGGL(k_rope_apply, dim3(SEQ), dim3(256), 0, st, QKraw, rope, Qb, Kb);
            for (int t = 0; t < 8; ++t) gemm(st, MEMN, DM, WkvT + (size_t)t * MEM_HD * DM, DM, MEM_LEN, MEM_HD, DM, NEpiBf{KVh + (size_t)t * MEM_LEN * MEM_HD, MEM_HD});
            break;
        case PH_MEMPRE:
            for (int h = 0; h < MEM_HEADS; ++h) {
                gemm(st, KVh + (size_t)h * MEM_LEN * MEM_HD, MEM_HD, WqBh + (size_t)h * DM * MEM_HD, MEM_HD, MEM_LEN, DM, MEM_HD, NEpiBf{BtS + (size_t)h * MEM_LEN * DM, DM});
                gemm(st, WoTh + (size_t)h * DM * MEM_HD, MEM_HD, KVh + (size_t)(4 + h) * MEM_LEN * MEM_HD, MEM_HD, DM, MEM_LEN, MEM_HD, NEpiBf{BtO + h * MEM_LEN, MEM_HEADS * MEM_LEN}); }
            break;
        case PH_LORA: break;
        case PH_SCANA: hipLaunchKernelGGL(k_prep, dim3(SEQ), dim3(256), 0, st, PR, P, S0, BONUS); break;
        case PH_SCANB: hipLaunchKernelGGL(k_scan, dim3(256), dim3(256), 0, st, S0, Y); break;
        case PH_SCANC: hipLaunchKernelGGL(k_rwkv_post, dim3(SEQ), dim3(256), 0, st, Y, S0, BONUS, F(14), F(15), MIXED); break;
        case PH_ATTN: hipLaunchKernelGGL(k_attn, dim3(SEQ / 64, 16, 4), dim3(64), 0, st, Qb, Kb, Vb, O2); break;
        case PH_POST:
            hipLaunchKernelGGL(k_diff_post, dim3(SEQ), dim3(256), 0, st, O2, F(16), F(17), MIXED);
            break;
        case PH_OUTPROJ: gemm(st, MIXED, DM, WoutT, DM, SEQ, DM, DM, NEpiResid{x, H1, DM}); break;
        case PH_HN1: hipLaunchKernelGGL(k_rmsnorm_bf16, dim3(SEQ), dim3(256), 0, st, H1, mem_q_norm, HN1); break;
        case PH_SCORES:
            gemm(st, HN1, DM, BtS, DM, SEQ, MEM_HEADS * MEM_LEN, DM, NEpiF32{Sraw, MEM_HEADS * MEM_LEN});
            hipLaunchKernelGGL(k_softmax_mem, dim3(SEQ), dim3(256), 0, st, Sraw, Pm);
            break;
        case PH_MEMOUT: gemm(st, Pm, MEM_HEADS * MEM_LEN, BtO, MEM_HEADS * MEM_LEN, SEQ, DM, MEM_HEADS * MEM_LEN, NEpiResid{H1, H2, DM}); break;
        case PH_ROUTER: hipLaunchKernelGGL(k_router, dim3(SEQ), dim3(256), 0, st, H2, moe_norm, rgw, rgb, rew, reb, XH, ctl, asg_e, asg_r, asg_w); break;
        case PH_GATHER:
            hipLaunchKernelGGL(k_moe_offsets, dim3(1), dim3(64), 0, st, ctl);
            hipLaunchKernelGGL(k_gather, dim3(SEQ), dim3(256), 0, st, XH, ctl, asg_e, asg_r, XG);
            break;
        case PH_GATEUP:
            gemm(st, XG, DM, WguT, DM, XG_ROWS, 2048, DM, NEpiF32{GU, 2048}, ctl, 2048);
            hipLaunchKernelGGL(k_silu_mul, dim3(XG_ROWS * 1024 / 256), dim3(256), 0, st, GU, ctl, HID);
            break;
        case PH_DOWN: gemm(st, HID, D_EXP, WdT, D_EXP, XG_ROWS, DM, D_EXP, NEpiF32{YC, DM}, ctl, 2048); break;
        case PH_FINAL: hipLaunchKernelGGL(k_final, dim3(SEQ), dim3(256), 0, st, H2, YC, ctl, asg_e, asg_r, asg_w, final_norm, (float*)d_out); break;
        }
    }
#if MK_PROBE >= 0
#if defined(MK_PROBE_VAR)
    a.pad = MK_PROBE_VAR;
#endif
    for (int r = 0; r < MK_PROBE_REPS; ++r) launch_mk(st, a, MK_PROBE, MK_PROBE + 1, li);
#endif
}
```

```cpp
#include <hip/hip_runtime.h>
#include <stdint.h>
#include <stdio.h>
#include <math.h>

typedef unsigned short bf16_t;
typedef float f32x4 __attribute__((ext_vector_type(4)));
typedef unsigned u32x4 __attribute__((ext_vector_type(4)));

#ifndef MK_NAIVE_MASK
#define MK_NAIVE_MASK 0
#endif
#ifndef MK_PROBE
#define MK_PROBE -1
#endif
#ifndef MK_PROBE_REPS
#define MK_PROBE_REPS 4
#endif

constexpr int SEQ = 8192, DM = 2048, RW = 1024, NH_R = 16, HD_R = 64;
constexpr int RWKV_COLS = 3328, IN_COLS = 6400, QK_COLS = 1024;
constexpr int MEM_LEN = 256, MEM_HEADS = 4, MEM_HD = 512;
constexpr int N_GROUPS = 8, EPG = 8, N_EXP = 64, D_EXP = 1024;
constexpr int XG_ROWS = 32768;
constexpr float NORM_EPS = 1e-6f, LNX_EPS = 64e-5f, SUBLN_EPS = 1e-5f;
constexpr float LAMBDA_INIT = 0.2f;
constexpr float C2 = 0.125f * 1.4426950408889634f;

constexpr size_t MiB = 1u << 20;
constexpr size_t WS_CTL = 0, WS_ROPE = 1 * MiB, WS_WINT = 4 * MiB, WS_WOUTT = 29 * MiB, WS_WKVT = 37 * MiB, WS_WQBH = 53 * MiB, WS_WOTH = 61 * MiB,
                 WS_BTS = 69 * MiB, WS_BTO = 73 * MiB, WS_MEMN = 77 * MiB, WS_KVH = 78 * MiB, WS_ASG = 80 * MiB, WS_BONUS = 81 * MiB,
                 WS_WGUT = 96 * MiB, WS_WDT = 608 * MiB, WS_H1 = 864 * MiB, WS_HN1 = 928 * MiB, WS_PM = 960 * MiB, WS_H2 = 976 * MiB, WS_XH = 1040 * MiB,
                 WS_XN = 1072 * MiB, WS_PR = 1104 * MiB, WS_QB = 1156 * MiB, WS_KB = 1172 * MiB, WS_VB = 1188 * MiB, WS_S0 = 1204 * MiB  ,
                 WS_Y = 1428 * MiB, WS_O2 = 1460 * MiB, WS_MIXED = 1492 * MiB, WS_END = 1524 * MiB;
constexpr size_t WS_XL = WS_S0, WS_WLORA = WS_S0 + 4 * MiB, WS_LG = WS_S0 + 6 * MiB, WS_RPP = WS_S0 + 54 * MiB, WS_YG = WS_S0 + 70 * MiB, WS_PT = WS_S0 + 102 * MiB, WS_QT = WS_S0 + 118 * MiB,
                 WS_SC = WS_S0 + 150 * MiB, WS_EG = WS_S0 + 166 * MiB, WS_EBV = WS_S0 + 182 * MiB;
constexpr size_t WS_PSQ = 84 * MiB;
constexpr size_t WS_RT = 82 * MiB, WS_RS = 83 * MiB;
constexpr size_t WS_QKRAW = WS_H2, WS_SRAW = WS_XH;
#if MK_PROBE >= 0
constexpr size_t WS_XG = 1524 * MiB, WS_HID = 1652 * MiB, WS_YC = 1716 * MiB, WS_GU = WS_YC, WS_NEED = 1972 * MiB;
#else
constexpr size_t WS_XG = 1072 * MiB, WS_HID = 1200 * MiB, WS_YC = 1264 * MiB, WS_GU = WS_YC, WS_NEED = WS_END;
#endif
constexpr size_t CTL_ZERO_BYTES = 1 * MiB;
constexpr int CW_CNT = 0, CW_BASE = 64, CW_NT = 160, CW_TILEE = 192;
constexpr int CW_TMO = 512, CW_CODE = 513;
constexpr int CW_AQ = 1024;
constexpr int CW_HIST = 65536;
constexpr int CW_BAR = 4096;

__device__ __forceinline__ float bf2f(bf16_t b) { return __uint_as_float((unsigned)b << 16); }
__device__ __forceinline__ bf16_t f2bf(float f) { unsigned u = __float_as_uint(f); return (bf16_t)((u + 0x7fffu + ((u >> 16) & 1u)) >> 16); }
__device__ __forceinline__ float sigmoidf_(float x) { return 1.f / (1.f + __expf(-x)); }
__host__ __device__ __forceinline__ int rope_phys(int d) { return d < 32 ? 8 * (d >> 2) + (d & 3) : 8 * ((d - 32) >> 2) + 4 + ((d - 32) & 3); }
__host__ __device__ __forceinline__ int row_map(int mode, int n) {
    return mode == 1 ? (n & ~63) + rope_phys(n & 63) : mode == 2 ? (n >> 7) * 256 + (n & 127) : mode == 3 ? (n >> 7) * 256 + 128 + (n & 127) : n; }

namespace pg8 {
#define PG8_LAS __attribute__((address_space(3)))
typedef unsigned short bf16_t;
typedef short bf16x8 __attribute__((ext_vector_type(8)));
typedef float f32x4 __attribute__((ext_vector_type(4)));
typedef unsigned u32x4 __attribute__((ext_vector_type(4)));
constexpr int BM = 256, BK = 64, HALF = 128, HTB = HALF * BK * 2  , STAGE_BYTES = 8 * HTB, NXCD = 8, WGM = 8;

__host__ __device__ __forceinline__ int lds_byte(int r, int c) { const int st = (r >> 4) * 2 + (c >> 5), rr = r & 15, cc = c & 31, ob = rr * 64 + cc * 2; return st * 1024 + (ob ^ (((ob >> 9) & 1) << 5)); }
__host__ __device__ __forceinline__ void stage_rc(int b, int& R, int& C) { const int st = b / 1024, sb = b % 1024, swz = sb ^ (((sb >> 9) & 1) << 5); R = (st >> 1) * 16 + swz / 64; C = (st & 1) * 32 + (swz % 64) / 2; }
__host__ __device__ __forceinline__ int perm32(int rho) { const int n = rho >> 4, i = rho & 15; return 8 * (i >> 2) + 4 * n + (i & 3); }

struct Unit { int pm, pn; };
struct Gemm { const bf16_t* A; const bf16_t* Bt; int M, N, K, lda, ldb; };

struct StaticOrder {
    int nM, nN, nwg, G, c;
    __host__ __device__ void init(int M, int N, int G_, int c_) { nM = M / BM; nN = N / BM; nwg = nM * nN; G = G_; c = c_; }
    __host__ __device__ bool next(int i, Unit& u) const {
        const long L = (long)i * G + c; if (L >= nwg) return false;
        int wgid = (int)L; { const int q = nwg / NXCD, r = nwg % NXCD, xcd = wgid % NXCD, off = wgid / NXCD; wgid = (xcd < r ? xcd * (q + 1) : r * (q + 1) + (xcd - r) * q) + off; }
        const int nig = WGM * nN, gid = wgid / nig, fm = gid * WGM, gsz = (nM - fm) < WGM ? (nM - fm) : WGM;
        u.pm = fm + ((wgid % nig) % gsz); u.pn = (wgid % nig) / gsz; return true;
    }
    __device__ __forceinline__ void a_ready(const Unit&) const {}
    __device__ __forceinline__ void done(const Unit&) const {}
};
__device__ __forceinline__ unsigned cvt_pk_bf16(float lo, float hi) { unsigned r; asm volatile("v_cvt_pk_bf16_f32 %0, %1, %2" : "=v"(r) : "v"(lo), "v"(hi)); return r; }
template <class Epi, class Sched, bool ALIGN_EPI = false, bool SP2 = false>
__device__ __forceinline__ void gemm_phase(PG8_LAS unsigned char* lds, const Gemm g, const Sched& S, const Epi& E) {
    const int tid = threadIdx.x, wid = __builtin_amdgcn_readfirstlane(tid >> 6), lane = tid & 63, wr = wid >> 2, wc = wid & 3, fr = lane & 15, fq = lane >> 4;
    const int K = g.K, nt = K / BK;
    unsigned voffA[2], voffB[2];
#pragma unroll
    for (int i = 0; i < 2; ++i) { int R, C; stage_rc(tid * 16 + i * 8192, R, C); const int Rb = Epi::PERM ? ((R & ~31) + perm32(R & 31)) : R;
        voffA[i] = (unsigned)(R * g.lda + C) * 2u; voffB[i] = (unsigned)(Rb * g.ldb + C) * 2u; }
    const size_t kstep = (size_t)(BK * 2);
    const size_t hstepA = (size_t)HALF * g.lda * 2, hstepB = (size_t)HALF * g.ldb * 2;
    const size_t tstepA = 2 * hstepA, tstepB = 2 * hstepB;
    const unsigned ldsw = (unsigned)wid * 1024u;
    const int aoff = lds_byte(wr * 64 + fr, fq * 8), boff = lds_byte(wc * 32 + fr, fq * 8);
#define PG8_SA(b, h) (((b) * 2 + (h)) * HTB)
#define PG8_SB(b, h) ((4 + (b) * 2 + (h)) * HTB)
#define PG8_STAGE(bufoff, gbase, voff) do { _Pragma("unroll") for (int _i = 0; _i < 2; ++_i) \
        __builtin_amdgcn_global_load_lds((const unsigned*)((const char*)(gbase) + (voff)[_i]), (PG8_LAS unsigned*)(lds + (bufoff) + ldsw + _i * 8192), 16, 0, 0); } while (0)
#define PG8_LDA(dst, b, h) do { _Pragma("unroll") for (int m = 0; m < 4; ++m) _Pragma("unroll") for (int k = 0; k < 2; ++k) dst[m][k] = *(const PG8_LAS bf16x8*)(lds + PG8_SA(b, h) + aoff + m * 2048 + k * 1024); } while (0)
#define PG8_LDB(dst, b, h) do { _Pragma("unroll") for (int n = 0; n < 2; ++n) _Pragma("unroll") for (int k = 0; k < 2; ++k) dst[n][k] = *(const PG8_LAS bf16x8*)(lds + PG8_SB(b, h) + boff + n * 2048 + k * 1024); } while (0)
#define PG8_MMA(ai, bj, At, Bt) do { __builtin_amdgcn_s_setprio(1); _Pragma("unroll") for (int m = 0; m < 4; ++m) _Pragma("unroll") for (int n = 0; n < 2; ++n) _Pragma("unroll") for (int k = 0; k < 2; ++k) \
        acc[ai][bj][m][n] = __builtin_amdgcn_mfma_f32_16x16x32_bf16(Bt[n][k], At[m][k], acc[ai][bj][m][n], 0, 0, 0); __builtin_amdgcn_s_setprio(0); } while (0)
#define PG8_WAIT_V(n) asm volatile("s_waitcnt vmcnt(" #n ")" ::: "memory")
#define PG8_WAIT_L(n) asm volatile("s_waitcnt lgkmcnt(" #n ")" ::: "memory")
#define PG8_BAR __builtin_amdgcn_s_barrier()
#define PG8_SCHED __builtin_amdgcn_sched_barrier(0)
    Unit cur, nxt; int ui = 0;
    if (!S.next(0, cur)) return;
    f32x4 acc[2][2][4][2];
#pragma unroll
    for (int a = 0; a < 2; ++a)
#pragma unroll
        for (int b = 0; b < 2; ++b)
#pragma unroll
            for (int m = 0; m < 4; ++m)
#pragma unroll
                for (int n = 0; n < 2; ++n) acc[a][b][m][n] = (f32x4){0.f, 0.f, 0.f, 0.f};
    bf16x8 At[4][2], B0[2][2], B1[2][2];
    const char* cA = (const char*)g.A + (size_t)cur.pm * tstepA; const char* cB = (const char*)g.Bt + (size_t)cur.pn * tstepB;
    S.a_ready(cur);
    if constexpr (SP2) {
        PG8_STAGE(PG8_SB(0, 0), cB, voffB); PG8_STAGE(PG8_SB(0, 1), cB + hstepB, voffB); PG8_STAGE(PG8_SA(0, 0), cA, voffA); PG8_STAGE(PG8_SA(0, 1), cA + hstepA, voffA);
        if (wr == 1) PG8_BAR;
        PG8_WAIT_V(2); PG8_BAR;
        PG8_STAGE(PG8_SB(1, 0), cB + kstep, voffB); PG8_STAGE(PG8_SA(1, 0), cA + kstep, voffA); PG8_STAGE(PG8_SB(1, 1), cB + hstepB + kstep, voffB);
        PG8_WAIT_V(6); PG8_BAR;
    } else {
        PG8_STAGE(PG8_SB(0, 0), cB, voffB); PG8_STAGE(PG8_SA(0, 0), cA, voffA); PG8_STAGE(PG8_SB(0, 1), cB + hstepB, voffB); PG8_STAGE(PG8_SA(0, 1), cA + hstepA, voffA);
        if (wr == 1) PG8_BAR;
        PG8_WAIT_V(4); PG8_BAR;
        PG8_STAGE(PG8_SB(1, 0), cB + kstep, voffB); PG8_STAGE(PG8_SA(1, 0), cA + kstep, voffA); PG8_STAGE(PG8_SB(1, 1), cB + hstepB + kstep, voffB);
        PG8_WAIT_V(6); PG8_BAR;
    }
    for (;;) {
        const bool has_next = S.next(ui + 1, nxt);
        const char* nA = has_next ? (const char*)g.A + (size_t)nxt.pm * tstepA : cA; const char* nB = has_next ? (const char*)g.Bt + (size_t)nxt.pn * tstepB : cB;
        for (int t = 0; t < nt; t += 2) {
            const bool last = (t == nt - 2);
            const char* a1 = cA + (size_t)(t + 1) * kstep;
            const char* a2 = last ? nA : cA + (size_t)(t + 2) * kstep; const char* b2 = last ? nB : cB + (size_t)(t + 2) * kstep;
            const char* a3 = a2 + kstep; const char* b3 = b2 + kstep;
            if (last && has_next) S.a_ready(nxt);
            if constexpr (SP2) {
            PG8_LDB(B0, 0, 0); PG8_LDB(B1, 0, 1); PG8_SCHED; PG8_LDA(At, 0, 0); PG8_STAGE(PG8_SA(1, 1), a1 + hstepA, voffA);
            PG8_WAIT_V(8); PG8_WAIT_L(0); PG8_BAR; PG8_MMA(0, 0, At, B0); PG8_MMA(0, 1, At, B1); PG8_BAR; PG8_SCHED;
            PG8_LDA(At, 0, 1); PG8_STAGE(PG8_SB(0, 0), b2, voffB); PG8_STAGE(PG8_SB(0, 1), b2 + hstepB, voffB); PG8_STAGE(PG8_SA(0, 0), a2, voffA);
            PG8_WAIT_V(8); PG8_WAIT_L(0); PG8_BAR; PG8_MMA(1, 0, At, B0); PG8_MMA(1, 1, At, B1); PG8_BAR; PG8_SCHED;
            PG8_LDB(B0, 1, 0); PG8_LDB(B1, 1, 1); PG8_SCHED; PG8_LDA(At, 1, 0); PG8_STAGE(PG8_SA(0, 1), a2 + hstepA, voffA);
            PG8_WAIT_V(8); PG8_WAIT_L(0); PG8_BAR; PG8_MMA(0, 0, At, B0); PG8_MMA(0, 1, At, B1); PG8_BAR; PG8_SCHED;
            PG8_LDA(At, 1, 1); PG8_STAGE(PG8_SB(1, 0), b3, voffB); PG8_STAGE(PG8_SB(1, 1), b3 + hstepB, voffB); PG8_STAGE(PG8_SA(1, 0), a3, voffA);
            PG8_WAIT_V(8); PG8_WAIT_L(0); PG8_BAR; PG8_MMA(1, 0, At, B0); PG8_MMA(1, 1, At, B1); PG8_BAR; PG8_SCHED;
            } else {
            PG8_LDB(B0, 0, 0); PG8_SCHED; PG8_LDA(At, 0, 0); PG8_STAGE(PG8_SA(1, 1), a1 + hstepA, voffA);
            PG8_WAIT_L(8); PG8_BAR; PG8_WAIT_L(0); PG8_MMA(0, 0, At, B0); PG8_BAR; PG8_SCHED;
            PG8_LDB(B1, 0, 1); PG8_STAGE(PG8_SB(0, 0), b2, voffB);
            PG8_BAR; PG8_WAIT_L(0); PG8_MMA(0, 1, At, B1); PG8_BAR;
            PG8_LDA(At, 0, 1); PG8_STAGE(PG8_SA(0, 0), a2, voffA);
            PG8_BAR; PG8_WAIT_L(0); PG8_MMA(1, 0, At, B0); PG8_BAR; PG8_SCHED;
            PG8_STAGE(PG8_SB(0, 1), b2 + hstepB, voffB);
            PG8_WAIT_V(6); PG8_BAR; PG8_MMA(1, 1, At, B1); PG8_BAR;
            PG8_LDB(B0, 1, 0); PG8_SCHED; PG8_LDA(At, 1, 0); PG8_STAGE(PG8_SA(0, 1), a2 + hstepA, voffA);
            PG8_WAIT_L(8); PG8_BAR; PG8_WAIT_L(0); PG8_MMA(0, 0, At, B0); PG8_BAR; PG8_SCHED;
            PG8_LDB(B1, 1, 1); PG8_STAGE(PG8_SB(1, 0), b3, voffB);
            PG8_BAR; PG8_WAIT_L(0); PG8_MMA(0, 1, At, B1); PG8_BAR;
            PG8_LDA(At, 1, 1); PG8_STAGE(PG8_SA(1, 0), a3, voffA);
            PG8_BAR; PG8_WAIT_L(0); PG8_MMA(1, 0, At, B0); PG8_BAR; PG8_SCHED;
            PG8_STAGE(PG8_SB(1, 1), b3 + hstepB, voffB);
            PG8_WAIT_V(6); PG8_BAR; PG8_MMA(1, 1, At, B1); PG8_BAR;
            }
        }
        if constexpr (ALIGN_EPI) { if (wr == 0) PG8_BAR; }
        if constexpr (!Epi::AFTER_DRAIN) { E(acc, cur, wr, wc, fr, fq); S.done(cur); }
        if (!has_next) break;
#pragma unroll
        for (int a = 0; a < 2; ++a)
#pragma unroll
            for (int b = 0; b < 2; ++b)
#pragma unroll
                for (int m = 0; m < 4; ++m)
#pragma unroll
                    for (int n = 0; n < 2; ++n) acc[a][b][m][n] = (f32x4){0.f, 0.f, 0.f, 0.f};
        cur = nxt; cA = nA; cB = nB; ++ui;
        if constexpr (ALIGN_EPI) { if (wr == 1) PG8_BAR; }
    }
    PG8_WAIT_V(0);
    if constexpr (!ALIGN_EPI) { if (wr == 0) PG8_BAR; }
    PG8_BAR;
    if constexpr (Epi::AFTER_DRAIN) { E.fused(acc, cur, wr, wc, fr, fq, lds, wid, lane); S.done(cur); }
#undef PG8_SA
#undef PG8_SB
#undef PG8_STAGE
#undef PG8_LDA
#undef PG8_LDB
#undef PG8_MMA
#undef PG8_WAIT_V
#undef PG8_WAIT_L
#undef PG8_BAR
#undef PG8_SCHED
}
}
namespace pg8 {
__device__ __forceinline__ u32x4 pack8(const f32x4 v0, const f32x4 v1) { u32x4 w; w.x = cvt_pk_bf16(v0[0], v0[1]); w.y = cvt_pk_bf16(v0[2], v0[3]); w.z = cvt_pk_bf16(v1[0], v1[1]); w.w = cvt_pk_bf16(v1[2], v1[3]); return w; }
struct EpiInProj {
    static constexpr bool PERM = true, AFTER_DRAIN = false;
    bf16_t *PR, *Qb, *Kb, *Vb; const float* rope;
    __device__ __forceinline__ void operator()(const f32x4 (&acc)[2][2][4][2], const Unit& u, int wr, int wc, int fr, int fq) const {
        const int row0 = u.pm * BM + wr * 64 + fr, cl = wc * 32 + 8 * fq;
        if (u.pn < 13 || u.pn >= 21) {
            bf16_t* base; int ldc, colt;
            if (u.pn < 13) { base = PR; ldc = RWKV_COLS; colt = u.pn * 256; } else { base = Vb; ldc = 1024; colt = (u.pn - 21) * 256; }
#pragma unroll
            for (int ai = 0; ai < 2; ++ai)
#pragma unroll
                for (int m = 0; m < 4; ++m) { bf16_t* rowp = base + (size_t)(row0 + ai * HALF + m * 16) * ldc + colt + cl;
#pragma unroll
                    for (int bj = 0; bj < 2; ++bj) *(u32x4*)(rowp + bj * HALF) = pack8(acc[ai][bj][m][0], acc[ai][bj][m][1]); }
        } else {
            const bool isq = u.pn < 17; bf16_t* base = isq ? Qb : Kb; const int colt = (u.pn - (isq ? 13 : 17)) * 256; const float sc = isq ? C2 : 1.f;
            const int j0 = 16 * (wc & 1) + 4 * fq;
#pragma unroll
            for (int ai = 0; ai < 2; ++ai)
#pragma unroll
                for (int m = 0; m < 4; ++m) { const int row = row0 + ai * HALF + m * 16;
                    const f32x4 t0 = *(const f32x4*)(rope + ((size_t)row * 32 + j0) * 2), t1 = *(const f32x4*)(rope + ((size_t)row * 32 + j0) * 2 + 4);
                    const f32x4 cs = {t0[0], t0[2], t1[0], t1[2]}, sn = {t0[1], t0[3], t1[1], t1[3]};
                    bf16_t* rowp = base + (size_t)row * 1024 + colt + cl;
#pragma unroll
                    for (int bj = 0; bj < 2; ++bj) { const f32x4 x1 = acc[ai][bj][m][0], x2 = acc[ai][bj][m][1];
                        const f32x4 lo = (x1 * cs - x2 * sn) * sc, hi = (x1 * sn + x2 * cs) * sc;
                        *(u32x4*)(rowp + bj * HALF) = pack8(lo, hi); } }
        }
    }
};
struct EpiKV {
    static constexpr bool PERM = true, AFTER_DRAIN = false;
    bf16_t* KVh;
    __device__ __forceinline__ void operator()(const f32x4 (&acc)[2][2][4][2], const Unit& u, int wr, int wc, int fr, int fq) const {
        bf16_t* base = KVh + (size_t)(u.pn >> 1) * (MEM_LEN * MEM_HD) + (u.pn & 1) * 256 + wc * 32 + 8 * fq;
#pragma unroll
        for (int ai = 0; ai < 2; ++ai)
#pragma unroll
            for (int m = 0; m < 4; ++m) { bf16_t* rowp = base + (size_t)(wr * 64 + fr + ai * HALF + m * 16) * MEM_HD;
#pragma unroll
                for (int bj = 0; bj < 2; ++bj) *(u32x4*)(rowp + bj * HALF) = pack8(acc[ai][bj][m][0], acc[ai][bj][m][1]); }
    }
};
struct EpiBfGen {
    static constexpr bool PERM = true, AFTER_DRAIN = false;
    bf16_t* C; int ldc, pm_mask, pn_mask, pn_sub;
    __device__ __forceinline__ void operator()(const f32x4 (&acc)[2][2][4][2], const Unit& u, int wr, int wc, int fr, int fq) const {
        bf16_t* base = C + (size_t)((u.pm & pm_mask) * BM + wr * 64 + fr) * ldc + ((u.pn - pn_sub) & pn_mask) * BM + wc * 32 + 8 * fq;
#pragma unroll
        for (int ai = 0; ai < 2; ++ai)
#pragma unroll
            for (int m = 0; m < 4; ++m) { bf16_t* rowp = base + (size_t)(ai * HALF + m * 16) * ldc;
#pragma unroll
                for (int bj = 0; bj < 2; ++bj) *(u32x4*)(rowp + bj * HALF) = pack8(acc[ai][bj][m][0], acc[ai][bj][m][1]); }
    }
};
struct EpiBfGenCS {
    static constexpr bool PERM = true, AFTER_DRAIN = false;
    bf16_t* C; int ldc, pm_mask, pn_mask, pn_sub; const float* cs;
    __device__ __forceinline__ void operator()(const f32x4 (&acc)[2][2][4][2], const Unit& u, int wr, int wc, int fr, int fq) const {
        const int colb = ((u.pn - pn_sub) & pn_mask) * BM + wc * 32 + 8 * fq;
        bf16_t* base = C + (size_t)((u.pm & pm_mask) * BM + wr * 64 + fr) * ldc + colb;
        const f32x4 sa0 = *(const f32x4*)(cs + colb), sa1 = *(const f32x4*)(cs + colb + 4), sb0 = *(const f32x4*)(cs + colb + HALF), sb1 = *(const f32x4*)(cs + colb + HALF + 4);
#pragma unroll
        for (int ai = 0; ai < 2; ++ai)
#pragma unroll
            for (int m = 0; m < 4; ++m) { bf16_t* rowp = base + (size_t)(ai * HALF + m * 16) * ldc;
                *(u32x4*)(rowp) = pack8(acc[ai][0][m][0] * sa0, acc[ai][0][m][1] * sa1); *(u32x4*)(rowp + HALF) = pack8(acc[ai][1][m][0] * sb0, acc[ai][1][m][1] * sb1); }
    }
};
struct EpiResid {
    static constexpr bool PERM = false, AFTER_DRAIN = false;
    const float* base; float* out;
    __device__ __forceinline__ void operator()(const f32x4 (&acc)[2][2][4][2], const Unit& u, int wr, int wc, int fr, int fq) const {
        const int row0 = u.pm * BM + wr * 64 + fr, col0 = u.pn * BM + wc * 32 + 4 * fq;
#pragma unroll
        for (int ai = 0; ai < 2; ++ai)
#pragma unroll
            for (int m = 0; m < 4; ++m) { const size_t off = (size_t)(row0 + ai * HALF + m * 16) * DM + col0;
#pragma unroll
                for (int bj = 0; bj < 2; ++bj)
#pragma unroll
                    for (int n = 0; n < 2; ++n) *(f32x4*)(out + off + bj * HALF + n * 16) = *(const f32x4*)(base + off + bj * HALF + n * 16) + acc[ai][bj][m][n]; }
    }
};
struct EpiResidSq {
    static constexpr bool PERM = true, AFTER_DRAIN = false;
    const float* base; float* out; bf16_t* outb; float* psq;
    __device__ __forceinline__ void operator()(const f32x4 (&acc)[2][2][4][2], const Unit& u, int wr, int wc, int fr, int fq) const {
        const int row0 = u.pm * BM + wr * 64 + fr, col0 = u.pn * BM + wc * 32 + 8 * fq;
#pragma unroll
        for (int ai = 0; ai < 2; ++ai)
#pragma unroll
            for (int m = 0; m < 4; ++m) { const int row = row0 + ai * HALF + m * 16; const size_t off = (size_t)row * DM + col0; float s = 0.f;
#pragma unroll
                for (int bj = 0; bj < 2; ++bj) { const f32x4 v0 = *(const f32x4*)(base + off + bj * HALF) + acc[ai][bj][m][0], v1 = *(const f32x4*)(base + off + bj * HALF + 4) + acc[ai][bj][m][1];
                    *(f32x4*)(out + off + bj * HALF) = v0; *(f32x4*)(out + off + bj * HALF + 4) = v1; *(u32x4*)(outb + off + bj * HALF) = pack8(v0, v1);
                    s += ((v0[0] * v0[0] + v0[1] * v0[1]) + (v0[2] * v0[2] + v0[3] * v0[3])) + ((v1[0] * v1[0] + v1[1] * v1[1]) + (v1[2] * v1[2] + v1[3] * v1[3])); }
                s += __shfl_xor(s, 16); s += __shfl_xor(s, 32);
                if (fq == 0) psq[(size_t)row * 32 + u.pn * 4 + wc] = s; }
    }
};
struct EpiSoftmax {
    static constexpr bool PERM = true, AFTER_DRAIN = true;
    bf16_t* P; float scale_log2e;
    __device__ __forceinline__ void fused(f32x4 (&acc)[2][2][4][2], const Unit& u, int wr, int wc, int fr, int fq, PG8_LAS unsigned char* lds, int wid, int lane) const {
        PG8_LAS float* Pm = (PG8_LAS float*)lds;
        PG8_LAS float* Ps = (PG8_LAS float*)(lds + 4096);
        PG8_LAS float* Rs = (PG8_LAS float*)(lds + 8192);
        { const float* psq = (const float*)((const unsigned char*)P + ((long)WS_PSQ - (long)WS_PM));
          const int t_ = wid * 64 + lane, r_ = t_ >> 1, hf = t_ & 1; const float* pp = psq + (size_t)(u.pm * BM + r_) * 32 + hf * 16; float s = 0.f;
#pragma unroll
          for (int j = 0; j < 4; ++j) { const f32x4 v = *(const f32x4*)(pp + 4 * j); s += (v[0] + v[1]) + (v[2] + v[3]); }
          s += __shfl_xor(s, 1);
          if (!hf) Rs[r_] = rsqrtf(s * (1.f / DM) + NORM_EPS); }
#pragma unroll
        for (int ai = 0; ai < 2; ++ai)
#pragma unroll
            for (int m = 0; m < 4; ++m) { float mx = -3.0e38f;
#pragma unroll
                for (int bj = 0; bj < 2; ++bj)
#pragma unroll
                    for (int n = 0; n < 2; ++n) { acc[ai][bj][m][n] = acc[ai][bj][m][n] * scale_log2e; const f32x4 x = acc[ai][bj][m][n]; mx = fmaxf(mx, fmaxf(fmaxf(x[0], x[1]), fmaxf(x[2], x[3]))); }
                mx = fmaxf(mx, __shfl_xor(mx, 16)); mx = fmaxf(mx, __shfl_xor(mx, 32));
                if (fq == 0) Pm[(ai * HALF + wr * 64 + m * 16 + fr) * 4 + wc] = mx; }
        asm volatile("s_waitcnt lgkmcnt(0)" ::: "memory"); __builtin_amdgcn_s_barrier(); asm volatile("" ::: "memory");
#pragma unroll
        for (int ai = 0; ai < 2; ++ai)
#pragma unroll
            for (int m = 0; m < 4; ++m) { const int r = ai * HALF + wr * 64 + m * 16 + fr; const f32x4 pm4 = *(const PG8_LAS f32x4*)(Pm + r * 4);
                const float mx = fmaxf(fmaxf(pm4[0], pm4[1]), fmaxf(pm4[2], pm4[3])), rsr = Rs[r]; float s = 0.f;
#pragma unroll
                for (int bj = 0; bj < 2; ++bj)
#pragma unroll
                    for (int n = 0; n < 2; ++n) { f32x4 x = acc[ai][bj][m][n];
#pragma unroll
                        for (int i = 0; i < 4; ++i) x[i] = __builtin_amdgcn_exp2f((x[i] - mx) * rsr);
                        acc[ai][bj][m][n] = x; s += (x[0] + x[1]) + (x[2] + x[3]); }
                s += __shfl_xor(s, 16); s += __shfl_xor(s, 32);
                if (fq == 0) Ps[r * 4 + wc] = s; }
        asm volatile("s_waitcnt lgkmcnt(0)" ::: "memory"); __builtin_amdgcn_s_barrier(); asm volatile("" ::: "memory");
        bf16_t* base = P + (size_t)(u.pm * BM) * 1024 + u.pn * BM + wc * 32 + 8 * fq;
#pragma unroll
        for (int ai = 0; ai < 2; ++ai)
#pragma unroll
            for (int m = 0; m < 4; ++m) { const int r = ai * HALF + wr * 64 + m * 16 + fr; const f32x4 ps4 = *(const PG8_LAS f32x4*)(Ps + r * 4);
                const float inv = 1.0f / ((ps4[0] + ps4[1]) + (ps4[2] + ps4[3]));
#pragma unroll
                for (int bj = 0; bj < 2; ++bj) *(u32x4*)(base + (size_t)r * 1024 + bj * HALF) = pack8(acc[ai][bj][m][0] * inv, acc[ai][bj][m][1] * inv); }
    }
};
struct EpiGateUp {
    static constexpr bool PERM = true, AFTER_DRAIN = false;
    bf16_t* HID;
    __device__ __forceinline__ void operator()(const f32x4 (&acc)[2][2][4][2], const Unit& u, int wr, int wc, int fr, int fq) const {
        bf16_t* base = HID + (size_t)(u.pm * BM + wr * 64 + fr) * D_EXP + (u.pn & 7) * HALF + wc * 32 + 8 * fq;
#pragma unroll
        for (int ai = 0; ai < 2; ++ai)
#pragma unroll
            for (int m = 0; m < 4; ++m) { f32x4 h[2];
#pragma unroll
                for (int n = 0; n < 2; ++n) { const f32x4 gt = acc[ai][0][m][n], up = acc[ai][1][m][n];
#pragma unroll
                    for (int i = 0; i < 4; ++i) h[n][i] = gt[i] * __builtin_amdgcn_rcpf(1.0f + __builtin_amdgcn_exp2f(-1.4426950408889634f * gt[i])) * up[i]; }
                *(u32x4*)(base + (size_t)(ai * HALF + m * 16) * D_EXP) = pack8(h[0], h[1]); }
    }
};
struct EpiYC {
    static constexpr bool PERM = false, AFTER_DRAIN = false;
    float* YC;
    __device__ __forceinline__ void operator()(const f32x4 (&acc)[2][2][4][2], const Unit& u, int wr, int wc, int fr, int fq) const {
        float* base = YC + (size_t)(u.pm * BM + wr * 64 + fr) * DM + (u.pn & 7) * BM + wc * 32 + 4 * fq;
#pragma unroll
        for (int ai = 0; ai < 2; ++ai)
#pragma unroll
            for (int m = 0; m < 4; ++m)
#pragma unroll
                for (int bj = 0; bj < 2; ++bj)
#pragma unroll
                    for (int n = 0; n < 2; ++n) *(f32x4*)(base + (size_t)(ai * HALF + m * 16) * DM + bj * HALF + n * 16) = acc[ai][bj][m][n];
    }
};
struct HeadOrderS { int G, c;
    __device__ __forceinline__ bool next(int i, Unit& u) const { const int L = i * G + c; if (L >= 32) return false; u.pm = L >> 3; u.pn = L; return true; }
    __device__ __forceinline__ void a_ready(const Unit&) const {} __device__ __forceinline__ void done(const Unit&) const {} };
struct HeadOrderO { int G, c;
    __device__ __forceinline__ bool next(int i, Unit& u) const { const int L = i * G + c; if (L >= 32) return false; u.pm = L; u.pn = 4 + (L >> 3); return true; }
    __device__ __forceinline__ void a_ready(const Unit&) const {} __device__ __forceinline__ void done(const Unit&) const {} };
struct MoeOrder { const unsigned* ctl; int G, c;
    __device__ __forceinline__ bool next(int i, Unit& u) const { const int L = i * G + c;
        const int nt = (int)__hip_atomic_load(ctl + CW_NT, __ATOMIC_RELAXED, __HIP_MEMORY_SCOPE_AGENT); if (L >= nt * 8) return false;
        u.pm = L >> 3; u.pn = (int)__hip_atomic_load(ctl + CW_TILEE + u.pm, __ATOMIC_RELAXED, __HIP_MEMORY_SCOPE_AGENT) * 8 + (L & 7); return true; }
    __device__ __forceinline__ void a_ready(const Unit&) const {} __device__ __forceinline__ void done(const Unit&) const {} };
}

#include <hip/hip_bf16.h>
#include <cmath>
namespace attn_body {
using bf16=__hip_bfloat16;
using bf16x8=__attribute__((ext_vector_type(8)))short;
using s16x4=__attribute__((ext_vector_type(4)))short;
using f32x16=__attribute__((ext_vector_type(16)))float;
using u32x4=__attribute__((ext_vector_type(4)))unsigned;
constexpr int BATCH=2,NHEAD=16,SEQ=8192,D=64,DM=NHEAD*D;
constexpr int NW=8,QBLK=32,QB=QBLK*NW,KVBLK=64,NQB=SEQ/QB;
constexpr int ATTN_PITCH=DM, ATTN_UNIT_ROWS=QB;
__device__ __forceinline__ int crow(int r,int hi){return (r&3)+8*(r>>2)+4*hi;}
#define SBAR() __builtin_amdgcn_sched_barrier(0)
__device__ __forceinline__ void cmask(f32x16&p0,f32x16&p1,int jb,int qrel,int hi){
  const float NEG=-INFINITY; int kb=64*jb+4*hi;
  #pragma unroll
  for(int r=0;r<16;++r){int kv=kb+(r&3)+8*(r>>2); if(kv>qrel)p0[r]=NEG; if(kv+32>qrel)p1[r]=NEG;}
}

constexpr int NSLOT=3, SLOTB=8192;
constexpr int LDS_K=0, LDS_V=NSLOT*SLOTB, LDS_WS=2*NSLOT*SLOTB, LDS_OST=LDS_WS+NW*64*4, LDS_BYTES=LDS_OST+NW*4096;
constexpr float C2=0.125f*1.4426950408889634f;
__device__ __forceinline__ void glds16(const void*gsrc,unsigned lds_dst){unsigned keep;
  asm volatile("s_mov_b32 %0, m0\n\ts_mov_b32 m0, %2\n\ts_nop 0\n\tglobal_load_lds_dwordx4 %1, off\n\ts_mov_b32 m0, %0":"=&s"(keep):"v"(gsrc),"s"(lds_dst):"memory");}
__device__ __forceinline__ float max3f(float a,float b,float c){float r;asm("v_max3_f32 %0, %1, %2, %3":"=v"(r):"v"(a),"v"(b),"v"(c));return r;}
__device__ __forceinline__ float max2f(float a,float b){float r;asm("v_max_f32_e32 %0, %1, %2":"=v"(r):"v"(a),"v"(b));return r;}
__device__ __forceinline__ float fadd_s(float a,float b){float r;asm("v_add_f32_e32 %0, %1, %2":"=v"(r):"v"(a),"v"(b));return r;}
__device__ __forceinline__ float fsub_s(float a,float b){float r;asm("v_sub_f32_e32 %0, %1, %2":"=v"(r):"v"(a),"v"(b));return r;}
typedef float f32x2_t __attribute__((ext_vector_type(2))); typedef __bf16 bf16x2_t __attribute__((ext_vector_type(2)));
__device__ __forceinline__ unsigned cvtpk_s(float lo,float hi){f32x2_t v={lo,hi};bf16x2_t b=__builtin_convertvector(v,bf16x2_t);return __builtin_bit_cast(unsigned,b);}
#define WAIT_BAR(N) asm volatile("s_waitcnt vmcnt(" #N ") lgkmcnt(0)\n\ts_barrier":::"memory")

__device__ __forceinline__ void qkt(f32x16&p0,f32x16&p1,const char*Kslot,const bf16x8*qr,const f32x16&negm,int r32,int hi){
  const char*kb=Kslot+hi*1024+r32*16;
  #pragma unroll
  for(int d0=0;d0<4;++d0){
    const bf16x8 b0=*reinterpret_cast<const bf16x8*>(kb+d0*2048);
    const bf16x8 b1=*reinterpret_cast<const bf16x8*>(kb+d0*2048+512);
    if(d0==0){p0=__builtin_amdgcn_mfma_f32_32x32x16_bf16(b0,qr[0],negm,0,0,0);p1=__builtin_amdgcn_mfma_f32_32x32x16_bf16(b1,qr[0],negm,0,0,0);}
    else{p0=__builtin_amdgcn_mfma_f32_32x32x16_bf16(b0,qr[d0],p0,0,0,0);p1=__builtin_amdgcn_mfma_f32_32x32x16_bf16(b1,qr[d0],p1,0,0,0);}}
}
typedef __attribute__((address_space(3))) const char* lds_cptr;
typedef short v4i16_t __attribute__((ext_vector_type(4)));
__device__ __forceinline__ void kload8(bf16x8*kf,lds_cptr kp){
  kf[0]=*(const __attribute__((address_space(3))) bf16x8*)(kp);      kf[1]=*(const __attribute__((address_space(3))) bf16x8*)(kp+512);
  kf[2]=*(const __attribute__((address_space(3))) bf16x8*)(kp+2048); kf[3]=*(const __attribute__((address_space(3))) bf16x8*)(kp+2560);
  kf[4]=*(const __attribute__((address_space(3))) bf16x8*)(kp+4096); kf[5]=*(const __attribute__((address_space(3))) bf16x8*)(kp+4608);
  kf[6]=*(const __attribute__((address_space(3))) bf16x8*)(kp+6144); kf[7]=*(const __attribute__((address_space(3))) bf16x8*)(kp+6656);
}
__device__ __forceinline__ void kload2(bf16x8*kf,lds_cptr kp,int j){ kf[2*j]=*(const __attribute__((address_space(3))) bf16x8*)(kp+j*2048); kf[2*j+1]=*(const __attribute__((address_space(3))) bf16x8*)(kp+j*2048+512); }
__device__ __forceinline__ s16x4 vtr(lds_cptr p){ return __builtin_bit_cast(s16x4,__builtin_amdgcn_ds_read_tr16_b64_v4i16((__attribute__((address_space(3))) v4i16_t*)p)); }
__device__ __forceinline__ float rowmax(const f32x16&p0,const f32x16&p1){
  float a=max3f(p0[0],p0[1],p1[0]),b=max3f(p0[2],p0[3],p1[1]);a=max3f(a,p1[2],p1[3]);
  #pragma unroll
  for(int r=4;r<16;r+=4){a=max3f(a,p0[r],p0[r+1]);b=max3f(b,p0[r+2],p0[r+3]);a=max3f(a,p1[r],p1[r+1]);b=max3f(b,p1[r+2],p1[r+3]);}
  const float m=max2f(a,b);
  auto rr=__builtin_amdgcn_permlane32_swap(__float_as_uint(m),__float_as_uint(m),false,false);
  return max2f(__uint_as_float(rr[0]),__uint_as_float(rr[1]));
}
__device__ __forceinline__ void pv(f32x16*o,int vb,bf16x8 pa0,bf16x8 pa1,bf16x8 pa2,bf16x8 pa3){
  #pragma unroll
  for(int d0=0;d0<2;++d0){s16x4 lo[4],hi[4];
    #pragma unroll
    for(int ks=0;ks<4;++ks){
      asm volatile("ds_read_b64_tr_b16 %0,%1 offset:%c2":"=&v"(lo[ks]):"v"(vb),"i"(d0*4096+ks*1024):"memory");
      asm volatile("ds_read_b64_tr_b16 %0,%1 offset:%c2":"=&v"(hi[ks]):"v"(vb),"i"(d0*4096+ks*1024+512):"memory");}
    asm volatile("s_waitcnt lgkmcnt(0)":::"memory");SBAR();
    #define PK(k) (bf16x8){lo[k][0],lo[k][1],lo[k][2],lo[k][3],hi[k][0],hi[k][1],hi[k][2],hi[k][3]}
    o[d0]=__builtin_amdgcn_mfma_f32_32x32x16_bf16(pa0,PK(0),o[d0],0,0,0);
    o[d0]=__builtin_amdgcn_mfma_f32_32x32x16_bf16(pa1,PK(1),o[d0],0,0,0);
    o[d0]=__builtin_amdgcn_mfma_f32_32x32x16_bf16(pa2,PK(2),o[d0],0,0,0);
    o[d0]=__builtin_amdgcn_mfma_f32_32x32x16_bf16(pa3,PK(3),o[d0],0,0,0);
    #undef PK
  }
}

#ifndef ATTN_STORE16
#define ATTN_STORE16(p,v) (*(u32x4*)(p)=(v))
#endif
template<int THRL> __device__ __forceinline__ void attn_unit(int b,int h,int qb,const bf16*Q,const bf16*__restrict__ K,const bf16*__restrict__ V,bf16*O,char*shm){
  const int tid=threadIdx.x,lane=tid&63,r32=lane&31,hi=lane>>5; const int wid=__builtin_amdgcn_readfirstlane(tid>>6);
  const long rowbase=(long)b*SEQ; const int q0=qb*QB;
  const bf16*Qw=Q+(rowbase+q0+wid*QBLK)*DM+h*D;
  const bf16*Kh=K+rowbase*DM+h*D,*Vh=V+rowbase*DM+h*D;
  const unsigned lds0=(unsigned)(uintptr_t)shm;
  float*wsf=(float*)(shm+LDS_WS)+wid*64;
  const bf16*ksrc=Kh+(long)lane*DM+wid*8;
  const bf16*vsrc=Vh+(long)(16*(wid&3)+(lane>>2))*DM+(wid>>2)*32+(lane&3)*8;
  const unsigned kdst=lds0+LDS_K+wid*1024, vdst=lds0+LDS_V+wid*1024;
  #define DMA_K(t,slot) glds16(ksrc+(long)(t)*KVBLK*DM,(unsigned)__builtin_amdgcn_readfirstlane(kdst+(slot)))
  #define DMA_V(t,slot) glds16(vsrc+(long)(t)*KVBLK*DM,(unsigned)__builtin_amdgcn_readfirstlane(vdst+(slot)))
  const int vb0=(int)(lds0+LDS_V)+((lane>>4)&1)*32+(lane&3)*8+(4*hi+((lane&15)>>2))*64;
  const char*Kbase=shm+LDS_K; bf16x8 kf[8];
  const lds_cptr shm3=(lds_cptr)shm; const lds_cptr kp0=shm3+LDS_K+hi*1024+r32*16; const lds_cptr vp0=shm3+LDS_V+((lane>>4)&1)*32+(lane&3)*8+(4*hi+((lane&15)>>2))*64;
  const int NT=(q0+QB)/KVBLK;
  DMA_K(0,0);DMA_V(0,0);DMA_K(1,SLOTB);
  bf16x8 qr[4];
  #pragma unroll
  for(int d0=0;d0<4;++d0)qr[d0]=*reinterpret_cast<const bf16x8*>(&Qw[(long)r32*DM+d0*16+hi*8]);
  float mhat=0.f,l_reg=0.f;f32x16 o[2];o[0]=f32x16{};o[1]=f32x16{};f32x16 negm=f32x16{};asm volatile("":"+v"(negm));
  const int qrel=wid*QBLK+r32;
  #define CMASK(P0,P1,t) do{int jb_=(t)-(NT-4); if(jb_>=0)cmask(P0,P1,jb_,qrel,hi);}while(0)
  bool resc=false;
  #define START(P0,P1) do{ const float rm=rowmax(P0,P1); resc=false; \
    { const float dl=rm; mhat=fadd_s(mhat,dl); \
      _Pragma("unroll") for(int r=0;r<16;++r){P0[r]=fsub_s(P0[r],dl);P1[r]=fsub_s(P1[r],dl);} \
      _Pragma("unroll") for(int r=0;r<16;++r)negm[r]=-mhat; asm volatile("":"+v"(negm)); } \
    _Pragma("unroll") for(int r=0;r<16;++r)P0[r]=__builtin_amdgcn_exp2f(P0[r]); }while(0)
  #define RESC() do{ if(resc){ asm volatile("s_waitcnt lgkmcnt(0)":::"memory"); \
      _Pragma("unroll") for(int d_=0;d_<2;++d_) _Pragma("unroll") for(int r=0;r<16;++r)o[d_][r]*=wsf[crow(r,hi)]; } }while(0)
  f32x16 pA0,pA1,pB0,pB1;
  int sl_prev=0,sl_cur=0,sl_next=SLOTB;
  #define ROT() do{sl_prev=sl_cur;sl_cur=sl_next;sl_next=(sl_next==(NSLOT-1)*SLOTB)?0:sl_next+SLOTB;}while(0)
  DMA_K(2,2*SLOTB);
  WAIT_BAR(3);
  qkt(pA0,pA1,Kbase,qr,negm,r32,hi);asm volatile("s_nop 15\n\ts_nop 7":"+v"(pA0),"+v"(pA1));CMASK(pA0,pA1,0);
  START(pA0,pA1);
  _Pragma("unroll") for(int r=0;r<16;++r)pA1[r]=__builtin_amdgcn_exp2f(pA1[r]);
  WAIT_BAR(0);
  DMA_K(3,0);DMA_V(1,SLOTB);
  ROT();
  kload8(kf,kp0+sl_cur);
  WAIT_BAR(2);
  s16x4 vlo[8],vhi[8]; u32x4 pw0,pw1,pw2,pw3;
  #define PKW(P,B) cvtpk_s(P[B],P[B+1])
  #define PAF(k) __builtin_bit_cast(bf16x8,pw##k)
  #define VFR(i) (bf16x8){vlo[i][0],vlo[i][1],vlo[i][2],vlo[i][3],vhi[i][0],vhi[i][1],vhi[i][2],vhi[i][3]}
  #define PIN(x) asm volatile("":"+v"(x))
  #define MX3(a,b,c) __builtin_fmaxf(__builtin_fmaxf((a),(b)),(c))
  #define GAPA(MF,A0,A1,A2,A3,W0,W1,PW) do{ MF; sacc+=A0; sacc+=A1; sacc+=A2; sacc+=A3; PIN(sacc); W0; W1; PIN(PW); SBAR(); }while(0)
  #define EX(v) __builtin_amdgcn_exp2f(v)
  #define GAPB(MF,X,B) do{ MF; X[B]=EX(X[B]); X[B+1]=EX(X[B+1]); X[B+2]=EX(X[B+2]); X[B+3]=EX(X[B+3]); PIN(X); SBAR(); }while(0)
  #define VRD(i) do{ vlo[i]=vtr(vp_+(((i)>>2)*4096+((i)&3)*1024)); vhi[i]=vtr(vp_+(((i)>>2)*4096+((i)&3)*1024+512)); }while(0)
  #define KRD(G,j) do{ if(G){ kload2(kf,kp0+sl_next,j); SBAR(); } }while(0)
  #define STEP(C0,C1,P0,P1,t,GK,GV,GL) do{ SBAR(); \
    const lds_cptr vp_=vp0+sl_prev; \
    VRD(0); SBAR(); float sacc=(P0[0]+P0[1]); \
    GAPA(C0=__builtin_amdgcn_mfma_f32_32x32x16_bf16(kf[0],qr[0],negm,0,0,0), P0[2],P0[3],P0[4],P0[5],     pw0[0]=PKW(P0,0), pw0[1]=PKW(P0,2), pw0); \
    VRD(4); SBAR(); GAPA(C1=__builtin_amdgcn_mfma_f32_32x32x16_bf16(kf[1],qr[0],negm,0,0,0), P0[6],P0[7],P0[8],P0[9],     pw0[2]=PKW(P0,4), pw0[3]=PKW(P0,6), pw0); \
    VRD(1); SBAR(); GAPA(C0=__builtin_amdgcn_mfma_f32_32x32x16_bf16(kf[2],qr[1],C0,0,0,0),   P0[10],P0[11],P0[12],P0[13], pw1[0]=PKW(P0,8), pw1[1]=PKW(P0,10), pw1); \
    VRD(5); SBAR(); GAPA(C1=__builtin_amdgcn_mfma_f32_32x32x16_bf16(kf[3],qr[1],C1,0,0,0),   P0[14],P0[15],P1[0],P1[1],   pw1[2]=PKW(P0,12),pw1[3]=PKW(P0,14), pw1); \
    VRD(2); SBAR(); GAPA(C0=__builtin_amdgcn_mfma_f32_32x32x16_bf16(kf[4],qr[2],C0,0,0,0),   P1[2],P1[3],P1[4],P1[5],     pw2[0]=PKW(P1,0), pw2[1]=PKW(P1,2), pw2); \
    VRD(6); SBAR(); GAPA(C1=__builtin_amdgcn_mfma_f32_32x32x16_bf16(kf[5],qr[2],C1,0,0,0),   P1[6],P1[7],P1[8],P1[9],     pw2[2]=PKW(P1,4), pw2[3]=PKW(P1,6), pw2); \
    VRD(3); SBAR(); GAPA(C0=__builtin_amdgcn_mfma_f32_32x32x16_bf16(kf[6],qr[3],C0,0,0,0),   P1[10],P1[11],P1[12],P1[13], pw3[0]=PKW(P1,8), pw3[1]=PKW(P1,10), pw3); \
    VRD(7); SBAR(); GAPA(C1=__builtin_amdgcn_mfma_f32_32x32x16_bf16(kf[7],qr[3],C1,0,0,0),   P1[14],P1[15],0.f,0.f,       pw3[2]=PKW(P1,12),pw3[3]=PKW(P1,14), pw3); \
    l_reg+=sacc; \
    if(GK){DMA_K((t)+3,sl_cur);} if(GV){DMA_V((t)+1,sl_next);} \
    CMASK(C0,C1,t); \
    { float a=MX3(C0[0],C0[1],C1[0]),b=MX3(C0[2],C0[3],C1[1]); a=MX3(a,C1[2],C1[3]); \
      _Pragma("unroll") for(int r=4;r<16;r+=4){a=MX3(a,C0[r],C0[r+1]);b=MX3(b,C0[r+2],C0[r+3]);a=MX3(a,C1[r],C1[r+1]);b=MX3(b,C1[r+2],C1[r+3]);} \
      float rm=__builtin_fmaxf(a,b); { auto rr=__builtin_amdgcn_permlane32_swap(__float_as_uint(rm),__float_as_uint(rm),false,false); rm=__builtin_fmaxf(__uint_as_float(rr[0]),__uint_as_float(rr[1])); } \
      resc=false; \
      if(__builtin_expect(__any(rm>(float)THRL),0)){ const float dl=__builtin_fmaxf(rm,0.f); mhat+=dl; \
        _Pragma("unroll") for(int r=0;r<16;++r){C0[r]-=dl;C1[r]-=dl;} \
        _Pragma("unroll") for(int r=0;r<16;++r)negm[r]=-mhat; asm volatile("":"+v"(negm)); \
        const float f=__builtin_amdgcn_exp2f(-dl); l_reg*=f; if(hi==0)wsf[r32]=f; resc=true; } } \
    SBAR(); \
    GAPB(o[0]=__builtin_amdgcn_mfma_f32_32x32x16_bf16(PAF(0),VFR(0),o[0],0,0,0), C0,0); \
    GAPB(o[1]=__builtin_amdgcn_mfma_f32_32x32x16_bf16(PAF(0),VFR(4),o[1],0,0,0), C0,4); \
    KRD(GL,0); GAPB(o[0]=__builtin_amdgcn_mfma_f32_32x32x16_bf16(PAF(1),VFR(1),o[0],0,0,0), C0,8); \
    KRD(GL,1); GAPB(o[1]=__builtin_amdgcn_mfma_f32_32x32x16_bf16(PAF(1),VFR(5),o[1],0,0,0), C0,12); \
    KRD(GL,2); GAPB(o[0]=__builtin_amdgcn_mfma_f32_32x32x16_bf16(PAF(2),VFR(2),o[0],0,0,0), C1,0); \
    KRD(GL,3); GAPB(o[1]=__builtin_amdgcn_mfma_f32_32x32x16_bf16(PAF(2),VFR(6),o[1],0,0,0), C1,4); \
    GAPB(o[0]=__builtin_amdgcn_mfma_f32_32x32x16_bf16(PAF(3),VFR(3),o[0],0,0,0), C1,8); \
    GAPB(o[1]=__builtin_amdgcn_mfma_f32_32x32x16_bf16(PAF(3),VFR(7),o[1],0,0,0), C1,12); \
    }while(0)
  int t=1;
  #undef CMASK
  #define CMASK(P0,P1,t) do{}while(0)
  for(;t+5<NT;t+=2){
    STEP(pB0,pB1,pA0,pA1,t,true,true,true);     WAIT_BAR(2); RESC(); ROT();
    STEP(pA0,pA1,pB0,pB1,t+1,true,true,true);   WAIT_BAR(2); RESC(); ROT();
  }
  #undef CMASK
  #define CMASK(P0,P1,t) do{int jb_=(t)-(NT-4); if(jb_>=0)cmask(P0,P1,jb_,qrel,hi);}while(0)
  #define ENDW(tt) do{ if((tt)+3<NT){WAIT_BAR(2);} else if((tt)+2<NT){WAIT_BAR(1);} else {WAIT_BAR(0);} }while(0)
  for(;t+1<NT;t+=2){
    STEP(pB0,pB1,pA0,pA1,t,(t+3<NT),(t+1<NT),(t+1<NT));       ENDW(t);   RESC(); ROT();
    STEP(pA0,pA1,pB0,pB1,t+1,(t+4<NT),(t+2<NT),(t+2<NT));     ENDW(t+1); RESC(); ROT();
  }
  STEP(pB0,pB1,pA0,pA1,NT-1,false,false,false); RESC();
  { float sacc=pB0[0]+pB0[1]; _Pragma("unroll") for(int r=2;r<16;++r)sacc+=pB0[r]; _Pragma("unroll") for(int r=0;r<16;++r)sacc+=pB1[r]; l_reg+=sacc;
    pw0=(u32x4){PKW(pB0,0),PKW(pB0,2),PKW(pB0,4),PKW(pB0,6)};pw1=(u32x4){PKW(pB0,8),PKW(pB0,10),PKW(pB0,12),PKW(pB0,14)};pw2=(u32x4){PKW(pB1,0),PKW(pB1,2),PKW(pB1,4),PKW(pB1,6)};pw3=(u32x4){PKW(pB1,8),PKW(pB1,10),PKW(pB1,12),PKW(pB1,14)};
    SBAR(); pv(o,vb0+sl_cur,PAF(0),PAF(1),PAF(2),PAF(3)); }
  #undef PKW
  #undef PAF
  #undef VFR
  #undef PIN
  #undef MX3
  #undef GAPA
  #undef GAPB
  #undef EX
  #undef VRD
  #undef KRD
  #undef STEP
  #undef ENDW
  {auto rr=__builtin_amdgcn_permlane32_swap(__float_as_uint(l_reg),__float_as_uint(l_reg),false,false);l_reg=__uint_as_float(rr[0])+__uint_as_float(rr[1]);}
  if(hi==0)wsf[32+r32]=l_reg;asm volatile("s_waitcnt lgkmcnt(0)":::"memory");
  float rli[16];
  #pragma unroll
  for(int r=0;r<16;++r)rli[r]=__builtin_amdgcn_rcpf(wsf[32+crow(r,hi)]);
  bf16*Ow=O+(rowbase+q0+wid*QBLK)*DM+h*D;
  { bf16*stg=(bf16*)(shm+LDS_OST)+wid*2048;
    #pragma unroll
    for(int r=0;r<16;++r){const int orow=crow(r,hi);
      #pragma unroll
      for(int d0=0;d0<2;++d0)stg[orow*64+d0*32+r32]=__float2bfloat16(o[d0][r]*rli[r]);}
    asm volatile("s_waitcnt lgkmcnt(0)":::"memory");
    #pragma unroll
    for(int i=0;i<4;++i){const int row=i*8+(lane>>3),ch=lane&7; const u32x4 v=*(const u32x4*)(stg+row*64+ch*8); ATTN_STORE16(Ow+(long)row*DM+ch*8,v);} }
  asm volatile("s_waitcnt lgkmcnt(0)\n\ts_barrier":::"memory");
  #undef DMA_K
  #undef DMA_V
  #undef CMASK
  #undef START
  #undef RESC
  #undef ROT
}
constexpr int ATTN_LDS_BYTES=LDS_BYTES;
struct AttnTensors { const bf16* Q; const bf16* K; const bf16* V; bf16* O; };
struct AttnUnit { int bh; int qb; };
struct StaticOrder {
  int vcu;
  __device__ __forceinline__ explicit StaticOrder(int grid,int block):vcu((block%8)*(grid/8)+block/8){}
  __device__ __forceinline__ bool next(int i,AttnUnit&u)const{ if(i>=4)return false; const int s=vcu&7; u.bh=vcu>>3; u.qb=(i==0)?s:(i==1)?15-s:(i==2)?16+s:31-s; return true; }
  __device__ __forceinline__ void a_ready(const AttnUnit&)const{}
  __device__ __forceinline__ void done(const AttnUnit&)const{}
};
struct QueueOrder {
  unsigned* head; volatile __attribute__((address_space(3))) unsigned* slot; int grp; mutable unsigned pend;
  __device__ __forceinline__ bool next(int i,AttnUnit&u)const{
    __syncthreads();
    if(threadIdx.x==0){ const unsigned cur=(i==0)?__hip_atomic_fetch_add(head+64*grp,1u,__ATOMIC_RELAXED,__HIP_MEMORY_SCOPE_AGENT):pend; slot[0]=cur;
      if(cur<128u) pend=__hip_atomic_fetch_add(head+64*grp,1u,__ATOMIC_RELAXED,__HIP_MEMORY_SCOPE_AGENT); }
    __syncthreads();
    const unsigned q=slot[0]; if(q>=128u)return false;
    u.qb=31-(int)(q>>2); u.bh=4*grp+(int)(q&3u); return true; }
  __device__ __forceinline__ void a_ready(const AttnUnit&)const{}
  __device__ __forceinline__ void done(const AttnUnit&)const{}
};
template<class Sched,int THRL=8> __device__ __forceinline__ void attn_phase(char*lds,const AttnTensors&T,const Sched&S){
  AttnUnit u;
  for(int i=0;S.next(i,u);++i){ S.a_ready(u); { const int st=u.bh, h=(st>>1)&15, e=st&1, hv=(((st>>2)&7)<<1)+e; attn_unit<THRL>(st>>5,h,u.qb,T.Q,T.K,T.V+(hv-h)*D,T.O+(size_t)e*SEQ*DM,lds); } S.done(u); }
}
#undef SBAR
#undef WAIT_BAR
}
#define GAS __attribute__((address_space(1)))
#define LAS __attribute__((address_space(3)))
typedef unsigned short bf16;
typedef unsigned v4u __attribute__((ext_vector_type(4)));
typedef short bf16x8 __attribute__((ext_vector_type(8)));
typedef GAS unsigned gu32;
typedef GAS unsigned long long gu64;
#define RLX_AGENT __ATOMIC_RELAXED, __HIP_MEMORY_SCOPE_AGENT
#define LDS_WAIT() asm volatile("s_waitcnt lgkmcnt(0)" ::: "memory")
#define VM_WAIT() asm volatile("s_waitcnt vmcnt(0)" ::: "memory")
__device__ __forceinline__ unsigned long long rt() { return __builtin_amdgcn_s_memrealtime(); }

#define XB_TMO      128
#define XB_XCNT(j)  (256  + 64 * (j))
#define XB_XSUB(j)  (1280 + 64 * (j))
#define XB_XGEN(j)  (2304 + 64 * (j))
#define XB_TOP      3328
#define XB_TOPGEN   3392
#define XCD_BAR_WORDS 3456
#define XB_SPIN_CAP (1u << 18)

__device__ __forceinline__ unsigned xb_ld(unsigned* p)              { return __hip_atomic_load(p, __ATOMIC_RELAXED, __HIP_MEMORY_SCOPE_AGENT); }
__device__ __forceinline__ unsigned xb_add(unsigned* p, unsigned v) { return __hip_atomic_fetch_add(p, v, __ATOMIC_RELAXED, __HIP_MEMORY_SCOPE_AGENT); }
__device__ __forceinline__ unsigned xb_xcc_id() { return (unsigned)__builtin_amdgcn_s_getreg((3 << 11) | 20) & 0xFu; }
#define XB_SPIN(cond, bar) do { unsigned _sp = 0; while (cond) { __builtin_amdgcn_s_sleep(1); \
    if ((++_sp & 255u) == 0u) { if (xb_ld(&(bar)[XB_TMO])) break; if (_sp > XB_SPIN_CAP) { atomicAdd(&(bar)[XB_TMO], 1u); break; } } } } while (0)

struct XcdBarrier {
    unsigned* bar; unsigned x;
    volatile LAS unsigned* st;
};

__device__ __forceinline__ XcdBarrier xcd_barrier_post(unsigned* bar, volatile LAS unsigned* st) {
    XcdBarrier b; b.bar = bar; b.x = xb_xcc_id(); b.st = st;
    if (threadIdx.x == 0) (void)xb_add(&bar[XB_XCNT(b.x)], 1u);
    return b;
}
__device__ __forceinline__ void xcd_barrier_complete(unsigned* bar, unsigned x, unsigned& nloc, unsigned& nx) {
    const unsigned G = gridDim.x * gridDim.y * gridDim.z;
    unsigned sum, cnt, mine, sp = 0u;
    for (;;) {
        sum = 0u; cnt = 0u; mine = 0u;
#pragma unroll
        for (unsigned j = 0; j < 16; ++j) { const unsigned c = xb_ld(&bar[XB_XCNT(j)]); sum += c; cnt += (c > 0u) ? 1u : 0u; mine = (j == x) ? c : mine; }
        if (sum == G) break;
        __builtin_amdgcn_s_sleep(1);
        if ((++sp & 255u) == 0u) { if (xb_ld(&bar[XB_TMO])) break; if (sp > XB_SPIN_CAP) { atomicAdd(&bar[XB_TMO], 1u); break; } }
    }
    nloc = mine > 0u ? mine : 1u; nx = cnt > 0u ? cnt : 1u;
}

__device__ __forceinline__ void xcd_barrier(const XcdBarrier& b) {
    asm volatile("s_waitcnt vmcnt(0)" ::: "memory");
    __syncthreads();
    if (threadIdx.x == 0) {
        unsigned* bar = b.bar;
        __builtin_amdgcn_s_waitcnt(0);
        unsigned nloc = b.st[0], nx = b.st[1];
        if (nloc == 0u) { xcd_barrier_complete(bar, b.x, nloc, nx); b.st[0] = nloc; b.st[1] = nx; }
        const unsigned old = xb_add(&bar[XB_XSUB(b.x)], 1u);
        const unsigned gen = old / nloc;
        if (old + 1u == (gen + 1u) * nloc) {
            __builtin_amdgcn_fence(__ATOMIC_RELEASE, "agent");
            asm volatile("s_waitcnt vmcnt(0)" ::: "memory");
            const unsigned og = xb_add(&bar[XB_TOP], 1u);
            const unsigned tg = og / nx;
            if (og + 1u == (tg + 1u) * nx) xb_add(&bar[XB_TOPGEN], 1u);
            else XB_SPIN(xb_ld(&bar[XB_TOPGEN]) == tg, bar);
            __builtin_amdgcn_fence(__ATOMIC_ACQUIRE, "agent");
            xb_add(&bar[XB_XGEN(b.x)], 1u);
            asm volatile("s_waitcnt vmcnt(0)" ::: "memory");
        } else {
            XB_SPIN(xb_ld(&bar[XB_XGEN(b.x)]) == gen, bar);
            __builtin_amdgcn_fence(__ATOMIC_ACQUIRE, "agent");
            asm volatile("s_waitcnt vmcnt(0)" ::: "memory");
        }
    }
    __syncthreads();
}

typedef float pk2_f32x2_t __attribute__((ext_vector_type(2))); typedef __bf16 pk2_bf16x2_t __attribute__((ext_vector_type(2)));
__device__ __forceinline__ unsigned pk2(float lo, float hi) { const pk2_f32x2_t v = {lo, hi}; const pk2_bf16x2_t b = __builtin_convertvector(v, pk2_bf16x2_t); return __builtin_bit_cast(unsigned, b); }
#define DPP_ADD(v, ctrl) v += __builtin_bit_cast(float, __builtin_amdgcn_update_dpp(0, __builtin_bit_cast(int, v), ctrl, 0xf, 0xf, true))
__device__ __forceinline__ float rowpair_sum(float v) { float a = v, b = v; asm("s_nop 1\n\tv_permlane16_swap_b32 %0, %1" : "+v"(a), "+v"(b)); return a + b; }
__device__ __forceinline__ float wave_allsum(float v) {
    DPP_ADD(v, 0xB1);
    DPP_ADD(v, 0x4E);
    DPP_ADD(v, 0x141);
    DPP_ADD(v, 0x140);
    v = rowpair_sum(v);
    { float a = v, b = v; asm("s_nop 1\n\tv_permlane32_swap_b32 %0, %1" : "+v"(a), "+v"(b)); v = a + b; }
    return v;
}
__device__ __forceinline__ float row16_sum(float v) { DPP_ADD(v, 0xB1); DPP_ADD(v, 0x4E); DPP_ADD(v, 0x141); DPP_ADD(v, 0x140); return v; }
struct PrepW { const float *mu, *w0, *w2, *a0, *a2, *g2, *k_k, *k_a, *r_k; };

__device__ __forceinline__ void prep_token_a(const bf16_t* PR, const PrepW& P, int t, int lt, LAS float* xs) {
    const bf16_t* cur = PR + (size_t)t * RWKV_COLS; const int c = 3072 + lt;
    const float a = bf2f(cur[c]), p = t > 0 ? bf2f(cur[c - RWKV_COLS]) : 0.f, v = a + (p - a) * P.mu[c];
    xs[lt] = lt < 64 ? tanhf(v) : (lt < 128 ? v : sigmoidf_(v));
}
__device__ __forceinline__ void prep_token_b(const bf16_t* PR, const PrepW& P, int t, int lt, const LAS float* xs, float* S0, float* BONUS) {
    const bf16_t* cur = PR + (size_t)t * RWKV_COLS;
    float lw[4], la[4], lg[4] = {0.f, 0.f, 0.f, 0.f};
#pragma unroll
    for (int i = 0; i < 4; ++i) { lw[i] = P.w0[lt * 4 + i]; la[i] = P.a0[lt * 4 + i]; }
#pragma unroll 4
    for (int j = 0; j < 64; ++j) { const f32x4 w = *(const GAS f32x4*)(P.w2 + (size_t)j * RW + lt * 4), a = *(const GAS f32x4*)(P.a2 + (size_t)j * RW + lt * 4); const float x0 = xs[j], x1 = xs[64 + j];
#pragma unroll
        for (int i = 0; i < 4; ++i) { lw[i] += x0 * w[i]; la[i] += x1 * a[i]; } }
#pragma unroll 4
    for (int j = 0; j < 128; ++j) { const f32x4 g = *(const GAS f32x4*)(P.g2 + (size_t)j * RW + lt * 4); const float x2 = xs[128 + j];
#pragma unroll
        for (int i = 0; i < 4; ++i) lg[i] += x2 * g[i]; }
    float r[4], k0[4], v[4], kk[4], a[4], ss = 0.f;
#pragma unroll
    for (int i = 0; i < 4; ++i) { const int c = lt * 4 + i;
        { const float x = bf2f(cur[c]), p = t > 0 ? bf2f(cur[c - RWKV_COLS]) : 0.f; r[i] = x + (p - x) * P.mu[c]; }
        { const float x = bf2f(cur[1024 + c]), p = t > 0 ? bf2f(cur[1024 + c - RWKV_COLS]) : 0.f; k0[i] = x + (p - x) * P.mu[1024 + c]; }
        { const float x = bf2f(cur[2048 + c]), p = t > 0 ? bf2f(cur[2048 + c - RWKV_COLS]) : 0.f; v[i] = x + (p - x) * P.mu[2048 + c]; }
        a[i] = sigmoidf_(la[i]); kk[i] = k0[i] * P.k_k[c]; ss += kk[i] * kk[i]; }
    ss = row16_sum(ss);
    const float inv = 1.f / fmaxf(sqrtf(ss), 1e-12f);
    float bon = 0.f; const size_t ob = (size_t)t * RW + lt * 4; constexpr size_t SS = (size_t)SEQ * RW;
    f32x4 o_r, o_w, o_k, o_v, o_a, o_b, o_g;
#pragma unroll
    for (int i = 0; i < 4; ++i) { const int c = lt * 4 + i;
        const float x = -lw[i], sp = fmaxf(x, 0.f) + log1pf(__expf(-fabsf(x))), wraw = -sp - 0.5f, dec = __expf(-__expf(wraw));
        const float kn = kk[i] * inv, k = k0[i] * (1.f + (a[i] - 1.f) * P.k_a[c]);
        bon += r[i] * k * P.r_k[c];
        o_r[i] = r[i]; o_w[i] = dec; o_k[i] = k; o_v[i] = v[i]; o_a[i] = -kn; o_b[i] = kn * a[i]; o_g[i] = lg[i]; }
    *(GAS f32x4*)(S0 + 0 * SS + ob) = o_r; *(GAS f32x4*)(S0 + 1 * SS + ob) = o_w; *(GAS f32x4*)(S0 + 2 * SS + ob) = o_k; *(GAS f32x4*)(S0 + 3 * SS + ob) = o_v;
    *(GAS f32x4*)(S0 + 4 * SS + ob) = o_a; *(GAS f32x4*)(S0 + 5 * SS + ob) = o_b; *(GAS f32x4*)(S0 + 6 * SS + ob) = o_g;
    bon = row16_sum(bon);
    if ((lt & 15) == 0) BONUS[t * 16 + (lt >> 4)] = bon;
}
__device__ __forceinline__ void scan_row(const float* S0, float* Y, int h, int vr, int lane) {
    constexpr size_t SS = (size_t)SEQ * RW; constexpr int U = 8;
    const GAS float* pr = (const GAS float*)S0 + h * 64 + lane; const GAS float* pv = (const GAS float*)S0 + 3 * SS + h * 64 + vr;
    float s = 0.f, yacc = 0.f;
    float cr[U], cw[U], ck[U], ca[U], cb[U], cv[U];
#pragma unroll
    for (int u = 0; u < U; ++u) { const size_t o = (size_t)u * RW; cr[u] = pr[o]; cw[u] = pr[SS + o]; ck[u] = pr[2 * SS + o]; ca[u] = pr[4 * SS + o]; cb[u] = pr[5 * SS + o]; cv[u] = pv[o]; }
    for (int t0 = 0; t0 < SEQ; t0 += U) {
        float nr[U], nw[U], nk[U], na[U], nb[U], nv[U];
        const int tn = (t0 + U < SEQ) ? t0 + U : t0;
#pragma unroll
        for (int u = 0; u < U; ++u) { const size_t o = (size_t)(tn + u) * RW; nr[u] = pr[o]; nw[u] = pr[SS + o]; nk[u] = pr[2 * SS + o]; na[u] = pr[4 * SS + o]; nb[u] = pr[5 * SS + o]; nv[u] = pv[o]; }
#pragma unroll
        for (int u = 0; u < U; ++u) {
            const float sa = wave_allsum(s * ca[u]);
            s = s * cw[u] + sa * cb[u] + cv[u] * ck[u];
            const float y = wave_allsum(s * cr[u]);
            yacc = (lane == ((t0 + u) & 63)) ? y : yacc; }
        if (((t0 + U) & 63) == 0) ((GAS float*)Y)[(size_t)(t0 + U - 64 + lane) * RW + h * 64 + vr] = yacc;
#pragma unroll
        for (int u = 0; u < U; ++u) { cr[u] = nr[u]; cw[u] = nw[u]; ck[u] = nk[u]; ca[u] = na[u]; cb[u] = nb[u]; cv[u] = nv[u]; }
    }
}
template <int NT_>
__device__ __forceinline__ void diff_post_tokens(const bf16_t* O2, float lam, const f32x4 sw, bf16_t* MIXED, int t, int tstep, int lt) {
    const int h = lt >> 5, d0 = (lt & 31) * 4; const bf16_t* ob2 = O2 + (size_t)(d0 >> 6) * SEQ * 1024 + (d0 & 63);
    unsigned long long a[NT_], b[NT_];
#pragma unroll
    for (int k = 0; k < NT_; ++k) { const int tk = t + k * tstep < SEQ ? t + k * tstep : SEQ - 1;
        a[k] = *(const GAS unsigned long long*)(ob2 + (size_t)tk * 1024 + (2 * h) * 64); b[k] = *(const GAS unsigned long long*)(ob2 + (size_t)tk * 1024 + (2 * h + 1) * 64); }
#pragma unroll
    for (int k = 0; k < NT_; ++k) { f32x4 o; float q = 0.f;
#pragma unroll
        for (int i = 0; i < 4; ++i) { o[i] = bf2f((bf16_t)(a[k] >> (16 * i))) - lam * bf2f((bf16_t)(b[k] >> (16 * i))); q += o[i] * o[i]; }
        q = rowpair_sum(row16_sum(q));
        const float rs = rsqrtf(q * (1.f / 128.f) + SUBLN_EPS) * (1.f - LAMBDA_INIT);
        o = o * rs * sw;
        if (t + k * tstep < SEQ) *(GAS unsigned long long*)(MIXED + (size_t)(t + k * tstep) * DM + 1024 + h * 128 + d0) = (unsigned long long)pk2(o[0], o[1]) | ((unsigned long long)pk2(o[2], o[3]) << 32); }
}
#define SC_BAR() do { asm volatile("s_waitcnt lgkmcnt(0)" ::: "memory"); __builtin_amdgcn_s_barrier(); asm volatile("" ::: "memory"); } while (0)
typedef short bf16x8_t __attribute__((ext_vector_type(8)));
typedef float f32x16_t __attribute__((ext_vector_type(16)));
__device__ __forceinline__ int swz(int row, int k) { return row * 128 + ((((k >> 3) ^ row) & 7) << 4) + ((k & 7) << 1); }
__device__ __forceinline__ void mm64(const LAS unsigned char* Aop, const LAS unsigned char* Bop, int ta, int tb0, int lane, f32x4 (&acc)[2]) {
    const int fr = lane & 15, fq = lane >> 4;
    const bf16x8_t a0 = *(const LAS bf16x8_t*)(Aop + swz(16 * ta + fr, 8 * fq)), a1 = *(const LAS bf16x8_t*)(Aop + swz(16 * ta + fr, 32 + 8 * fq));
#pragma unroll
    for (int t = 0; t < 2; ++t) {
        const bf16x8_t b0 = *(const LAS bf16x8_t*)(Bop + swz(16 * (tb0 + t) + fr, 8 * fq)), b1 = *(const LAS bf16x8_t*)(Bop + swz(16 * (tb0 + t) + fr, 32 + 8 * fq));
        acc[t] = __builtin_amdgcn_mfma_f32_16x16x32_bf16(a0, b0, acc[t], 0, 0, 0);
        acc[t] = __builtin_amdgcn_mfma_f32_16x16x32_bf16(a1, b1, acc[t], 0, 0, 0); }
}
__device__ __forceinline__ unsigned long long pk4(const f32x4 v) { return (unsigned long long)pk2(v[0], v[1]) | ((unsigned long long)pk2(v[2], v[3]) << 32); }
__device__ __forceinline__ f32x4 up4(unsigned long long w) { f32x4 r; r[0] = bf2f((bf16_t)w); r[1] = bf2f((bf16_t)(w >> 16)); r[2] = bf2f((bf16_t)(w >> 32)); r[3] = bf2f((bf16_t)(w >> 48)); return r; }
__device__ __forceinline__ float sum8(float v) { DPP_ADD(v, 0xB1); DPP_ADD(v, 0x4E); DPP_ADD(v, 0x141); return v; }
constexpr int SA_AT = 0, SA_BT = 8192, SA_KT = 16384, SA_RT = 24576, SA_ATT = 32768, SA_VTT = 40960, SA_BPT = 49152, SA_KPT = 57344, SA_M1 = 65536, SA_TT = 81920, SA_M2T = 90112,
              SA_M3 = 98304, SA_LW = 106496, SA_TOT = 122880, SA_PAR = 124928  , SA_END = 126976;
constexpr int SA_X1 = SA_AT, SA_WT = SA_BT, SA_G = SA_KT, SA_KPPT = SA_M3;
struct ScanW { const float *mu, *w0, *a0, *k_k, *k_a, *r_k; };
struct ScanBufs { const bf16_t* PR; const bf16_t* LG; bf16_t* RPP; float* YG; bf16_t* PT; float* QT; bf16_t* EG; bf16_t* EBV; };
constexpr int NCHUNK = SEQ / 64;

struct ScanIn { u32x4 cr, ck, cv, pr, pk, pv, gw, ga, gg; };
__device__ __forceinline__ void scanA_fetch(const ScanBufs& B, int h, int c, int tid, ScanIn& in) {
    const int tau = tid >> 3, n0 = (tid & 7) * 8, t = c * 64 + tau, ch = h * 64 + n0;
    const bf16_t* cur = B.PR + (size_t)t * RWKV_COLS + ch; const bf16_t* prv = t > 0 ? cur - RWKV_COLS : cur;
    in.cr = *(const GAS u32x4*)(cur); in.ck = *(const GAS u32x4*)(cur + 1024); in.cv = *(const GAS u32x4*)(cur + 2048);
    in.pr = *(const GAS u32x4*)(prv); in.pk = *(const GAS u32x4*)(prv + 1024); in.pv = *(const GAS u32x4*)(prv + 2048);
    const bf16_t* lgp = B.LG + (size_t)t * 3072 + ch;
    in.gw = *(const GAS u32x4*)(lgp); in.ga = *(const GAS u32x4*)(lgp + 1024); in.gg = *(const GAS u32x4*)(lgp + 2048);
}
__device__ __forceinline__ void scanA_params(LAS unsigned char* L, const ScanW& W, int h, int tid) {
    if (tid < 128) { const int a = tid >> 4, j = (tid & 15) * 4;
        const float* src = a == 0 ? W.mu : a == 1 ? W.mu + 1024 : a == 2 ? W.mu + 2048 : a == 3 ? W.w0 : a == 4 ? W.a0 : a == 5 ? W.k_k : a == 6 ? W.k_a : W.r_k;
        *(LAS f32x4*)(L + SA_PAR + (a * 64 + j) * 4) = *(const GAS f32x4*)(src + h * 64 + j); }
}
__device__ __forceinline__ void scanA_unit(LAS unsigned char* L, const ScanW& W, const ScanBufs& B, int h, int c, int tid, int wave, int lane, const ScanIn& in, bool nvalid, int hn, int cn, ScanIn& nxt, int dbg = 0) {
    const int tau = tid >> 3, n0 = (tid & 7) * 8, t = c * 64 + tau, ch = h * 64 + n0;
    float r_[8], km[8], v_[8], a_[8], b_[8], lw[8];
    const LAS float* PAR = (const LAS float*)(L + SA_PAR);
    {
        const bool hasp = t > 0;
        const u32x4 cr = in.cr, ck = in.ck, cv = in.cv; u32x4 pr = in.pr, pk = in.pk, pv = in.pv;
        if (!hasp) { pr = (u32x4){0u, 0u, 0u, 0u}; pk = pr; pv = pr; }
        const u32x4 gw = in.gw, ga = in.ga, gg = in.gg;
        float k0[8], eta[8], g_[8], ss = 0.f;
#pragma unroll
        for (int e = 0; e < 8; ++e) { const int sh = (e & 1) * 16, q = e >> 1;
            const float xr = __uint_as_float((cr[q] >> sh) << 16), xk = __uint_as_float((ck[q] >> sh) << 16), xv = __uint_as_float((cv[q] >> sh) << 16);
            const float yr = __uint_as_float((pr[q] >> sh) << 16), yk = __uint_as_float((pk[q] >> sh) << 16), yv = __uint_as_float((pv[q] >> sh) << 16);
            r_[e] = xr + (yr - xr) * PAR[0 * 64 + n0 + e]; k0[e] = xk + (yk - xk) * PAR[1 * 64 + n0 + e]; v_[e] = xv + (yv - xv) * PAR[2 * 64 + n0 + e];
            const float l_w = PAR[3 * 64 + n0 + e] + __uint_as_float((gw[q] >> sh) << 16), l_a = PAR[4 * 64 + n0 + e] + __uint_as_float((ga[q] >> sh) << 16); g_[e] = __uint_as_float((gg[q] >> sh) << 16);
            const float x = -l_w, sp = fmaxf(x, 0.f) + __logf(1.f + __expf(-fabsf(x)));
            lw[e] = -__expf(-sp - 0.5f);
            eta[e] = __builtin_amdgcn_rcpf(1.f + __expf(-l_a)); const float kk = k0[e] * PAR[5 * 64 + n0 + e]; a_[e] = kk; ss += kk * kk; }
        ss = sum8(ss); const float inv = __builtin_amdgcn_rsqf(fmaxf(ss, 1e-24f))  ; float bon = 0.f;
#pragma unroll
        for (int e = 0; e < 8; ++e) { const float kn = a_[e] * inv; km[e] = k0[e] * (1.f + (eta[e] - 1.f) * PAR[6 * 64 + n0 + e]); a_[e] = -kn; b_[e] = kn * eta[e]; bon += r_[e] * km[e] * PAR[7 * 64 + n0 + e]; }
        bon = sum8(bon);
        { u32x4 og, ob;
#pragma unroll
          for (int q = 0; q < 4; ++q) { og[q] = pk2(g_[2 * q], g_[2 * q + 1]); ob[q] = pk2(bon * v_[2 * q], bon * v_[2 * q + 1]); }
          *(GAS u32x4*)(B.EG + (size_t)t * RW + ch) = og; *(GAS u32x4*)(B.EBV + (size_t)t * RW + ch) = ob; }
        LAS float* LW = (LAS float*)(L + SA_LW) + tau * 64 + n0;
        *(LAS f32x4*)(LW) = (f32x4){lw[0], lw[1], lw[2], lw[3]}; *(LAS f32x4*)(LW + 4) = (f32x4){lw[4], lw[5], lw[6], lw[7]};
    }
    SC_BAR();
    if (nvalid) scanA_fetch(B, hn, cn, tid, nxt);
    {
        const int n = tid & 63, part = tid >> 6; LAS float* LW = (LAS float*)(L + SA_LW); LAS float* TOT = (LAS float*)(L + SA_TOT);
        float p[8]; float run = 0.f;
#pragma unroll
        for (int j = 0; j < 8; ++j) { run += LW[(8 * part + j) * 64 + n]; p[j] = run; }
        TOT[part * 64 + n] = run;
        SC_BAR();
        float off = 0.f;
#pragma unroll
        for (int q = 0; q < 8; ++q) off += (q < part) ? TOT[q * 64 + n] : 0.f;
#pragma unroll
        for (int j = 0; j < 8; ++j) LW[(8 * part + j) * 64 + n] = off + p[j];
    }
    SC_BAR();
    {
        const LAS float* LWr = (const LAS float*)(L + SA_LW) + tau * 64 + n0; const LAS float* LWe = (const LAS float*)(L + SA_LW) + 63 * 64 + n0;
        float at[8], bt[8], kt[8], rt[8], bp[8], kp[8];
#pragma unroll
        for (int e = 0; e < 8; ++e) { const float La = LWr[e], Le = LWe[e], eL = __expf(La), eLp = __expf(La - lw[e]), eI = __expf(-La), eE = __expf(Le - La);
            at[e] = a_[e] * eLp; bt[e] = b_[e] * eI; kt[e] = km[e] * eI; rt[e] = r_[e] * eL; bp[e] = b_[e] * eE; kp[e] = km[e] * eE; }
        const int o = swz(tau, n0);
        { u32x4 w;
#pragma unroll
          for (int q = 0; q < 4; ++q) w[q] = pk2(at[2 * q], at[2 * q + 1]);
          *(LAS u32x4*)(L + SA_AT + o) = w;
#pragma unroll
          for (int q = 0; q < 4; ++q) w[q] = pk2(bt[2 * q], bt[2 * q + 1]);
          *(LAS u32x4*)(L + SA_BT + o) = w;
#pragma unroll
          for (int q = 0; q < 4; ++q) w[q] = pk2(kt[2 * q], kt[2 * q + 1]);
          *(LAS u32x4*)(L + SA_KT + o) = w;
#pragma unroll
          for (int q = 0; q < 4; ++q) w[q] = pk2(rt[2 * q], rt[2 * q + 1]);
          *(LAS u32x4*)(L + SA_RT + o) = w; }
        unsigned pa[4], pv[4], pb[4], pk[4];
#pragma unroll
        for (int q = 0; q < 4; ++q) { pa[q] = pk2(at[2 * q], at[2 * q + 1]); pv[q] = pk2(v_[2 * q], v_[2 * q + 1]); pb[q] = pk2(bp[2 * q], bp[2 * q + 1]); pk[q] = pk2(kp[2 * q], kp[2 * q + 1]); }
#pragma unroll
        for (int e = 0; e < 8; ++e) { const int ot = swz(n0 + e, tau), sh = 16 * (e & 1), q = e >> 1;
            *(LAS bf16_t*)(L + SA_ATT + ot) = (bf16_t)(pa[q] >> sh); *(LAS bf16_t*)(L + SA_VTT + ot) = (bf16_t)(pv[q] >> sh); *(LAS bf16_t*)(L + SA_BPT + ot) = (bf16_t)(pb[q] >> sh); *(LAS bf16_t*)(L + SA_KPT + ot) = (bf16_t)(pk[q] >> sh); }
    }
    SC_BAR();
    if (dbg & 4) return;
    const int ta = wave >> 1, tb0 = 2 * (wave & 1), fr = lane & 15, fq = lane >> 4, i0 = 16 * ta + 4 * fq;
    f32x4 g4[2] = {{0.f, 0.f, 0.f, 0.f}, {0.f, 0.f, 0.f, 0.f}};
    {
        f32x4 d1[2] = {{0.f, 0.f, 0.f, 0.f}, {0.f, 0.f, 0.f, 0.f}}, d1t[2] = {{0.f, 0.f, 0.f, 0.f}, {0.f, 0.f, 0.f, 0.f}}, d2[2] = {{0.f, 0.f, 0.f, 0.f}, {0.f, 0.f, 0.f, 0.f}}, d3[2] = {{0.f, 0.f, 0.f, 0.f}, {0.f, 0.f, 0.f, 0.f}};
        mm64(L + SA_BT, L + SA_AT, ta, tb0, lane, d1); mm64(L + SA_AT, L + SA_BT, ta, tb0, lane, d1t); mm64(L + SA_AT, L + SA_KT, ta, tb0, lane, d2); mm64(L + SA_BT, L + SA_RT, ta, tb0, lane, d3); mm64(L + SA_KT, L + SA_RT, ta, tb0, lane, g4);
#pragma unroll
        for (int t2 = 0; t2 < 2; ++t2) { const int j = 16 * (tb0 + t2) + fr; f32x4 r0;
#pragma unroll
            for (int q = 0; q < 4; ++q) { const int i = i0 + q; if (!(i < j)) d1[t2][q] = 0.f; if (!(j < i)) { d1t[t2][q] = 0.f; d2[t2][q] = 0.f; } if (!(i <= j)) { d3[t2][q] = 0.f; g4[t2][q] = 0.f; } r0[q] = d1t[t2][q] + (i == j ? 1.f : 0.f); }
            *(LAS unsigned long long*)(L + SA_M1 + swz(j, i0)) = pk4(d1[t2]);
            *(LAS unsigned long long*)(L + SA_M1 + 8192 + swz(j, i0)) = pk4(d1t[t2]);
            *(LAS unsigned long long*)(L + SA_TT + swz(j, i0)) = pk4(r0);
            *(LAS unsigned long long*)(L + SA_M2T + swz(j, i0)) = pk4(d2[t2]);
            *(LAS unsigned long long*)(L + SA_M3 + swz(j, i0)) = pk4(d3[t2]); }
    }
    SC_BAR();
    {
#define INV_SQUARE(Lp, Up, Ln, Un, needU) do { f32x4 e1[2] = {{0.f, 0.f, 0.f, 0.f}, {0.f, 0.f, 0.f, 0.f}}, e2[2] = {{0.f, 0.f, 0.f, 0.f}, {0.f, 0.f, 0.f, 0.f}}; \
        mm64(L + (Up), L + (Lp), ta, tb0, lane, e1); if (needU) mm64(L + (Lp), L + (Up), ta, tb0, lane, e2); \
        _Pragma("unroll") for (int t2 = 0; t2 < 2; ++t2) { const int j = 16 * (tb0 + t2) + fr; *(LAS unsigned long long*)(L + (Ln) + swz(j, i0)) = pk4(e1[t2]); if (needU) *(LAS unsigned long long*)(L + (Un) + swz(j, i0)) = pk4(e2[t2]); } } while (0)
#define INV_ACC(Lk, Rp, Rn) do { f32x4 e3[2] = {{0.f, 0.f, 0.f, 0.f}, {0.f, 0.f, 0.f, 0.f}}; mm64(L + (Lk), L + (Rp), ta, tb0, lane, e3); \
        _Pragma("unroll") for (int t2 = 0; t2 < 2; ++t2) { const int j = 16 * (tb0 + t2) + fr; *(LAS unsigned long long*)(L + (Rn) + swz(j, i0)) = pk4(e3[t2] + up4(*(const LAS unsigned long long*)(L + (Rp) + swz(j, i0)))); } } while (0)
        INV_SQUARE(SA_M1, SA_M1 + 8192, SA_AT, SA_BT, true);                                        SC_BAR();
        INV_ACC(SA_AT, SA_TT, SA_KT); INV_SQUARE(SA_AT, SA_BT, SA_M1, SA_M1 + 8192, true);          SC_BAR();
        INV_ACC(SA_M1, SA_KT, SA_TT); INV_SQUARE(SA_M1, SA_M1 + 8192, SA_AT, SA_BT, true);          SC_BAR();
        INV_ACC(SA_AT, SA_TT, SA_KT); INV_SQUARE(SA_AT, SA_BT, SA_M1, SA_M1 + 8192, true);          SC_BAR();
        INV_ACC(SA_M1, SA_KT, SA_TT); INV_SQUARE(SA_M1, SA_M1 + 8192, SA_AT, SA_BT, false);         SC_BAR();
        INV_ACC(SA_AT, SA_TT, SA_KT);
#undef INV_SQUARE
#undef INV_ACC
    }
    SC_BAR();
    {
        f32x4 dx[2] = {{0.f, 0.f, 0.f, 0.f}, {0.f, 0.f, 0.f, 0.f}}, dw[2] = {{0.f, 0.f, 0.f, 0.f}, {0.f, 0.f, 0.f, 0.f}};
        mm64(L + SA_KT, L + SA_M3, ta, tb0, lane, dx); mm64(L + SA_KT, L + SA_BPT, ta, tb0, lane, dw);
#pragma unroll
        for (int t2 = 0; t2 < 2; ++t2) { const int j = 16 * (tb0 + t2) + fr;
            *(LAS unsigned long long*)(L + SA_X1 + swz(j, i0)) = pk4(dx[t2]);
            *(LAS unsigned long long*)(L + SA_WT + swz(j, i0)) = pk4(dw[t2]); }
    }
    SC_BAR();
    const size_t ub = ((size_t)h * NCHUNK + c) * 4096;
    {
        f32x4 dr[2] = {{0.f, 0.f, 0.f, 0.f}, {0.f, 0.f, 0.f, 0.f}}, dp[2] = {{0.f, 0.f, 0.f, 0.f}, {0.f, 0.f, 0.f, 0.f}}, dk[2] = {{0.f, 0.f, 0.f, 0.f}, {0.f, 0.f, 0.f, 0.f}};
        mm64(L + SA_ATT, L + SA_X1, ta, tb0, lane, dr); mm64(L + SA_M2T, L + SA_X1, ta, tb0, lane, g4); mm64(L + SA_ATT, L + SA_WT, ta, tb0, lane, dp); mm64(L + SA_M2T, L + SA_WT, ta, tb0, lane, dk);
        const LAS float* LWe = (const LAS float*)(L + SA_LW) + 63 * 64;
        f32x4 rk[2], kk2[2];
#pragma unroll
        for (int t2 = 0; t2 < 2; ++t2) { const int j = 16 * (tb0 + t2) + fr; rk[t2] = up4(*(const LAS unsigned long long*)(L + SA_RT + swz(j, i0))); kk2[t2] = up4(*(const LAS unsigned long long*)(L + SA_KPT + swz(j, i0))); }
        SC_BAR();
#pragma unroll
        for (int t2 = 0; t2 < 2; ++t2) { const int j = 16 * (tb0 + t2) + fr;
            dr[t2] = dr[t2] + rk[t2]; dk[t2] = dk[t2] + kk2[t2];
#pragma unroll
            for (int q = 0; q < 4; ++q) if (i0 + q == j) dp[t2][q] += __expf(LWe[j]);
            *(GAS unsigned long long*)(B.RPP + ub + j * 64 + i0) = pk4(dr[t2]);
            *(GAS unsigned long long*)(B.PT + ub + (((i0 >> 4) * 64 + j) * 2 + ((i0 >> 2) & 1)) * 8 + ((i0 >> 3) & 1) * 4) = pk4(dp[t2]);
            *(LAS unsigned long long*)(L + SA_G + swz(j, i0)) = pk4(g4[t2]);
            *(LAS unsigned long long*)(L + SA_KPPT + swz(j, i0)) = pk4(dk[t2]); }
    }
    SC_BAR();
    {
        f32x4 dy[2] = {{0.f, 0.f, 0.f, 0.f}, {0.f, 0.f, 0.f, 0.f}}, dq[2] = {{0.f, 0.f, 0.f, 0.f}, {0.f, 0.f, 0.f, 0.f}};
        mm64(L + SA_VTT, L + SA_G, ta, tb0, lane, dy); mm64(L + SA_KPPT, L + SA_VTT, ta, tb0, lane, dq);
#pragma unroll
        for (int t2 = 0; t2 < 2; ++t2) { const int j = 16 * (tb0 + t2) + fr;
            *(GAS f32x4*)(B.YG + ub + j * 64 + i0) = dy[t2];
            *(GAS f32x4*)(B.QT + ub + (((i0 >> 3) * 64 + j) * 2 + ((i0 >> 2) & 1)) * 4) = dq[t2]; }
    }
    SC_BAR();
}
__device__ __forceinline__ unsigned long long ld8(const bf16_t* p) { return *(const GAS unsigned long long*)p; }
__device__ __forceinline__ void scanB_wave(const bf16_t* PT, const float* QT, bf16_t* SC, int h, int ib, int lane) {
    const int c31 = lane & 31, hh = lane >> 5;
    f32x16_t xa[2];
#pragma unroll
    for (int r = 0; r < 16; ++r) { xa[0][r] = 0.f; xa[1][r] = 0.f; }
    u32x4 pa[2][2][2]; f32x4 qa[2][4];
    auto loadPQ = [&](int c, u32x4 (&p)[2][2][2], f32x4 (&q)[2][4]) {
        const size_t ub = ((size_t)h * NCHUNK + c) * 4096;
#pragma unroll
        for (int a = 0; a < 2; ++a) {
#pragma unroll
            for (int nb = 0; nb < 2; ++nb)
#pragma unroll
                for (int s = 0; s < 2; ++s) p[a][nb][s] = *(const GAS u32x4*)(PT + ub + (((2 * nb + s) * 64 + 32 * a + c31) * 2 + hh) * 8);
#pragma unroll
            for (int g = 0; g < 4; ++g) q[a][g] = *(const GAS f32x4*)(QT + ub + (((4 * a + g) * 64 + 32 * ib + c31) * 2 + hh) * 4); }
    };
    auto step = [&](int c, const u32x4 (&p)[2][2][2], const f32x4 (&q)[2][4]) {
        const size_t ub = ((size_t)h * NCHUNK + c) * 4096;
        bf16x8_t bfrag[2][2];
#pragma unroll
        for (int nb = 0; nb < 2; ++nb) {
#pragma unroll
            for (int s = 0; s < 2; ++s) { u32x4 w;
#pragma unroll
                for (int z = 0; z < 4; ++z) w[z] = pk2(xa[nb][8 * s + 2 * z], xa[nb][8 * s + 2 * z + 1]);
                bfrag[nb][s] = __builtin_bit_cast(bf16x8_t, w);
                *(GAS unsigned long long*)(SC + ub + ((4 * nb + 2 * s + 0) * 64 + 32 * ib + c31) * 8 + 4 * hh) = (unsigned long long)w[0] | ((unsigned long long)w[1] << 32);
                *(GAS unsigned long long*)(SC + ub + ((4 * nb + 2 * s + 1) * 64 + 32 * ib + c31) * 8 + 4 * hh) = (unsigned long long)w[2] | ((unsigned long long)w[3] << 32); } }
#pragma unroll
        for (int a = 0; a < 2; ++a) { f32x16_t ya;
#pragma unroll
            for (int r = 0; r < 16; ++r) ya[r] = q[a][r >> 2][r & 3];
#pragma unroll
            for (int nb = 0; nb < 2; ++nb)
#pragma unroll
                for (int s = 0; s < 2; ++s) ya = __builtin_amdgcn_mfma_f32_32x32x16_bf16(__builtin_bit_cast(bf16x8_t, p[a][nb][s]), bfrag[nb][s], ya, 0, 0, 0);
            xa[a] = ya; }
    };
    u32x4 pb[2][2][2]; f32x4 qb[2][4];
    loadPQ(0, pa, qa);
    for (int c = 0; c < NCHUNK; c += 2) {
        loadPQ(c + 1, pb, qb);
        step(c, pa, qa);
        loadPQ(c + 2 < NCHUNK ? c + 2 : c + 1, pa, qa);
        step(c + 1, pb, qb);
    }
}
__device__ __forceinline__ void scanC_unit(LAS unsigned char* L, const bf16_t* SC, const bf16_t* RPP, const float* YG, const bf16_t* EG, const bf16_t* EBV, const float* lnx_w, const float* lnx_b, bf16_t* MIXED,
                                           int h, int c, int tid, int wave, int lane) {
    const size_t ub = ((size_t)h * NCHUNK + c) * 4096;
    { const int row = tid >> 3, k0 = (tid & 7) * 8, srow = tid & 63, sc8 = tid >> 6;
      *(LAS u32x4*)(L + swz(srow, 8 * sc8)) = *(const GAS u32x4*)(SC + ub + (sc8 * 64 + srow) * 8);
      *(LAS u32x4*)(L + 8192 + swz(row, k0)) = *(const GAS u32x4*)(RPP + ub + row * 64 + k0); }
    SC_BAR();
    { const int ta = wave >> 1, tb0 = 2 * (wave & 1), fr = lane & 15, fq = lane >> 4, i0 = 16 * ta + 4 * fq;
      f32x4 d[2] = {{0.f, 0.f, 0.f, 0.f}, {0.f, 0.f, 0.f, 0.f}};
      mm64(L, L + 8192, ta, tb0, lane, d);
#pragma unroll
      for (int t2 = 0; t2 < 2; ++t2) { const int j = 16 * (tb0 + t2) + fr; *(LAS f32x4*)(L + 16384 + (j * 64 + i0) * 4) = d[t2] + *(const GAS f32x4*)(YG + ub + j * 64 + i0); } }
    SC_BAR();
    { const int tau = tid >> 3, i8 = (tid & 7) * 8, t = c * 64 + tau, ch = h * 64 + i8;
      f32x4 y0 = *(const LAS f32x4*)(L + 16384 + (tau * 64 + i8) * 4), y1 = *(const LAS f32x4*)(L + 16384 + (tau * 64 + i8 + 4) * 4);
      const float mean = sum8(((y0[0] + y0[1]) + (y0[2] + y0[3])) + ((y1[0] + y1[1]) + (y1[2] + y1[3]))) * (1.f / 64.f);
      y0 = y0 - mean; y1 = y1 - mean;
      const float rstd = rsqrtf(sum8(((y0[0] * y0[0] + y0[1] * y0[1]) + (y0[2] * y0[2] + y0[3] * y0[3])) + ((y1[0] * y1[0] + y1[1] * y1[1]) + (y1[2] * y1[2] + y1[3] * y1[3]))) * (1.f / 64.f) + LNX_EPS);
      const u32x4 eg = *(const GAS u32x4*)(EG + (size_t)t * RW + ch), eb = *(const GAS u32x4*)(EBV + (size_t)t * RW + ch);
      const f32x4 w0 = *(const GAS f32x4*)(lnx_w + ch), w1 = *(const GAS f32x4*)(lnx_w + ch + 4), b0 = *(const GAS f32x4*)(lnx_b + ch), b1 = *(const GAS f32x4*)(lnx_b + ch + 4);
      float o[8];
#pragma unroll
      for (int e = 0; e < 8; ++e) { const int sh = (e & 1) * 16, q = e >> 1; const float g = __uint_as_float((eg[q] >> sh) << 16), bv = __uint_as_float((eb[q] >> sh) << 16);
          const float yv = e < 4 ? y0[e & 3] : y1[e & 3], lw = e < 4 ? w0[e & 3] : w1[e & 3], lb = e < 4 ? b0[e & 3] : b1[e & 3];
          o[e] = (yv * rstd * lw + lb + bv) * g; }
      u32x4 w;
#pragma unroll
      for (int q = 0; q < 4; ++q) w[q] = pk2(o[2 * q], o[2 * q + 1]);
      *(GAS u32x4*)(MIXED + (size_t)t * DM + ch) = w; }
    SC_BAR();
}
constexpr int MS_ROWS = 320, MS_AP = MS_ROWS / 64  , MS_A = 0, MS_B = 49152, MS_STAGE = 65536;
#define MS_BAR() do { asm volatile("s_waitcnt lgkmcnt(0)" ::: "memory"); __builtin_amdgcn_s_barrier(); asm volatile("" ::: "memory"); } while (0)
template <int MODE>
__device__ __forceinline__ void moe_stream_unit(LAS unsigned char* L, const bf16_t* A, int lda_, const float* W0, const float* W1, int ldw_, int ncol0, int K, int row0, int cnt, bf16_t* HID, float* YC, int tid, int wave, int lane,
                                                f32x4& pb0, f32x4& pb1, f32x4& pb2, f32x4& pb3, bool& have0, bool nvalid, const float* W0n, const float* W1n, int ncol0n) {
    constexpr int nK = MODE == 0 ? DM / 64 : D_EXP / 64, lda = MODE == 0 ? DM : D_EXP, ldw = MODE == 0 ? D_EXP : DM;
    static_assert(nK % 2 == 0 && nK >= 6, "K-loop rotation");
    (void)K; (void)lda_; (void)ldw_; (void)YC;
    if (cnt <= 0) { have0 = false; return; }
    typedef unsigned u32x2_t __attribute__((ext_vector_type(2)));
    const int fr = lane & 15, fq = lane >> 4, wn = wave >> 2, wm = (wave + 2 * wn) & 3;
    const int mh = __builtin_amdgcn_readfirstlane(wave & 1), kq = __builtin_amdgcn_readfirstlane(wave >> 1);
    const float* wbase = (MODE == 0 ? (mh ? W1 : W0) : W0 + mh * 64) + ncol0 + (size_t)(16 * kq) * ldw;
    const __amdgpu_buffer_rsrc_t wrsrc = __builtin_amdgcn_make_buffer_rsrc((void*)wbase, 0, 0x7fffffff, 0x00020000);
    const unsigned wlane = (unsigned)((fq * 4 * ldw + fr * 4) * 4), alane = (unsigned)(((tid >> 3) * lda + (tid & 7) * 8) * 2);
    const int awoff = (tid >> 3) * 128 + (((tid & 7) ^ ((tid >> 3) & 7)) << 4);
    const int bwrow = (mh * 64 + 4 * fr) * 128 + (fq & 1) * 8, bwc = (kq * 2 + (fq >> 1)) ^ (fr & 7) ^ ((fr & 1) << 2);
    const int offk0 = fr * 128 + (((0 + fq) ^ (fr & 7)) << 4) + wm * 2048, offk1 = fr * 128 + (((4 + fq) ^ (fr & 7)) << 4) + wm * 2048;
    const int bnb = MS_B + (MODE == 0 ? 2 * wn : 4 * wn) * 2048;
    const int bkx = fr * 128 + ((fq ^ (fr & 7) ^ (fr >> 2)) << 4) + bnb, bky = bkx ^ 64;
    for (int pass0 = 0; pass0 < cnt; pass0 += MS_ROWS) {
        const int rows = (cnt - pass0) < MS_ROWS ? (cnt - pass0) : MS_ROWS, ntiles = (rows + 15) >> 4;
      auto body = [&](auto nmt_, auto nap_) __attribute__((always_inline)) {
        constexpr int NMT = decltype(nmt_)::value, NAP = decltype(nap_)::value;
        const bf16_t* Ap = A + (size_t)(row0 + pass0) * lda;
        const __amdgpu_buffer_rsrc_t arsrc = __builtin_amdgcn_make_buffer_rsrc((void*)Ap, 0, rows * lda * 2, 0x00020000);
        u32x4 a0[NAP]; f32x4 b0[4] = {pb0, pb1, pb2, pb3};
        f32x4 acc[NMT][4];
#pragma unroll
        for (int i = 0; i < NMT; ++i)
#pragma unroll
            for (int t = 0; t < 4; ++t) acc[i][t] = (f32x4){0.f, 0.f, 0.f, 0.f};
#define MS_LOADA(kt, ar) do { _Pragma("unroll") for (int i = 0; i < NAP; ++i) ar[i] = __builtin_bit_cast(u32x4, __builtin_amdgcn_raw_buffer_load_b128(arsrc, alane, (unsigned)(((64 * i) * lda + (kt) * 64) * 2), 0)); } while (0)
#define MS_LOADW(kt, b) do { _Pragma("unroll") for (int j = 0; j < 4; ++j) b[j] = __builtin_bit_cast(f32x4, __builtin_amdgcn_raw_buffer_load_b128(wrsrc, wlane, (unsigned)((((kt) * 64 + j) * ldw) * 4), 2  )); } while (0)
#define MS_WRITE(st, ar, b) do { _Pragma("unroll") for (int i = 0; i < NAP; ++i) *(LAS u32x4*)(L + awoff + ((st) * MS_STAGE + MS_A + i * 8192)) = ar[i]; \
            _Pragma("unroll") for (int c = 0; c < 4; ++c) { const u32x2_t w_ = {pg8::cvt_pk_bf16(b[0][c], b[1][c]), pg8::cvt_pk_bf16(b[2][c], b[3][c])}; \
                *(LAS u32x2_t*)(L + bwrow + ((bwc ^ c) << 4) + ((st) * MS_STAGE + MS_B + c * 128)) = w_; } } while (0)
        LAS unsigned char* const ak00 = L + offk0 + MS_A, * const ak01 = L + offk1 + MS_A, * const ak10 = L + offk0 + MS_STAGE + MS_A, * const ak11 = L + offk1 + MS_STAGE + MS_A;
        LAS unsigned char* const bk0x = L + bkx, * const bk0y = L + bky, * const bk1x = L + bkx + MS_STAGE, * const bk1y = L + bky + MS_STAGE;
#define MS_DSR(dst, base, off) asm volatile("ds_read_b128 %0, %1 offset:%2" : "=v"(dst) : "v"(base), "n"(off) : "memory")
#define MS_BOFF(t) ((MODE == 0 ? (((t) < 2 ? 0 : 4) + ((t) & 1)) : (t)) * 2048)
#define MS_RD(F, st, ks) do { _Pragma("unroll") for (int i = 0; i < NMT; ++i) MS_DSR(F##a[i], ((st) ? ((ks) ? ak11 : ak10) : ((ks) ? ak01 : ak00)), i * 8192); \
            _Pragma("unroll") for (int t = 0; t < 4; ++t) MS_DSR(F##b[t], ((st) ? ((((ks) ^ t) & 1) ? bk1y : bk1x) : ((((ks) ^ t) & 1) ? bk0y : bk0x)), MS_BOFF(t)); } while (0)
#define MS_TIE8(F) "+v"(F##a[0]), "+v"(F##a[1]), "+v"(F##a[2]), "+v"(F##a[3]), "+v"(F##b[0]), "+v"(F##b[1]), "+v"(F##b[2]), "+v"(F##b[3])
#define MS_WAITL(n, F) do { if constexpr (NMT == 5) asm volatile("s_waitcnt lgkmcnt(" #n ")" : MS_TIE8(F), "+v"(F##a[NMT - 1]) :: "memory"); else asm volatile("s_waitcnt lgkmcnt(" #n ")" : MS_TIE8(F) :: "memory"); } while (0)
#define MS_WAITN(F) do { if constexpr (NMT == 5) asm volatile("s_waitcnt lgkmcnt(9)" : MS_TIE8(F), "+v"(F##a[NMT - 1]) :: "memory"); else asm volatile("s_waitcnt lgkmcnt(8)" : MS_TIE8(F) :: "memory"); } while (0)
#define MS_BART(F) do { if constexpr (NMT == 5) asm volatile("s_waitcnt lgkmcnt(0)\n\ts_barrier" : MS_TIE8(F), "+v"(F##a[NMT - 1]) :: "memory"); else asm volatile("s_waitcnt lgkmcnt(0)\n\ts_barrier" : MS_TIE8(F) :: "memory"); } while (0)
#define MS_MM(F) do { _Pragma("unroll") for (int i = 0; i < NMT; ++i) \
            _Pragma("unroll") for (int t = 0; t < 4; ++t) acc[i][t] = __builtin_amdgcn_mfma_f32_16x16x32_bf16(F##b[t], F##a[i], acc[i][t], 0, 0, 0); } while (0)
#define MS_SB() __builtin_amdgcn_sched_barrier(0)
#define MS_ITER(st, WR, LD) do { MS_RD(f1, st, 1); MS_WAITN(f0); MS_MM(f0); MS_SB(); WR; LD; MS_BART(f1); MS_RD(f0, 1 - (st), 0); MS_MM(f1); MS_SB(); } while (0)
        bf16x8_t f0a[NMT], f0b[4], f1a[NMT], f1b[4];
        MS_LOADA(0, a0); if (!(have0 && pass0 == 0)) MS_LOADW(0, b0);
        MS_WRITE(0, a0, b0); MS_LOADA(1, a0); MS_LOADW(1, b0);
        MS_BAR();
        MS_RD(f0, 0, 0);
        int kt = 0;
        for (; kt + 4 <= nK; kt += 2) {
            MS_ITER(0, MS_WRITE(1, a0, b0), { MS_LOADA(kt + 2, a0); MS_LOADW(kt + 2, b0); });
            MS_ITER(1, MS_WRITE(0, a0, b0), { MS_LOADA(kt + 3, a0); MS_LOADW(kt + 3, b0); });
        }
        MS_ITER(0, MS_WRITE(1, a0, b0), (void)0);
        if (nvalid && pass0 + MS_ROWS >= cnt) {
            const float* wbn = (MODE == 0 ? (mh ? W1n : W0n) : W0n + mh * 64) + ncol0n + (size_t)(16 * kq) * ldw;
            const __amdgpu_buffer_rsrc_t wrn = __builtin_amdgcn_make_buffer_rsrc((void*)wbn, 0, 0x7fffffff, 0x00020000);
#pragma unroll
            for (int j = 0; j < 4; ++j) b0[j] = __builtin_bit_cast(f32x4, __builtin_amdgcn_raw_buffer_load_b128(wrn, wlane, (unsigned)((j * ldw) * 4), 2));
            pb0 = b0[0]; pb1 = b0[1]; pb2 = b0[2]; pb3 = b0[3]; }
        MS_RD(f1, 1, 1); MS_WAITN(f0); MS_MM(f0); MS_WAITL(0, f1); MS_MM(f1);
#undef MS_ITER
#undef MS_SB
#undef MS_BART
#undef MS_WAITL
#undef MS_WAITN
#undef MS_TIE8
#undef MS_DSR
#undef MS_MM
#undef MS_RD
#undef MS_BOFF
#undef MS_LOADA
#undef MS_LOADW
#undef MS_WRITE
        const __amdgpu_buffer_rsrc_t orsrc = __builtin_amdgcn_make_buffer_rsrc((void*)HID, 0, 0x7fffffff, 0x00020000);
        const unsigned olane = MODE == 0 ? (unsigned)((fr * D_EXP + 4 * fq) * 2) : (unsigned)((fr * DM + 4 * fq) * 2);
#pragma unroll
        for (int i = 0; i < NMT; ++i) { const int mt = wm + 4 * i; if (mt < ntiles) { const unsigned rowb = (unsigned)(row0 + pass0 + 16 * mt);
            if (MODE == 0) {
#pragma unroll
                for (int t = 0; t < 2; ++t) { f32x4 hv;
#pragma unroll
                    for (int r = 0; r < 4; ++r) { const float gt = acc[i][t][r]; hv[r] = gt * __builtin_amdgcn_rcpf(1.0f + __builtin_amdgcn_exp2f(-1.4426950408889634f * gt)) * acc[i][t + 2][r]; }
                    const u32x2_t w2 = {pk2(hv[0], hv[1]), pk2(hv[2], hv[3])};
                    __builtin_amdgcn_raw_buffer_store_b64(w2, orsrc, olane, (rowb * D_EXP + ncol0 + 16 * (2 * wn + t)) * 2u, 0); }
            } else {
#pragma unroll
                for (int t = 0; t < 4; ++t) { const u32x2_t w2 = {pk2(acc[i][t][0], acc[i][t][1]), pk2(acc[i][t][2], acc[i][t][3])};
                    __builtin_amdgcn_raw_buffer_store_b64(w2, orsrc, olane, (rowb * DM + ncol0 + 16 * (4 * wn + t)) * 2u, 0); }
            } } }
      };
        if (rows <= 256) body(std::integral_constant<int, 4>{}, std::integral_constant<int, 4>{});
        else body(std::integral_constant<int, 5>{}, std::integral_constant<int, 5>{});
    }
    have0 = nvalid;
}
constexpr int NWAVES = 8;
constexpr int RING_OFF = 0, RING_BYTES = 131072;
constexpr int LDSCTL_OFF = RING_BYTES, MISC_OFF = LDSCTL_OFF + 320;
constexpr int LDS_BYTES = 147456;
enum Phase { PH_PRO = 0, PH_INPROJ = 1, PH_MEMPRE = 2, PH_LORA = 3, PH_SCANA = 4, PH_SCANB = 5, PH_SCANC = 6, PH_ATTN = 7, PH_POST = 8, PH_OUTPROJ = 9, PH_HN1 = 10, PH_SCORES = 11, PH_MEMOUT = 12,
             PH_ROUTER = 13, PH_GATHER = 14, PH_GATEUP = 15, PH_DOWN = 16, PH_FINAL = 17, PH_N = 18, PH_X1 = 18, PH_X2 = 19, PH_X3 = 20 };

__device__ __forceinline__ float wave_sum(float v) {
#pragma unroll
    for (int o = 1; o < 64; o <<= 1) v += __shfl_xor(v, o);
    return v;
}
__device__ __forceinline__ void tr_item(const float* W, int pitch, int ncols, int K, bf16_t* WT, int ldt, int mode, LAS float* scr, int item, int lane) {
    const int nblk = ncols / 32, kb = item / nblk, nb = item % nblk, k0 = 64 * kb, n0 = 32 * nb;
#pragma unroll 8
    for (int i = 0; i < 32; ++i) { const int kk = 2 * i + (lane >> 5); scr[kk * 33 + (lane & 31)] = W[(size_t)(k0 + kk) * pitch + n0 + (lane & 31)]; }
    LDS_WAIT(); asm volatile("" ::: "memory");
    const int c = lane & 7;
#pragma unroll
    for (int j = 0; j < 4; ++j) { const int n = (lane >> 3) + 8 * j; const LAS float* s = scr + (8 * c) * 33 + n;
        v4u o; o.x = pk2(s[0 * 33], s[1 * 33]); o.y = pk2(s[2 * 33], s[3 * 33]); o.z = pk2(s[4 * 33], s[5 * 33]); o.w = pk2(s[6 * 33], s[7 * 33]);
        *(GAS v4u*)(WT + (size_t)row_map(mode, n0 + n) * ldt + k0 + 8 * c) = o; }
    LDS_WAIT(); asm volatile("" ::: "memory");
}
__device__ __forceinline__ void tr_job(const float* W, int pitch, int ncols, int K, bf16_t* WT, int mode, int nmat, size_t wstride, size_t tstride, LAS float* scr, int gw, int NGW, int lane, int ldt = 0) {
    if (ldt == 0) ldt = K;
    const int per = (K / 64) * (ncols / 32), total = per * nmat;
    for (int it = gw; it < total; it += NGW) { const int mat = it / per, r = it - mat * per; tr_item(W + (size_t)mat * wstride, pitch, ncols, K, WT + (size_t)mat * tstride, ldt, mode, scr, r, lane); }
}
__device__ __forceinline__ void rms_row_bf16(const float* xrow, const float* g, bf16_t* orow, int lane) {
    const GAS f32x4* xr = (const GAS f32x4*)xrow + lane; const GAS f32x4* gr = (const GAS f32x4*)g + lane;
    f32x4 v[8], g8[8]; float s = 0.f;
#pragma unroll
    for (int j = 0; j < 8; ++j) { v[j] = xr[64 * j]; g8[j] = gr[64 * j]; }
#pragma unroll
    for (int j = 0; j < 8; ++j) s += (v[j].x * v[j].x + v[j].y * v[j].y) + (v[j].z * v[j].z + v[j].w * v[j].w);
    const float rs = rsqrtf(wave_sum(s) * (1.f / DM) + NORM_EPS);
    GAS unsigned long long* o8 = (GAS unsigned long long*)orow + lane;
#pragma unroll
    for (int j = 0; j < 8; ++j) { const f32x4 gg = g8[j]; o8[64 * j] = (unsigned long long)pk2(v[j].x * rs * gg.x, v[j].y * rs * gg.y) | ((unsigned long long)pk2(v[j].z * rs * gg.z, v[j].w * rs * gg.w) << 32); }
}

__device__ __forceinline__ const float* inf_fresh(const float* p) { asm volatile("" : "+s"(p)); return p; }
struct Args { const float* in[34]; float* out; unsigned char* ws; int ph_lo, ph_hi, li, pad; };
__global__ void __launch_bounds__(NWAVES * 64, 2) mk_fwd(Args args) {
    extern __shared__ __attribute__((aligned(16))) unsigned char lds[];
    LAS unsigned char* const L = (LAS unsigned char*)lds;
    volatile LAS unsigned* const MISC = (volatile LAS unsigned*)(L + MISC_OFF);
    const int tid = threadIdx.x, lane = tid & 63, wave = __builtin_amdgcn_readfirstlane(tid >> 6);
    const int G = gridDim.x; const int bx = blockIdx.x; const int vcu = __builtin_amdgcn_readfirstlane((G % 8 == 0) ? (bx % 8) * (G / 8) + bx / 8 : bx);
    unsigned char* ws = args.ws;
    gu32* ctl = (gu32*)(ws + WS_CTL);
    for (int u = tid; u < (LDS_BYTES - LDSCTL_OFF) / 4; u += NWAVES * 64) ((LAS unsigned*)(L + LDSCTL_OFF))[u] = 0u;
    __syncthreads();
    XcdBarrier bar = xcd_barrier_post((unsigned*)(ctl + CW_BAR) + args.li * XCD_BAR_WORDS, MISC + 8);
    const int lo = args.ph_lo, hi = args.ph_hi;
#define IN(k) (lo <= (k) && (k) < hi)
#define FRESH_IDS int tid_f_ = (int)threadIdx.x; asm volatile("" : "+v"(tid_f_)); const int tid = tid_f_, lane = tid_f_ & 63; (void)tid; (void)lane
#define SEAM(k) do { if ((k) + 1 < hi) xcd_barrier(bar); } while (0)
    const int gw = vcu * NWAVES + wave, NGW = G * NWAVES;
#define WSP(T, off) ((T*)(ws + (off)))
#define INF(i) (args.in[i])
    if (IN(PH_PRO)) {
        FRESH_IDS;
        LAS float* scr = (LAS float*)(L + RING_OFF + wave * 16384);
        tr_job(INF(4), IN_COLS, RWKV_COLS, DM, WSP(bf16_t, WS_WINT), 0, 1, 0, 0, scr, gw, NGW, lane);
        tr_job(INF(4) + RWKV_COLS, IN_COLS, 2 * QK_COLS, DM, WSP(bf16_t, WS_WINT) + (size_t)RWKV_COLS * DM, 1, 1, 0, 0, scr, gw, NGW, lane);
        tr_job(INF(4) + RWKV_COLS + 2 * QK_COLS, IN_COLS, 1024, DM, WSP(bf16_t, WS_WINT) + (size_t)(RWKV_COLS + 2 * QK_COLS) * DM, 0, 1, 0, 0, scr, gw, NGW, lane);
        tr_job(INF(22), DM, DM, DM, WSP(bf16_t, WS_WKVT), 0, 1, 0, 0, scr, gw, NGW, lane);
        tr_job(INF(23), DM, DM, DM, WSP(bf16_t, WS_WKVT) + (size_t)DM * DM, 0, 1, 0, 0, scr, gw, NGW, lane);
        {
            const double invrev = pow(10000.0, -(double)((gw * 64 + lane) & 31) / 32.0) * 0.15915494309189533577;
            for (int i = gw * 64 + lane; i < SEQ * 32; i += NGW * 64) { const int t = i >> 5;
                const double rev = (double)((const int*)INF(2))[t] * invrev; const float fr = (float)(rev - rint(rev));
                WSP(float, WS_ROPE)[2 * i] = __builtin_amdgcn_cosf(fr); WSP(float, WS_ROPE)[2 * i + 1] = __builtin_amdgcn_sinf(fr); } }
        for (int m = gw; m < SEQ; m += NGW) rms_row_bf16(INF(0) + (size_t)m * DM, INF(3), WSP(bf16_t, WS_XN) + (size_t)m * DM, lane);
        for (int m = gw; m < MEM_LEN; m += NGW) rms_row_bf16(INF(1) + (size_t)m * DM, INF(20), WSP(bf16_t, WS_MEMN) + (size_t)m * DM, lane);
        SEAM(PH_PRO);
    }
    if (IN(PH_INPROJ)) {
        FRESH_IDS;
        { pg8::Gemm g{WSP(bf16_t, WS_XN), WSP(bf16_t, WS_WINT), SEQ, IN_COLS, DM, DM, DM}; pg8::StaticOrder S; S.init(SEQ, IN_COLS, G, bx);
          pg8::EpiInProj E{WSP(bf16_t, WS_PR), WSP(bf16_t, WS_QB), WSP(bf16_t, WS_KB), WSP(bf16_t, WS_VB), WSP(float, WS_ROPE)};
          pg8::gemm_phase<pg8::EpiInProj, pg8::StaticOrder, true, true>(L + RING_OFF, g, S, E); }
        { pg8::Gemm g{WSP(bf16_t, WS_MEMN), WSP(bf16_t, WS_WKVT), MEM_LEN, 2 * DM, DM, DM, DM}; pg8::StaticOrder S; S.init(MEM_LEN, 2 * DM, G, (bx + G - 32) % G);
          pg8::EpiKV E{WSP(bf16_t, WS_KVH)};
          pg8::gemm_phase<pg8::EpiKV, pg8::StaticOrder, true, true>(L + RING_OFF, g, S, E); }
        if (bx >= 48 || G <= 48) { const int gw2 = (G > 48 ? bx - 48 : bx) * NWAVES + wave, NGW2 = (G > 48 ? G - 48 : G) * NWAVES;
            __syncthreads();
            LAS float* scr = (LAS float*)(L + RING_OFF + wave * 16384);
            tr_job(INF(18), DM, DM, DM, WSP(bf16_t, WS_WOUTT), 0, 1, 0, 0, scr, gw2, NGW2, lane);
            tr_job(INF(24), DM, DM, MEM_HD, WSP(bf16_t, WS_WOTH), 0, MEM_HEADS, (size_t)MEM_HD * DM, (size_t)DM * MEM_HD, scr, gw2, NGW2, lane);
            for (int i = gw2 * 64 + lane; i < 80 * DM; i += NGW2 * 64) { const int col = i >> 11, k = i & 2047;
                const float w = col < 8 ? INF(26)[(size_t)k * 8 + col] : (col < 72 ? INF(28)[(size_t)k * 64 + col - 8] : 0.f);
                WSP(float, WS_RT)[i] = w * INF(25)[k]; }
            tr_job(INF(7), RW, RW, 64, WSP(bf16_t, WS_WLORA), 0, 1, 0, 0, scr, gw2, NGW2, lane, 256);
            tr_job(INF(9), RW, RW, 64, WSP(bf16_t, WS_WLORA) + (size_t)1024 * 256 + 64, 0, 1, 0, 0, scr, gw2, NGW2, lane, 256);
            tr_job(INF(10), RW, RW, 128, WSP(bf16_t, WS_WLORA) + (size_t)2048 * 256 + 128, 0, 1, 0, 0, scr, gw2, NGW2, lane, 256);
            for (int i = gw2 * 64 + lane; i < 3072 * 32; i += NGW2 * 64) { const int n = i >> 5, col = (i & 31) * 8, sec = n >> 10;
                const bool inblk = (sec == 0 && col < 64) || (sec == 1 && col >= 64 && col < 128) || (sec == 2 && col >= 128);
                if (!inblk) *(GAS v4u*)(WSP(bf16_t, WS_WLORA) + (size_t)n * 256 + col) = (v4u){0u, 0u, 0u, 0u}; }
            for (int i = gw2 * 64 + lane; i < DM * DM / 8; i += NGW2 * 64) { const int k = i >> 8, gc = (i & 255) * 8, h = gc >> 9, d = gc & 511;
                const f32x4 a = *(const GAS f32x4*)(INF(21) + (size_t)k * DM + gc), b = *(const GAS f32x4*)(INF(21) + (size_t)k * DM + gc + 4);
                v4u o; o.x = pk2(a.x, a.y); o.y = pk2(a.z, a.w); o.z = pk2(b.x, b.y); o.w = pk2(b.z, b.w);
                *(GAS v4u*)(WSP(bf16_t, WS_WQBH) + ((size_t)h * DM + k) * MEM_HD + d) = o; }
        }
        SEAM(PH_INPROJ);
    }
    if (IN(PH_MEMPRE)) {
        FRESH_IDS;
        {
            const float* mu = INF(5);
            for (int i = (bx * NWAVES * 64 + tid); i < SEQ * 32; i += G * NWAVES * 64) { const int t = i >> 5, j0 = (i & 31) * 8;
                const bf16_t* cur = WSP(bf16_t, WS_PR) + (size_t)t * RWKV_COLS + 3072 + j0;
                const u32x4 cv = *(const GAS u32x4*)cur; u32x4 pv = {0u, 0u, 0u, 0u}; if (t > 0) pv = *(const GAS u32x4*)(cur - RWKV_COLS);
                float o[8];
#pragma unroll
                for (int e = 0; e < 8; ++e) { const int sh = (e & 1) * 16, q = e >> 1; const float x = __uint_as_float((cv[q] >> sh) << 16), p = __uint_as_float((pv[q] >> sh) << 16), v = x + (p - x) * mu[3072 + j0 + e];
                    o[e] = j0 < 64 ? 1.f - 2.f * __builtin_amdgcn_rcpf(1.f + __expf(2.f * v))   : (j0 < 128 ? v : __builtin_amdgcn_rcpf(1.f + __expf(-v))  ); }
                u32x4 w;
#pragma unroll
                for (int q = 0; q < 4; ++q) w[q] = pk2(o[2 * q], o[2 * q + 1]);
                *(GAS u32x4*)(WSP(bf16_t, WS_XL) + (size_t)t * 256 + j0) = w; }
        }
        SEAM(PH_MEMPRE);
    }
    if (IN(PH_LORA)) {
        FRESH_IDS;
        pg8::Gemm g{WSP(bf16_t, WS_XL), WSP(bf16_t, WS_WLORA), SEQ, 3072, 256, 256, 256}; pg8::StaticOrder S; S.init(SEQ, 3072, G, bx);
        pg8::EpiBfGen E{WSP(bf16_t, WS_LG), 3072, 0xffff, 0xffff, 0};
        pg8::gemm_phase<pg8::EpiBfGen, pg8::StaticOrder, false, true>(L + RING_OFF, g, S, E);
        { pg8::Gemm g{WSP(bf16_t, WS_KVH), WSP(bf16_t, WS_WQBH), MEM_HEADS * MEM_LEN, MEM_HEADS * DM, MEM_HD, MEM_HD, MEM_HD}; pg8::HeadOrderS S{G, (bx + G - 128 % G) % G};
          pg8::EpiBfGenCS E{WSP(bf16_t, WS_BTS), DM, 0xffff, 7, 0, INF(19)};
          pg8::gemm_phase<pg8::EpiBfGenCS, pg8::HeadOrderS, true, true>(L + RING_OFF, g, S, E); }
        { pg8::Gemm g{WSP(bf16_t, WS_WOTH), WSP(bf16_t, WS_KVH), MEM_HEADS * DM, 2 * MEM_HEADS * MEM_LEN, MEM_HD, MEM_HD, MEM_HD}; pg8::HeadOrderO S{G, (bx + G - 160 % G) % G};
          pg8::EpiBfGen E{WSP(bf16_t, WS_BTO), MEM_HEADS * MEM_LEN, 7, 0xffff, 4};
          pg8::gemm_phase<pg8::EpiBfGen, pg8::HeadOrderO, true, true>(L + RING_OFF, g, S, E); }
        SEAM(PH_LORA);
    }
    if (IN(PH_SCANA)) {
        FRESH_IDS;
        const ScanW W{INF(5), INF(6), INF(8), INF(11), INF(12), INF(13)};
        const ScanBufs B{WSP(bf16_t, WS_PR), WSP(bf16_t, WS_LG), WSP(bf16_t, WS_RPP), WSP(float, WS_YG), WSP(bf16_t, WS_PT), WSP(float, WS_QT), WSP(bf16_t, WS_EG), WSP(bf16_t, WS_EBV)};
        { const bool hm = G == 256; const int nun = NH_R * NCHUNK;
          auto unit_of = [&](int k, int& h, int& c) { if (hm) { h = bx >> 4; c = (bx & 15) + 16 * k; return k < NCHUNK / 16; } const int u = bx + k * G; h = u / NCHUNK; c = u % NCHUNK; return u < nun; };
          ScanIn cur_; int h0, c0, hl = -1; bool ok = unit_of(0, h0, c0); if (ok) scanA_fetch(B, h0, c0, tid, cur_);
          for (int k = 0; ok; ++k) { ScanIn nxt_ = cur_; int hn, cn; const bool okn = unit_of(k + 1, hn, cn);
              if (h0 != hl) { SC_BAR(); scanA_params(L + RING_OFF, W, h0, tid); hl = h0; SC_BAR(); }
              scanA_unit(L + RING_OFF, W, B, h0, c0, tid, wave, lane, cur_, okn, hn, cn, nxt_, args.pad); cur_ = nxt_; h0 = hn; c0 = cn; ok = okn; } }
        SEAM(PH_SCANA);
    }
    if (IN(PH_SCANB)) {
        FRESH_IDS;
        if (wave == 0 && bx < 2 * NH_R) scanB_wave(WSP(bf16_t, WS_PT), WSP(float, WS_QT), WSP(bf16_t, WS_SC), bx >> 1, bx & 1, lane);
        {
            static_assert(attn_body::ATTN_LDS_BYTES <= RING_BYTES, "attention body LDS");
            const attn_body::AttnTensors AT{(const attn_body::bf16*)WSP(bf16_t, WS_QB), (const attn_body::bf16*)WSP(bf16_t, WS_KB), (const attn_body::bf16*)WSP(bf16_t, WS_VB), (attn_body::bf16*)WSP(bf16_t, WS_O2)};
            const attn_body::QueueOrder S{(unsigned*)(ctl + CW_AQ), MISC + 16, bx & 7, 0u};
            attn_body::attn_phase<attn_body::QueueOrder>((char*)lds + RING_OFF, AT, S);
        }
        SEAM(PH_SCANB);
    }
    if (IN(PH_SCANC)) {
        FRESH_IDS;
        for (int u = bx; u < NH_R * NCHUNK; u += G)
            scanC_unit(L + RING_OFF, WSP(bf16_t, WS_SC), WSP(bf16_t, WS_RPP), WSP(float, WS_YG), WSP(bf16_t, WS_EG), WSP(bf16_t, WS_EBV), INF(14), INF(15), WSP(bf16_t, WS_MIXED), u / NCHUNK, u % NCHUNK, tid, wave, lane);
        __syncthreads();
    }
    if (IN(PH_POST)) {
        FRESH_IDS;
        const float* lp = INF(16); const float lam = __expf(wave_allsum(lp[lane] * lp[64 + lane])) - __expf(wave_allsum(lp[128 + lane] * lp[192 + lane])) + LAMBDA_INIT;
        const int hw = tid >> 8, lt = tid & 255;
        const f32x4 sw = *(const GAS f32x4*)(INF(17) + (lt & 31) * 4);
        for (int t = bx * 2 + hw; t < SEQ; t += 8 * G) diff_post_tokens<4>(WSP(bf16_t, WS_O2), lam, sw, WSP(bf16_t, WS_MIXED), t, 2 * G, lt);
        SEAM(PH_POST);
    }
    if (IN(PH_OUTPROJ)) {
        FRESH_IDS;
        pg8::Gemm g{WSP(bf16_t, WS_MIXED), WSP(bf16_t, WS_WOUTT), SEQ, DM, DM, DM, DM}; pg8::StaticOrder S; S.init(SEQ, DM, G, bx);
        pg8::EpiResidSq E{INF(0), WSP(float, WS_H1), WSP(bf16_t, WS_HN1), WSP(float, WS_PSQ)};
        pg8::gemm_phase<pg8::EpiResidSq, pg8::StaticOrder, false, true>(L + RING_OFF, g, S, E);
        SEAM(PH_OUTPROJ);
    }
    if (IN(PH_HN1)) {
        FRESH_IDS;
    }
    if (IN(PH_SCORES)) {
        FRESH_IDS;
        pg8::Gemm g{WSP(bf16_t, WS_HN1), WSP(bf16_t, WS_BTS), SEQ, MEM_HEADS * MEM_LEN, DM, DM, DM}; pg8::StaticOrder S; S.init(SEQ, MEM_HEADS * MEM_LEN, G, bx);
        pg8::EpiSoftmax E{WSP(bf16_t, WS_PM), 0.044194173824159216f * 1.4426950408889634f};
        pg8::gemm_phase<pg8::EpiSoftmax, pg8::StaticOrder, false, true>(L + RING_OFF, g, S, E);
        SEAM(PH_SCORES);
    }
    if (IN(PH_MEMOUT)) {
        FRESH_IDS;
        pg8::Gemm g{WSP(bf16_t, WS_PM), WSP(bf16_t, WS_BTO), SEQ, DM, MEM_HEADS * MEM_LEN, MEM_HEADS * MEM_LEN, MEM_HEADS * MEM_LEN}; pg8::StaticOrder S; S.init(SEQ, DM, G, bx);
        pg8::EpiResid E{WSP(float, WS_H1), WSP(float, WS_H2)};
        pg8::gemm_phase<pg8::EpiResid, pg8::StaticOrder, false, true>(L + RING_OFF, g, S, E);
        SEAM(PH_MEMOUT);
    }
    if (IN(PH_ROUTER)) {
        FRESH_IDS;
        LAS float* part = (LAS float*)(L + RING_OFF);
        LAS float* ssq = (LAS float*)(L + RING_OFF + 40960);
        LAS unsigned* lh = (LAS unsigned*)(L + RING_OFF + 45056);
        gu32* hist = ctl + CW_HIST;
        const int tl = wave >> 2, kq = wave & 3, fr = lane & 15, fq = lane >> 4;
        int* asg_e = WSP(int, WS_ASG); int* asg_r = asg_e + 2 * SEQ; float* asg_w = (float*)(asg_r + 2 * SEQ);
        for (int it = 0; it < (SEQ / 32 + G - 1) / G; ++it) { const int blk = it * G + bx; const bool on = blk < SEQ / 32; const int t0 = blk * 32 + tl * 16;
            __syncthreads();
            if (tid < N_EXP) lh[tid] = 0u;
            if (on) {
                f32x4 acc[5]; float sq = 0.f;
#pragma unroll
                for (int ct = 0; ct < 5; ++ct) acc[ct] = (f32x4){0.f, 0.f, 0.f, 0.f};
                const GAS float* ap = (const GAS float*)WSP(float, WS_H2) + (size_t)(t0 + fr) * DM + kq * 512 + 4 * fq;
                const GAS float* bp = (const GAS float*)WSP(float, WS_RT) + (size_t)fr * DM + kq * 512 + 4 * fq;
#pragma unroll 2
                for (int kb = 0; kb < 32; ++kb) { const f32x4 av = *(const GAS f32x4*)(ap + kb * 16); f32x4 bv[5];
#pragma unroll
                    for (int ct = 0; ct < 5; ++ct) bv[ct] = *(const GAS f32x4*)(bp + (size_t)ct * 16 * DM + kb * 16);
                    sq += (av[0] * av[0] + av[1] * av[1]) + (av[2] * av[2] + av[3] * av[3]);
#pragma unroll
                    for (int j = 0; j < 4; ++j)
#pragma unroll
                        for (int ct = 0; ct < 5; ++ct) acc[ct] = __builtin_amdgcn_mfma_f32_16x16x4f32(av[j], bv[ct][j], acc[ct], 0, 0, 0); }
                sq = rowpair_sum(sq); { float a2 = sq, b2 = sq; asm("s_nop 1\n\tv_permlane32_swap_b32 %0, %1" : "+v"(a2), "+v"(b2)); sq = a2 + b2; }
                if (fq == 0) ssq[(tl * 4 + kq) * 16 + fr] = sq;
#pragma unroll
                for (int ct = 0; ct < 5; ++ct)
#pragma unroll
                    for (int r = 0; r < 4; ++r) part[((tl * 4 + kq) * 16 + 4 * fq + r) * 80 + ct * 16 + fr] = acc[ct][r]; }
            __syncthreads();
            if (on && tid < 32) { const int tk = tid & 15, tt = tid >> 4, t = blk * 32 + tt * 16 + tk;
                const float s = (ssq[(tt * 4 + 0) * 16 + tk] + ssq[(tt * 4 + 1) * 16 + tk]) + (ssq[(tt * 4 + 2) * 16 + tk] + ssq[(tt * 4 + 3) * 16 + tk]);
                const float rs = rsqrtf(s * (1.f / DM) + NORM_EPS); WSP(float, WS_RS)[t] = rs;
                const LAS float* p0 = part + ((tt * 4 + 0) * 16 + tk) * 80; const float *bg = INF(27), *be = INF(29);
#define LGT(c) ((((p0[c] + p0[1280 + (c)]) + (p0[2560 + (c)] + p0[3840 + (c)])) * rs) + ((c) < 8 ? bg[c] : be[(c) - 8]))
                float gl[8];
#pragma unroll
                for (int i = 0; i < 8; ++i) gl[i] = LGT(i);
                int gi = 0; float gm = gl[0];
#pragma unroll
                for (int i = 1; i < 8; ++i) if (gl[i] > gm) { gm = gl[i]; gi = i; }
                float gs = 0.f;
#pragma unroll
                for (int i = 0; i < 8; ++i) gs += expf(gl[i] - gm);
                const float gwt = 1.f / gs;
                float el[8];
                for (int i = 0; i < 8; ++i) el[i] = LGT(8 + gi * 8 + i);
                int i0 = 0; for (int i = 1; i < 8; ++i) if (el[i] > el[i0]) i0 = i;
                int i1 = -1; for (int i = 0; i < 8; ++i) if (i != i0 && (i1 < 0 || el[i] > el[i1])) i1 = i;
#undef LGT
                const float p1 = expf(el[i1] - el[i0]), w0 = gwt / (1.f + p1), w1 = gwt * p1 / (1.f + p1);
                const int e0 = gi * 8 + i0, e1 = gi * 8 + i1;
                asg_e[2 * t] = e0; asg_e[2 * t + 1] = e1; asg_w[2 * t] = w0; asg_w[2 * t + 1] = w1;
                asg_r[2 * t] = (int)__hip_atomic_fetch_add(lh + e0, 1u, __ATOMIC_RELAXED, __HIP_MEMORY_SCOPE_WORKGROUP); asg_r[2 * t + 1] = (int)__hip_atomic_fetch_add(lh + e1, 1u, __ATOMIC_RELAXED, __HIP_MEMORY_SCOPE_WORKGROUP); }
            __syncthreads();
            if (on && tid < N_EXP) hist[blk * N_EXP + tid] = lh[tid]; }
        SEAM(PH_ROUTER);
    }
    if (IN(PH_GATHER)) {
        FRESH_IDS;
        LAS unsigned* sb = (LAS unsigned*)(L + RING_OFF);
        LAS unsigned* wt = sb + 64;
        LAS unsigned* pre = sb + 1024;
        constexpr int NBLK = SEQ / 32; static_assert(NBLK == 256, "8 waves x 32 blocks");
        const GAS unsigned* hist = (const GAS unsigned*)(ctl + CW_HIST);
        const int nit = (NBLK + G - 1) / G;
        { unsigned v[32];
#pragma unroll
          for (int k = 0; k < 32; ++k) v[k] = hist[(32 * wave + k) * N_EXP + lane];
          unsigned run = 0;
#pragma unroll
          for (int k = 0; k < 32; ++k) { const int blk = 32 * wave + k; if (blk % G == bx) pre[(blk / G) * 64 + lane] = run; run += v[k]; }
          wt[wave * 64 + lane] = run; }
        __syncthreads();
        if (wave == 0) { unsigned off[8], tot = 0;
#pragma unroll
            for (int w = 0; w < 8; ++w) { off[w] = tot; tot += wt[w * 64 + lane]; }
            for (int it = 0; it < nit; ++it) { const int blk = it * G + bx; if (blk < NBLK) { unsigned o = 0;
#pragma unroll
                for (int w = 0; w < 8; ++w) if ((blk >> 5) == w) o = off[w];
                pre[it * 64 + lane] += o; } }
            const unsigned n = (tot + 255u) / 256u; unsigned inc = n;
#pragma unroll
            for (int o = 1; o < 64; o <<= 1) { const unsigned vv = (unsigned)__shfl_up((int)inc, o); if (lane >= o) inc += vv; }
            const unsigned b = (inc - n) * 256u; sb[lane] = b;
            if (bx == 0) { __hip_atomic_store(ctl + CW_BASE + lane, b, RLX_AGENT); __hip_atomic_store(ctl + CW_CNT + lane, tot, RLX_AGENT); } }
        __syncthreads();
        const int* asg_e = WSP(int, WS_ASG); int* asg_r = WSP(int, WS_ASG) + 2 * SEQ;
        for (int it = 0; it < nit; ++it) { const int blk = it * G + bx; if (blk >= NBLK) break;
#pragma unroll 1
          for (int k = 0; k < 4; ++k) { const int t = blk * 32 + wave * 4 + k;
            const GAS f32x4* src = (const GAS f32x4*)(WSP(float, WS_H2) + (size_t)t * DM) + lane; const GAS f32x4* gp = (const GAS f32x4*)INF(25) + lane; const float rs = WSP(float, WS_RS)[t];
            unsigned long long r[8];
#pragma unroll
            for (int i = 0; i < 8; ++i) { const f32x4 v = src[64 * i] * gp[64 * i] * rs; r[i] = (unsigned long long)pk2(v[0], v[1]) | ((unsigned long long)pk2(v[2], v[3]) << 32); }
#pragma unroll
            for (int j = 0; j < 2; ++j) { const int ej = asg_e[2 * t + j]; const unsigned gr = pre[it * 64 + ej] + (unsigned)asg_r[2 * t + j]; const size_t row = sb[ej] + gr;
                if (lane == 0) asg_r[2 * t + j] = (int)gr;
                GAS unsigned long long* dst = (GAS unsigned long long*)(WSP(bf16_t, WS_XG) + row * DM) + lane;
#pragma unroll
                for (int i = 0; i < 8; ++i) dst[64 * i] = r[i]; } } }
        SEAM(PH_GATHER);
    }
    if (IN(PH_GATEUP)) {
        FRESH_IDS;
        const int me_ = ((vcu + (lane & 15) * G) >> 4) & (N_EXP - 1);
        const int cntv = (int)__hip_atomic_load(ctl + CW_CNT + me_, RLX_AGENT), basev = (int)__hip_atomic_load(ctl + CW_BASE + me_, RLX_AGENT);
        int kq_ = 0; f32x4 pq0 = {0.f, 0.f, 0.f, 0.f}, pq1 = pq0, pq2 = pq0, pq3 = pq0; bool have_ = false;
        for (int u = vcu; u < N_EXP * 16; u += G, ++kq_) { const int e = u >> 4, nt = u & 15;
            const int cnt = kq_ < 16 ? __builtin_amdgcn_readfirstlane(__shfl(cntv, kq_)) : __builtin_amdgcn_readfirstlane((int)__hip_atomic_load(ctl + CW_CNT + e, RLX_AGENT));
            const int row0 = kq_ < 16 ? __builtin_amdgcn_readfirstlane(__shfl(basev, kq_)) : __builtin_amdgcn_readfirstlane((int)__hip_atomic_load(ctl + CW_BASE + e, RLX_AGENT));
            const int un = u + G; const bool nv = un < N_EXP * 16; const int en = (un >> 4) & (N_EXP - 1), ntn = un & 15;
            moe_stream_unit<0>(L + RING_OFF, WSP(bf16_t, WS_XG), DM, INF(30) + (size_t)e * DM * D_EXP, INF(31) + (size_t)e * DM * D_EXP, D_EXP, 64 * nt, DM, row0, cnt, WSP(bf16_t, WS_HID), nullptr, tid, wave, lane,
                               pq0, pq1, pq2, pq3, have_, nv, INF(30) + (size_t)en * DM * D_EXP, INF(31) + (size_t)en * DM * D_EXP, 64 * ntn); }
        SEAM(PH_GATEUP);
    }
    if (IN(PH_DOWN)) {
        FRESH_IDS;
        const int me_ = ((vcu + (lane & 15) * G) >> 4) & (N_EXP - 1);
        const int cntv = (int)__hip_atomic_load(ctl + CW_CNT + me_, RLX_AGENT), basev = (int)__hip_atomic_load(ctl + CW_BASE + me_, RLX_AGENT);
        int kq_ = 0; f32x4 pq0 = {0.f, 0.f, 0.f, 0.f}, pq1 = pq0, pq2 = pq0, pq3 = pq0; bool have_ = false;
        for (int u = vcu; u < N_EXP * 16; u += G, ++kq_) { const int e = u >> 4, nt = u & 15;
            const int cnt = kq_ < 16 ? __builtin_amdgcn_readfirstlane(__shfl(cntv, kq_)) : __builtin_amdgcn_readfirstlane((int)__hip_atomic_load(ctl + CW_CNT + e, RLX_AGENT));
            const int row0 = kq_ < 16 ? __builtin_amdgcn_readfirstlane(__shfl(basev, kq_)) : __builtin_amdgcn_readfirstlane((int)__hip_atomic_load(ctl + CW_BASE + e, RLX_AGENT));
            const int un = u + G; const bool nv = un < N_EXP * 16; const int en = (un >> 4) & (N_EXP - 1), ntn = un & 15;
            moe_stream_unit<1>(L + RING_OFF, WSP(bf16_t, WS_HID), D_EXP, INF(32) + (size_t)e * D_EXP * DM, nullptr, DM, 128 * nt, D_EXP, row0, cnt, WSP(bf16_t, WS_YC), nullptr, tid, wave, lane,
                               pq0, pq1, pq2, pq3, have_, nv, INF(32) + (size_t)en * D_EXP * DM, nullptr, 128 * ntn); }
        SEAM(PH_DOWN);
    }
    if (IN(PH_FINAL)) {
        FRESH_IDS;
        __syncthreads();
        LAS unsigned* sb = (LAS unsigned*)(L + RING_OFF);
        if (tid < N_EXP) sb[tid] = __hip_atomic_load(ctl + CW_BASE + tid, RLX_AGENT);
        __syncthreads();
        const int* asg_e = WSP(int, WS_ASG); const int* asg_r = asg_e + 2 * SEQ; const float* asg_w = (const float*)(asg_r + 2 * SEQ);
        f32x4 g8[8];
        { const GAS f32x4* gp = (const GAS f32x4*)INF(33) + lane;
#pragma unroll
          for (int j = 0; j < 8; ++j) g8[j] = gp[64 * j]; }
        typedef unsigned u32x2_t __attribute__((ext_vector_type(2)));
        struct TokA { size_t r0, r1; float w0, w1; };
#define FIN_ASG(t_, k_) do { const int tt_ = (t_) < SEQ ? (t_) : SEQ - 1; k_.r0 = sb[asg_e[2 * tt_]] + (unsigned)asg_r[2 * tt_]; k_.r1 = sb[asg_e[2 * tt_ + 1]] + (unsigned)asg_r[2 * tt_ + 1]; k_.w0 = asg_w[2 * tt_]; k_.w1 = asg_w[2 * tt_ + 1]; } while (0)
#define FIN_ISSUE(t_, k_, h_, a_, b_) do { const int tt_ = (t_) < SEQ ? (t_) : SEQ - 1; const GAS f32x4* hp = (const GAS f32x4*)(WSP(float, WS_H2) + (size_t)tt_ * DM) + lane; \
            const GAS u32x2_t* y0 = (const GAS u32x2_t*)(WSP(bf16_t, WS_YC) + k_.r0 * DM) + lane; const GAS u32x2_t* y1 = (const GAS u32x2_t*)(WSP(bf16_t, WS_YC) + k_.r1 * DM) + lane; \
            _Pragma("unroll") for (int j = 0; j < 8; ++j) { h_[j] = hp[64 * j]; a_[j] = y0[64 * j]; b_[j] = y1[64 * j]; } } while (0)
#define FIN_DONE(t_, k_, h_, a_, b_) do { f32x4 v[8]; float s = 0.f; \
            _Pragma("unroll") for (int j = 0; j < 8; ++j) { const u32x2_t ya = a_[j], yb = b_[j]; \
                const f32x4 fa = {__uint_as_float(ya[0] << 16), __uint_as_float(ya[0] & 0xffff0000u), __uint_as_float(ya[1] << 16), __uint_as_float(ya[1] & 0xffff0000u)}; \
                const f32x4 fb = {__uint_as_float(yb[0] << 16), __uint_as_float(yb[0] & 0xffff0000u), __uint_as_float(yb[1] << 16), __uint_as_float(yb[1] & 0xffff0000u)}; \
                v[j] = h_[j] + (fa * k_.w0 + fb * k_.w1); s += (v[j][0] * v[j][0] + v[j][1] * v[j][1]) + (v[j][2] * v[j][2] + v[j][3] * v[j][3]); } \
            const float rs = rsqrtf(wave_allsum(s) * (1.f / DM) + NORM_EPS); \
            if ((t_) < SEQ) { GAS f32x4* op = (GAS f32x4*)(args.out + (size_t)(t_) * DM) + lane; _Pragma("unroll") for (int j = 0; j < 8; ++j) op[64 * j] = v[j] * rs * g8[j]; } } while (0)
        { TokA kA, kB; f32x4 hA[8], hB[8]; u32x2_t aA[8], bA[8], aB[8], bB[8];
          int t = gw; FIN_ASG(t, kA); FIN_ISSUE(t, kA, hA, aA, bA);
          for (; t < SEQ; t += 2 * NGW) {
              FIN_ASG(t + NGW, kB); FIN_ISSUE(t + NGW, kB, hB, aB, bB);
              FIN_DONE(t, kA, hA, aA, bA);
              FIN_ASG(t + 2 * NGW, kA); FIN_ISSUE(t + 2 * NGW, kA, hA, aA, bA);
              FIN_DONE(t + NGW, kB, hB, aB, bB); } }
#undef FIN_DONE
#undef FIN_ISSUE
#undef FIN_ASG
    }
#if MK_PROBE >= 18
    if (IN(PH_X1) || IN(PH_X2) || IN(PH_X3)) {
        f32x4 s = {0.f, 0.f, 0.f, 0.f};
        if (IN(PH_X1)) {
#ifndef MK_XW
#define MK_XW 4
#endif
            if (wave < MK_XW) for (int u = vcu; u < N_EXP * 16; u += G) { const int e = u >> 4, nt = u & 15;
                for (int m = 0; m < 2; ++m) { const float* wb = (m ? INF(31) : INF(30)) + (size_t)e * DM * D_EXP + 64 * nt + (lane & 15) * 4;
                for (int k0 = wave * 4 + (lane >> 4); k0 < DM; k0 += 16 * 4 * MK_XW) { f32x4 v[16];
#pragma unroll
                    for (int j = 0; j < 16; ++j) v[j] = *(const GAS f32x4*)(wb + (size_t)(k0 + 4 * MK_XW * j) * D_EXP);
#pragma unroll
                    for (int j = 0; j < 16; ++j) s += v[j]; } } } }
        if (IN(PH_X2)) {
        FRESH_IDS;
            const size_t total = (size_t)N_EXP * DM * D_EXP / 4;
            for (int m = 0; m < 2; ++m) { const GAS f32x4* p = (const GAS f32x4*)(m ? INF(31) : INF(30));
                for (size_t i = (size_t)gw * 64 + lane; i < total; i += (size_t)NGW * 64 * 8) { f32x4 v[8];
#pragma unroll
                    for (int j = 0; j < 8; ++j) { const size_t q = i + (size_t)j * NGW * 64; v[j] = q < total ? p[q] : (f32x4){0.f, 0.f, 0.f, 0.f}; }
#pragma unroll
                    for (int j = 0; j < 8; ++j) s += v[j]; } } }
        if (IN(PH_X3)) {
        FRESH_IDS;
            for (int u = vcu; u < N_EXP * 16; u += G) { const int e = u >> 4, kb = u & 15;
                for (int m = 0; m < 2; ++m) { const GAS f32x4* p = (const GAS f32x4*)((m ? INF(31) : INF(30)) + (size_t)e * DM * D_EXP + (size_t)kb * 128 * D_EXP);
                    for (int i = tid; i < 128 * D_EXP / 4; i += 512 * 8) { f32x4 v[8];
#pragma unroll
                        for (int j = 0; j < 8; ++j) v[j] = p[i + 512 * j];
#pragma unroll
                        for (int j = 0; j < 8; ++j) s += v[j]; } } } }
        if (s[0] + s[1] + s[2] + s[3] == 123.456f) WSP(float, WS_RS)[SEQ + tid] = s[0];
    }
#endif
#undef IN
#undef SEAM
#undef FRESH_IDS
#undef WSP
#undef INF
}

__global__ void k_transpose(const float* W, int K, int N, bf16_t* WT, int mode, int rowoff, size_t wstride, int rows_per_z) {
    __shared__ float t[32][33];
    W += (size_t)blockIdx.z * wstride; rowoff += blockIdx.z * rows_per_z;
    const int n0 = blockIdx.x * 32, k0 = blockIdx.y * 32, tx = threadIdx.x & 31, ty = threadIdx.x >> 5;
    for (int i = 0; i < 4; ++i) t[ty + 8 * i][tx] = W[(size_t)(k0 + ty + 8 * i) * N + n0 + tx];
    __syncthreads();
    for (int i = 0; i < 4; ++i) { const int n = n0 + ty + 8 * i; int r = n;
        if (mode == 1) r = (n & ~63) + rope_phys(n & 63);
        else if (mode == 2) r = (n >> 7) * 256 + (n & 127);
        else if (mode == 3) r = (n >> 7) * 256 + 128 + (n & 127);
        WT[(size_t)(rowoff + r) * K + k0 + tx] = f2bf(t[tx][ty + 8 * i]); }
}
__global__ void k_wqbh(const float* wq, bf16_t* O) { const size_t i = (size_t)blockIdx.x * blockDim.x + threadIdx.x; const int k = (int)(i >> 11), n = (int)(i & 2047); O[((size_t)(n >> 9) * DM + k) * MEM_HD + (n & 511)] = f2bf(wq[i]); }
__global__ void k_rmsnorm_bf16(const float* x, const float* g, bf16_t* out) {
    __shared__ float red[4];
    const float* xr = x + (size_t)blockIdx.x * DM; const int tid = threadIdx.x;
    float v[8]; float s = 0.f;
    for (int i = 0; i < 8; ++i) { v[i] = xr[tid + 256 * i]; s += v[i] * v[i]; }
    for (int o = 32; o > 0; o >>= 1) s += __shfl_xor(s, o);
    if ((tid & 63) == 0) red[tid >> 6] = s;
    __syncthreads();
    const float rs = rsqrtf((red[0] + red[1] + red[2] + red[3]) * (1.f / DM) + NORM_EPS);
    for (int i = 0; i < 8; ++i) out[(size_t)blockIdx.x * DM + tid + 256 * i] = f2bf(v[i] * rs * g[tid + 256 * i]);
}
__global__ void k_rope_table(const int* pos, float* tab) {
    const int i = blockIdx.x * blockDim.x + threadIdx.x; if (i >= SEQ * 32) return;
    const int t = i >> 5, j = i & 31;
    const double inv = pow(10000.0, -(double)j / 32.0), ang = (double)pos[t] * inv;
    tab[2 * i] = (float)cos(ang); tab[2 * i + 1] = (float)sin(ang);
}

struct NEpiInProj { bf16_t* PR; float* QKraw; bf16_t* Vb;
    __device__ void operator()(int m, int n, const float* v) const {
        if (n < RWKV_COLS) { for (int i = 0; i < 4; ++i) PR[(size_t)m * RWKV_COLS + n + i] = f2bf(v[i]); }
        else if (n < RWKV_COLS + 2 * QK_COLS) { for (int i = 0; i < 4; ++i) QKraw[(size_t)m * 2048 + (n - RWKV_COLS) + i] = v[i]; }
        else { for (int i = 0; i < 4; ++i) Vb[(size_t)m * 1024 + (n - RWKV_COLS - 2 * QK_COLS) + i] = f2bf(v[i]); } } };
struct NEpiBf { bf16_t* C; int ldc; int pad = 0; __device__ void operator()(int m, int n, const float* v) const { for (int i = 0; i < 4; ++i) C[(size_t)m * ldc + n + i] = f2bf(v[i]); } };
struct NEpiF32 { float* C; int ldc; int pad = 0; __device__ void operator()(int m, int n, const float* v) const { for (int i = 0; i < 4; ++i) C[(size_t)m * ldc + n + i] = v[i]; } };
struct NEpiResid { const float* base; float* out; int ldc; int pad = 0; __device__ void operator()(int m, int n, const float* v) const { for (int i = 0; i < 4; ++i) out[(size_t)m * ldc + n + i] = base[(size_t)m * ldc + n + i] + v[i]; } };

template <class Epi>
__global__ void __launch_bounds__(256) k_gemm(const bf16_t* A, int lda, const bf16_t* Bt, int ldb, int K, Epi epi, const unsigned* ctl, int eStrideB) {
    __shared__ float As[32][68], Bs[32][68];
    const int tid = threadIdx.x, m0 = blockIdx.y * 64, n0 = blockIdx.x * 64;
    if (ctl) { if ((m0 >> 8) >= (int)ctl[CW_NT]) return; Bt += (size_t)ctl[CW_TILEE + (m0 >> 8)] * eStrideB * ldb; }
    const int lr = tid >> 2, lc = (tid & 3) * 8;
    const int ty = tid >> 4, tx = tid & 15;
    float acc[4][4] = {};
    for (int k0 = 0; k0 < K; k0 += 32) {
        const u32x4 av = *(const u32x4*)(A + (size_t)(m0 + lr) * lda + k0 + lc);
        const u32x4 bv = *(const u32x4*)(Bt + (size_t)(n0 + lr) * ldb + k0 + lc);
        __syncthreads();
        for (int i = 0; i < 4; ++i) { As[lc + 2 * i][lr] = __uint_as_float(av[i] << 16); As[lc + 2 * i + 1][lr] = __uint_as_float(av[i] & 0xffff0000u);
                                      Bs[lc + 2 * i][lr] = __uint_as_float(bv[i] << 16); Bs[lc + 2 * i + 1][lr] = __uint_as_float(bv[i] & 0xffff0000u); }
        __syncthreads();
#pragma unroll 8
        for (int k = 0; k < 32; ++k) { const f32x4 a = *(const f32x4*)&As[k][ty * 4], b = *(const f32x4*)&Bs[k][tx * 4];
            for (int i = 0; i < 4; ++i) for (int j = 0; j < 4; ++j) acc[i][j] += a[i] * b[j]; }
    }
    for (int i = 0; i < 4; ++i) epi(m0 + ty * 4 + i, n0 + tx * 4, acc[i]);
}

__global__ void k_rope_apply(const float* QKraw, const float* tab, bf16_t* Qb, bf16_t* Kb) {
    const int t = blockIdx.x;
    for (int idx = threadIdx.x; idx < 1024; idx += 256) { const int which = idx >> 9, sh = (idx >> 5) & 15, j = idx & 31;
        const int plo = 8 * (j >> 2) + (j & 3), phi = plo + 4;
        const float* src = QKraw + (size_t)t * 2048 + which * 1024 + sh * 64;
        const float x1 = src[plo], x2 = src[phi], c = tab[((size_t)t * 32 + j) * 2], s = tab[((size_t)t * 32 + j) * 2 + 1];
        const float sc = which == 0 ? C2 : 1.f;
        bf16_t* dst = (which == 0 ? Qb : Kb) + (size_t)t * 1024 + sh * 64;
        dst[plo] = f2bf((x1 * c - x2 * s) * sc); dst[phi] = f2bf((x1 * s + x2 * c) * sc); }
}

__global__ void __launch_bounds__(256) k_prep(const bf16_t* PR, PrepW P, float* S0, float* BONUS) {
    __shared__ float xs[256];
    const int t = blockIdx.x, tid = threadIdx.x;
    const bf16_t* cur = PR + (size_t)t * RWKV_COLS; const bf16_t* prv = cur - RWKV_COLS;
    auto shifted = [&](int c) { const float a = bf2f(cur[c]), p = t > 0 ? bf2f(prv[c]) : 0.f; return a + (p - a) * P.mu[c]; };
    { const float v = shifted(3072 + tid); xs[tid] = tid < 64 ? tanhf(v) : (tid < 128 ? v : sigmoidf_(v)); }
    __syncthreads();
    float lw[4], la[4], lg[4] = {0.f, 0.f, 0.f, 0.f};
    for (int i = 0; i < 4; ++i) { lw[i] = P.w0[tid * 4 + i]; la[i] = P.a0[tid * 4 + i]; }
#pragma unroll 4
    for (int j = 0; j < 64; ++j) { const f32x4 w = *(const f32x4*)(P.w2 + (size_t)j * RW + tid * 4), a = *(const f32x4*)(P.a2 + (size_t)j * RW + tid * 4);
        for (int i = 0; i < 4; ++i) { lw[i] += xs[j] * w[i]; la[i] += xs[64 + j] * a[i]; } }
#pragma unroll 4
    for (int j = 0; j < 128; ++j) { const f32x4 g = *(const f32x4*)(P.g2 + (size_t)j * RW + tid * 4); for (int i = 0; i < 4; ++i) lg[i] += xs[128 + j] * g[i]; }
    float r[4], k0[4], v[4], kk[4], a[4], ss = 0.f;
    for (int i = 0; i < 4; ++i) { const int c = tid * 4 + i; r[i] = shifted(c); k0[i] = shifted(1024 + c); v[i] = shifted(2048 + c);
        a[i] = sigmoidf_(la[i]); kk[i] = k0[i] * P.k_k[c]; ss += kk[i] * kk[i]; }
    for (int o = 1; o < 16; o <<= 1) ss += __shfl_xor(ss, o);
    const float inv = 1.f / fmaxf(sqrtf(ss), 1e-12f);
    float bon = 0.f; const size_t ob = (size_t)t * RW + tid * 4; constexpr size_t SS = (size_t)SEQ * RW;
    for (int i = 0; i < 4; ++i) { const int c = tid * 4 + i;
        const float x = -lw[i], sp = fmaxf(x, 0.f) + log1pf(__expf(-fabsf(x))), wraw = -sp - 0.5f, dec = __expf(-__expf(wraw));
        const float kn = kk[i] * inv, k = k0[i] * (1.f + (a[i] - 1.f) * P.k_a[c]);
        bon += r[i] * k * P.r_k[c];
        S0[0 * SS + ob + i] = r[i]; S0[1 * SS + ob + i] = dec; S0[2 * SS + ob + i] = k; S0[3 * SS + ob + i] = v[i];
        S0[4 * SS + ob + i] = -kn; S0[5 * SS + ob + i] = kn * a[i]; S0[6 * SS + ob + i] = lg[i]; }
    for (int o = 1; o < 16; o <<= 1) bon += __shfl_xor(bon, o);
    if ((tid & 15) == 0) BONUS[t * 16 + (tid >> 4)] = bon;
}
__global__ void __launch_bounds__(256) k_scan(const float* S0, float* Y) {
    const int w = blockIdx.x * 4 + (threadIdx.x >> 6), lane = threadIdx.x & 63, h = w >> 6, vr = w & 63;
    constexpr size_t SS = (size_t)SEQ * RW;
    const float* pr = S0 + h * 64 + lane; float s = 0.f;
    for (int t = 0; t < SEQ; ++t) { const size_t o = (size_t)t * RW;
        const float r = pr[o], wd = pr[SS + o], k = pr[2 * SS + o], a = pr[4 * SS + o], b = pr[5 * SS + o], v = S0[3 * SS + o + h * 64 + vr];
        float sa = s * a; for (int x = 32; x > 0; x >>= 1) sa += __shfl_xor(sa, x);
        s = s * wd + sa * b + v * k;
        float y = s * r; for (int x = 32; x > 0; x >>= 1) y += __shfl_xor(y, x);
        if (lane == 0) Y[o + h * 64 + vr] = y; }
}
__global__ void __launch_bounds__(256) k_rwkv_post(const float* Y, const float* S0, const float* BONUS, const float* lnx_w, const float* lnx_b, bf16_t* MIXED) {
    const int t = blockIdx.x, tid = threadIdx.x; constexpr size_t SS = (size_t)SEQ * RW; const size_t ob = (size_t)t * RW + tid * 4;
    float y[4], s = 0.f; for (int i = 0; i < 4; ++i) { y[i] = Y[ob + i]; s += y[i]; }
    for (int o = 1; o < 16; o <<= 1) s += __shfl_xor(s, o);
    const float mean = s * (1.f / 64.f); float q = 0.f; for (int i = 0; i < 4; ++i) { y[i] -= mean; q += y[i] * y[i]; }
    for (int o = 1; o < 16; o <<= 1) q += __shfl_xor(q, o);
    const float rstd = rsqrtf(q * (1.f / 64.f) + LNX_EPS), bon = BONUS[t * 16 + (tid >> 4)];
    for (int i = 0; i < 4; ++i) { const int c = tid * 4 + i; const float o = (y[i] * rstd * lnx_w[c] + lnx_b[c] + bon * S0[3 * SS + ob + i]) * S0[6 * SS + ob + i];
        MIXED[(size_t)t * DM + c] = f2bf(o); }
}
__global__ void __launch_bounds__(64) k_attn(const bf16_t* Qb, const bf16_t* Kb, const bf16_t* Vb, bf16_t* O2) {
    const int row = blockIdx.x * 64 + threadIdx.x, sh = blockIdx.y, qt = blockIdx.z;
    float q[64], o[32]; for (int d = 0; d < 64; ++d) q[d] = bf2f(Qb[(size_t)row * 1024 + sh * 64 + d]);
    for (int d = 0; d < 32; ++d) o[d] = 0.f;
    float m = -1e30f, l = 0.f; const int jmax = blockIdx.x * 64 + 63;
    const bf16_t* kp = Kb + sh * 64; const bf16_t* vp = Vb + (sh >> 1) * 128 + qt * 32;
    for (int j = 0; j <= jmax; ++j) {
        float s = 0.f; for (int d = 0; d < 64; ++d) s += q[d] * bf2f(kp[(size_t)j * 1024 + d]);
        if (j <= row) { const float mn = fmaxf(m, s), f = exp2f(m - mn), p = exp2f(s - mn); l = l * f + p; m = mn;
            for (int d = 0; d < 32; ++d) o[d] = o[d] * f + p * bf2f(vp[(size_t)j * 1024 + d]); } }
    const float il = 1.f / l;
    for (int d = 0; d < 32; ++d) O2[(size_t)(qt >> 1) * SEQ * 1024 + (size_t)row * 1024 + sh * 64 + (qt & 1) * 32 + d] = f2bf(o[d] * il);
}
__global__ void __launch_bounds__(256) k_diff_post(const bf16_t* O2, const float* lambdas, const float* subln_w, bf16_t* MIXED) {
    __shared__ float lamsh;
    const int t = blockIdx.x, tid = threadIdx.x;
    if (tid < 64) { float a = lambdas[tid] * lambdas[64 + tid], b = lambdas[128 + tid] * lambdas[192 + tid];
        for (int o = 32; o > 0; o >>= 1) { a += __shfl_xor(a, o); b += __shfl_xor(b, o); }
        if (tid == 0) lamsh = expf(a) - expf(b) + LAMBDA_INIT; }
    __syncthreads();
    const float lam = lamsh; const int h = tid >> 5, d0 = (tid & 31) * 4;
    float o[4], q = 0.f;
    const bf16_t* ob = O2 + (size_t)(d0 >> 6) * SEQ * 1024 + (size_t)t * 1024 + (d0 & 63);
    for (int i = 0; i < 4; ++i) { o[i] = bf2f(ob[(2 * h) * 64 + i]) - lam * bf2f(ob[(2 * h + 1) * 64 + i]); q += o[i] * o[i]; }
    for (int x = 1; x < 32; x <<= 1) q += __shfl_xor(q, x);
    const float rs = rsqrtf(q * (1.f / 128.f) + SUBLN_EPS) * (1.f - LAMBDA_INIT);
    for (int i = 0; i < 4; ++i) MIXED[(size_t)t * DM + 1024 + h * 128 + d0 + i] = f2bf(o[i] * rs * subln_w[d0 + i]);
}
__global__ void __launch_bounds__(256) k_softmax_mem(const float* Sraw, bf16_t* Pm) {
    const int t = blockIdx.x, tid = threadIdx.x, h = tid >> 6;
    const float sc = 0.044194173824159216f;
    float v[4], m = -1e30f; for (int i = 0; i < 4; ++i) { v[i] = Sraw[(size_t)t * 1024 + h * 256 + (tid & 63) + 64 * i] * sc; m = fmaxf(m, v[i]); }
    for (int o = 32; o > 0; o >>= 1) m = fmaxf(m, __shfl_xor(m, o));
    float s = 0.f; for (int i = 0; i < 4; ++i) { v[i] = __expf(v[i] - m); s += v[i]; }
    for (int o = 32; o > 0; o >>= 1) s += __shfl_xor(s, o);
    const float il = 1.f / s; for (int i = 0; i < 4; ++i) Pm[(size_t)t * 1024 + h * 256 + (tid & 63) + 64 * i] = f2bf(v[i] * il);
}
__global__ void __launch_bounds__(256) k_router(const float* H2, const float* g, const float* wg, const float* bg, const float* we, const float* be, bf16_t* XH, unsigned* ctl, int* asg_e, int* asg_r, float* asg_w) {
    __shared__ float hn[DM]; __shared__ float red[4]; __shared__ float lg[72];
    const int t = blockIdx.x, tid = threadIdx.x; const float* xr = H2 + (size_t)t * DM;
    float v[8], s = 0.f; for (int i = 0; i < 8; ++i) { v[i] = xr[tid + 256 * i]; s += v[i] * v[i]; }
    for (int o = 32; o > 0; o >>= 1) s += __shfl_xor(s, o);
    if ((tid & 63) == 0) red[tid >> 6] = s;
    __syncthreads();
    const float rs = rsqrtf((red[0] + red[1] + red[2] + red[3]) * (1.f / DM) + NORM_EPS);
    for (int i = 0; i < 8; ++i) { const float x = v[i] * rs * g[tid + 256 * i]; hn[tid + 256 * i] = x; XH[(size_t)t * DM + tid + 256 * i] = f2bf(x); }
    __syncthreads();
    if (tid < 72) { float a = 0.f;
        if (tid < 8) { for (int k = 0; k < DM; ++k) a += hn[k] * wg[(size_t)k * 8 + tid]; a += bg[tid]; }
        else { for (int k = 0; k < DM; ++k) a += hn[k] * we[(size_t)k * 64 + tid - 8]; a += be[tid - 8]; }
        lg[tid] = a; }
    __syncthreads();
    if (tid == 0) {
        int gi = 0; float gm = lg[0]; for (int i = 1; i < 8; ++i) if (lg[i] > gm) { gm = lg[i]; gi = i; }
        float gs = 0.f; for (int i = 0; i < 8; ++i) gs += expf(lg[i] - gm);
        const float gw = 1.f / gs;
        const float* el = lg + 8 + gi * 8; int i0 = 0; for (int i = 1; i < 8; ++i) if (el[i] > el[i0]) i0 = i;
        int i1 = -1; for (int i = 0; i < 8; ++i) if (i != i0 && (i1 < 0 || el[i] > el[i1])) i1 = i;
        const float p1 = expf(el[i1] - el[i0]), w0 = gw / (1.f + p1), w1 = gw * p1 / (1.f + p1);
        const int e0 = gi * 8 + i0, e1 = gi * 8 + i1;
        asg_e[2 * t] = e0; asg_e[2 * t + 1] = e1; asg_w[2 * t] = w0; asg_w[2 * t + 1] = w1;
        asg_r[2 * t] = (int)atomicAdd(&ctl[CW_CNT + e0], 1u); asg_r[2 * t + 1] = (int)atomicAdd(&ctl[CW_CNT + e1], 1u); }
}
__global__ void k_moe_offsets(unsigned* ctl) {
    if (threadIdx.x == 0) { unsigned b = 0; int nt = 0;
        for (int e = 0; e < N_EXP; ++e) { ctl[CW_BASE + e] = b; const unsigned n = (ctl[CW_CNT + e] + 255u) / 256u; for (unsigned i = 0; i < n; ++i) ctl[CW_TILEE + nt++] = e; b += n * 256u; }
        ctl[CW_BASE + N_EXP] = b; ctl[CW_NT] = nt; }
}
__global__ void __launch_bounds__(256) k_gather(const bf16_t* XH, const unsigned* ctl, const int* asg_e, const int* asg_r, bf16_t* XG) {
    const int t = blockIdx.x, tid = threadIdx.x; const u32x4 v = *(const u32x4*)(XH + (size_t)t * DM + tid * 8);
    for (int i = 0; i < 2; ++i) { const size_t row = ctl[CW_BASE + asg_e[2 * t + i]] + asg_r[2 * t + i]; *(u32x4*)(XG + row * DM + tid * 8) = v; }
}
__global__ void k_silu_mul(const float* GU, const unsigned* ctl, bf16_t* HID) {
    const size_t i = (size_t)blockIdx.x * blockDim.x + threadIdx.x; const size_t row = i >> 10; const int c = (int)(i & 1023);
    if (row >= (size_t)ctl[CW_NT] * 256) return;
    const float gt = GU[row * 2048 + (c >> 7) * 256 + (c & 127)], up = GU[row * 2048 + (c >> 7) * 256 + 128 + (c & 127)];
    HID[row * 1024 + c] = f2bf(gt / (1.f + __expf(-gt)) * up);
}
__global__ void __launch_bounds__(256) k_final(const float* H2, const float* YC, const unsigned* ctl, const int* asg_e, const int* asg_r, const float* asg_w, const float* g, float* out) {
    __shared__ float red[4];
    const int t = blockIdx.x, tid = threadIdx.x;
    const size_t r0 = ctl[CW_BASE + asg_e[2 * t]] + asg_r[2 * t], r1 = ctl[CW_BASE + asg_e[2 * t + 1]] + asg_r[2 * t + 1]; const float w0 = asg_w[2 * t], w1 = asg_w[2 * t + 1];
    float v[8], s = 0.f; for (int i = 0; i < 8; ++i) { const int c = tid + 256 * i; v[i] = H2[(size_t)t * DM + c] + (w0 * YC[r0 * DM + c] + w1 * YC[r1 * DM + c]); s += v[i] * v[i]; }
    for (int o = 32; o > 0; o >>= 1) s += __shfl_xor(s, o);
    if ((tid & 63) == 0) red[tid >> 6] = s;
    __syncthreads();
    const float rs = rsqrtf((red[0] + red[1] + red[2] + red[3]) * (1.f / DM) + NORM_EPS);
    for (int i = 0; i < 8; ++i) out[(size_t)t * DM + tid + 256 * i] = v[i] * rs * g[tid + 256 * i];
}

template <class Epi> static void gemm(hipStream_t st, const bf16_t* A, int lda, const bf16_t* Bt, int ldb, int M, int N, int K, Epi e, const unsigned* ctl = nullptr, int eStrideB = 0) {
    hipLaunchKernelGGL(k_gemm<Epi>, dim3(N / 64, M / 64), dim3(256), 0, st, A, lda, Bt, ldb, K, e, ctl, eStrideB);
}
static int g_grid = 0;
static void launch_mk(hipStream_t st, Args a, int lo, int hi, int li) {
    a.ph_lo = lo; a.ph_hi = hi; a.li = li;
    hipLaunchKernelGGL(mk_fwd, dim3(g_grid), dim3(NWAVES * 64), LDS_BYTES, st, a);
    const hipError_t le = hipPeekAtLastError();
    if (le != hipSuccess) fprintf(stderr, "kernel_launch: mk_fwd launch [%d,%d) failed: %s\n", lo, hi, hipGetErrorName(le));
}
extern "C" void kernel_launch(void* const* d_in, const int* in_sizes, int n_in, void* d_out, int out_size, void* d_ws, size_t ws_size, hipStream_t stream) {
    if (n_in != 34 || ws_size < WS_NEED) { fprintf(stderr, "kernel_launch: need 34 inputs and %zu bytes of workspace (got %d, %zu)\n", (size_t)WS_END, n_in, ws_size); return; }
    if (g_grid == 0) {
        int dev = 0, cus = 0;
        if (hipGetDevice(&dev) != hipSuccess || hipDeviceGetAttribute(&cus, hipDeviceAttributeMultiprocessorCount, dev) != hipSuccess) { fprintf(stderr, "kernel_launch: device query failed\n"); g_grid = -1; return; }
        if (hipFuncSetAttribute((const void*)mk_fwd, hipFuncAttributeMaxDynamicSharedMemorySize, LDS_BYTES) != hipSuccess) { fprintf(stderr, "kernel_launch: hipFuncSetAttribute failed\n"); g_grid = -1; return; }
        int per_cu = 0; (void)hipOccupancyMaxActiveBlocksPerMultiprocessor(&per_cu, (const void*)mk_fwd, NWAVES * 64, LDS_BYTES); (void)hipGetLastError();
        if (per_cu < 1) fprintf(stderr, "kernel_launch: note: occupancy query reports %d workgroups per CU\n", per_cu);
        g_grid = cus;
    }
    if (g_grid < 0) return;
    auto F = [&](int i) { return (const float*)d_in[i]; };
    const float *x = F(0), *mem = F(1); const int* positions = (const int*)d_in[2];
    const float *mix_norm = F(3), *w_in = F(4), *w_out = F(18), *mem_q_norm = F(19), *mem_kv_norm = F(20), *wq = F(21), *wk = F(22), *wv = F(23), *wo = F(24),
                *moe_norm = F(25), *rgw = F(26), *rgb = F(27), *rew = F(28), *reb = F(29), *eg = F(30), *eu = F(31), *ed = F(32), *final_norm = F(33);
    (void)x; (void)mem; (void)positions; (void)mix_norm; (void)w_in; (void)w_out; (void)mem_kv_norm; (void)wq; (void)wk; (void)wv; (void)wo; (void)eg; (void)eu; (void)ed;
    char* ws = (char*)d_ws; hipStream_t st = stream;
    unsigned* ctl = (unsigned*)(ws + WS_CTL); float* rope = (float*)(ws + WS_ROPE);
    bf16_t *WinT = (bf16_t*)(ws + WS_WINT), *WoutT = (bf16_t*)(ws + WS_WOUTT), *WkvT = (bf16_t*)(ws + WS_WKVT), *WqBh = (bf16_t*)(ws + WS_WQBH), *WoTh = (bf16_t*)(ws + WS_WOTH),
           *BtS = (bf16_t*)(ws + WS_BTS), *BtO = (bf16_t*)(ws + WS_BTO), *MEMN = (bf16_t*)(ws + WS_MEMN), *KVh = (bf16_t*)(ws + WS_KVH), *WguT = (bf16_t*)(ws + WS_WGUT), *WdT = (bf16_t*)(ws + WS_WDT),
           *HN1 = (bf16_t*)(ws + WS_HN1), *Pm = (bf16_t*)(ws + WS_PM), *XH = (bf16_t*)(ws + WS_XH), *XN = (bf16_t*)(ws + WS_XN), *PR = (bf16_t*)(ws + WS_PR), *Qb = (bf16_t*)(ws + WS_QB),
           *Kb = (bf16_t*)(ws + WS_KB), *Vb = (bf16_t*)(ws + WS_VB), *O2 = (bf16_t*)(ws + WS_O2), *MIXED = (bf16_t*)(ws + WS_MIXED), *XG = (bf16_t*)(ws + WS_XG), *HID = (bf16_t*)(ws + WS_HID);
    float *H1 = (float*)(ws + WS_H1), *H2 = (float*)(ws + WS_H2), *S0 = (float*)(ws + WS_S0), *Y = (float*)(ws + WS_Y), *BONUS = (float*)(ws + WS_BONUS), *QKraw = (float*)(ws + WS_QKRAW),
          *Sraw = (float*)(ws + WS_SRAW), *YC = (float*)(ws + WS_YC), *GU = (float*)(ws + WS_GU);
    (void)WinT; (void)WoutT; (void)WkvT; (void)WqBh; (void)WoTh; (void)BtS; (void)BtO; (void)MEMN; (void)KVh; (void)WguT; (void)WdT; (void)Pm; (void)XN; (void)QKraw; (void)Sraw; (void)GU; (void)rope; (void)HID;
    int* asg_e = (int*)(ws + WS_ASG); int* asg_r = asg_e + 2 * SEQ; float* asg_w = (float*)(asg_r + 2 * SEQ);
    if (hipMemsetAsync(ctl, 0, CTL_ZERO_BYTES, st) != hipSuccess) { fprintf(stderr, "kernel_launch: memset failed\n"); return; }
    Args a{}; for (int i = 0; i < 34; ++i) a.in[i] = (const float*)d_in[i]; a.out = (float*)d_out; a.ws = (unsigned char*)d_ws;
    int li = 0;
    PrepW P{F(5), F(6), F(7), F(8), F(9), F(10), F(11), F(12), F(13)};
    int pend_lo = -1;
    for (int k = 0; k <= PH_N; ++k) {
        const bool naive = k < PH_N && ((MK_NAIVE_MASK >> k) & 1);
        if (k < PH_N && !naive) { if (pend_lo < 0) pend_lo = k; continue; }
        if (pend_lo >= 0) { launch_mk(st, a, pend_lo, k, li++); pend_lo = -1; }
        if (k == PH_N) break;
        switch (k) {
        case PH_PRO:
            hipLaunchKernelGGL(k_transpose, dim3(RWKV_COLS / 32, DM / 32, 1), dim3(256), 0, st, w_in, DM, IN_COLS, WinT, 0, 0, (size_t)0, 0);
            hipLaunchKernelGGL(k_transpose, dim3(2 * QK_COLS / 32, DM / 32, 1), dim3(256), 0, st, w_in + RWKV_COLS, DM, IN_COLS, WinT + (size_t)RWKV_COLS * DM, 1, 0, (size_t)0, 0);
            hipLaunchKernelGGL(k_transpose, dim3(1024 / 32, DM / 32, 1), dim3(256), 0, st, w_in + RWKV_COLS + 2 * QK_COLS, DM, IN_COLS, WinT + (size_t)(RWKV_COLS + 2 * QK_COLS) * DM, 0, 0, (size_t)0, 0);
            hipLaunchKernelGGL(k_transpose, dim3(DM / 32, DM / 32, 1), dim3(256), 0, st, w_out, DM, DM, WoutT, 0, 0, (size_t)0, 0);
            hipLaunchKernelGGL(k_transpose, dim3(DM / 32, DM / 32, 1), dim3(256), 0, st, wk, DM, DM, WkvT, 0, 0, (size_t)0, 0);
            hipLaunchKernelGGL(k_transpose, dim3(DM / 32, DM / 32, 1), dim3(256), 0, st, wv, DM, DM, WkvT + (size_t)DM * DM, 0, 0, (size_t)0, 0);
            hipLaunchKernelGGL(k_transpose, dim3(DM / 32, MEM_HD / 32, MEM_HEADS), dim3(256), 0, st, wo, MEM_HD, DM, WoTh, 0, 0, (size_t)MEM_HD * DM, 2048);
            hipLaunchKernelGGL(k_wqbh, dim3(DM * DM / 256), dim3(256), 0, st, wq, WqBh);
            hipLaunchKernelGGL(k_transpose, dim3(D_EXP / 32, DM / 32, N_EXP), dim3(256), 0, st, eg, DM, D_EXP, WguT, 2, 0, (size_t)DM * D_EXP, 2048);
            hipLaunchKernelGGL(k_transpose, dim3(D_EXP / 32, DM / 32, N_EXP), dim3(256), 0, st, eu, DM, D_EXP, WguT, 3, 0, (size_t)DM * D_EXP, 2048);
            hipLaunchKernelGGL(k_transpose, dim3(DM / 32, D_EXP / 32, N_EXP), dim3(256), 0, st, ed, D_EXP, DM, WdT, 0, 0, (size_t)DM * D_EXP, 2048);
            hipLaunchKernelGGL(k_rope_table, dim3(SEQ * 32 / 256), dim3(256), 0, st, positions, rope);
            hipLaunchKernelGGL(k_rmsnorm_bf16, dim3(SEQ), dim3(256), 0, st, x, mix_norm, XN);
            hipLaunchKernelGGL(k_rmsnorm_bf16, dim3(MEM_LEN), dim3(256), 0, st, mem, mem_kv_norm, MEMN);
            break;
        case PH_INPROJ:
            gemm(st, XN, DM, WinT, DM, SEQ, IN_COLS, DM, NEpiInProj{PR, QKraw, Vb});
            hipLaunchKernelGGL(k_rope_apply, dim3(SEQ), dim3(256), 0, st, QKraw, rope, Qb, Kb);
            for (int t = 0; t < 8; ++t) gemm(st, MEMN, DM, WkvT + (size_t)t * MEM_HD * DM, DM, MEM_LEN, MEM_HD, DM, NEpiBf{KVh + (size_t)t * MEM_LEN * MEM_HD, MEM_HD});
            break;
        case PH_MEMPRE:
            for (int h = 0; h < MEM_HEADS; ++h) {
                gemm(st, KVh + (size_t)h * MEM_LEN * MEM_HD, MEM_HD, WqBh + (size_t)h * DM * MEM_HD, MEM_HD, MEM_LEN, DM, MEM_HD, NEpiBf{BtS + (size_t)h * MEM_LEN * DM, DM});
                gemm(st, WoTh + (size_t)h * DM * MEM_HD, MEM_HD, KVh + (size_t)(4 + h) * MEM_LEN * MEM_HD, MEM_HD, DM, MEM_LEN, MEM_HD, NEpiBf{BtO + h * MEM_LEN, MEM_HEADS * MEM_LEN}); }
            break;
        case PH_LORA: break;
        case PH_SCANA: hipLaunchKernelGGL(k_prep, dim3(SEQ), dim3(256), 0, st, PR, P, S0, BONUS); break;
        case PH_SCANB: hipLaunchKernelGGL(k_scan, dim3(256), dim3(256), 0, st, S0, Y); break;
        case PH_SCANC: hipLaunchKernelGGL(k_rwkv_post, dim3(SEQ), dim3(256), 0, st, Y, S0, BONUS, F(14), F(15), MIXED); break;
        case PH_ATTN: hipLaunchKernelGGL(k_attn, dim3(SEQ / 64, 16, 4), dim3(64), 0, st, Qb, Kb, Vb, O2); break;
        case PH_POST:
            hipLaunchKernelGGL(k_diff_post, dim3(SEQ), dim3(256), 0, st, O2, F(16), F(17), MIXED);
            break;
        case PH_OUTPROJ: gemm(st, MIXED, DM, WoutT, DM, SEQ, DM, DM, NEpiResid{x, H1, DM}); break;
        case PH_HN1: hipLaunchKernelGGL(k_rmsnorm_bf16, dim3(SEQ), dim3(256), 0, st, H1, mem_q_norm, HN1); break;
        case PH_SCORES:
            gemm(st, HN1, DM, BtS, DM, SEQ, MEM_HEADS * MEM_LEN, DM, NEpiF32{Sraw, MEM_HEADS * MEM_LEN});
            hipLaunchKernelGGL(k_softmax_mem, dim3(SEQ), dim3(256), 0, st, Sraw, Pm);
            break;
        case PH_MEMOUT: gemm(st, Pm, MEM_HEADS * MEM_LEN, BtO, MEM_HEADS * MEM_LEN, SEQ, DM, MEM_HEADS * MEM_LEN, NEpiResid{H1, H2, DM}); break;
        case PH_ROUTER: hipLaunchKernelGGL(k_router, dim3(SEQ), dim3(256), 0, st, H2, moe_norm, rgw, rgb, rew, reb, XH, ctl, asg_e, asg_r, asg_w); break;
        case PH_GATHER:
            hipLaunchKernelGGL(k_moe_offsets, dim3(1), dim3(64), 0, st, ctl);
            hipLaunchKernelGGL(k_gather, dim3(SEQ), dim3(256), 0, st, XH, ctl, asg_e, asg_r, XG);
            break;
        case PH_GATEUP:
            gemm(st, XG, DM, WguT, DM, XG_ROWS, 2048, DM, NEpiF32{GU, 2048}, ctl, 2048);
            hipLaunchKernelGGL(k_silu_mul, dim3(XG_ROWS * 1024 / 256), dim3(256), 0, st, GU, ctl, HID);
            break;
        case PH_DOWN: gemm(st, HID, D_EXP, WdT, D_EXP, XG_ROWS, DM, D_EXP, NEpiF32{YC, DM}, ctl, 2048); break;
        case PH_FINAL: hipLaunchKernelGGL(k_final, dim3(SEQ), dim3(256), 0, st, H2, YC, ctl, asg_e, asg_r, asg_w, final_norm, (float*)d_out); break;
        }
    }
#if MK_PROBE >= 0
#if defined(MK_PROBE_VAR)
    a.pad = MK_PROBE_VAR;
#endif
    for (int r = 0; r < MK_PROBE_REPS; ++r) launch_mk(st, a, MK_PROBE, MK_PROBE + 1, li);
#endif
}
```
